# Optimizing an MI355X kernel written in HIP

```python
import math
import jax, jax.numpy as jnp
from jax import lax
import numpy as np

D_MODEL = 1024
BATCH = 8
SEQ = 4096
DEPTH = 4

GRID_W = 64
CTX_LEN = 256
N_MIXERS = 3
D_FF = 4 * D_MODEL
NORM_EPS = 1e-6
N_MOD = 6
S5_GROUP = 16
S5_GROUPS = D_MODEL // S5_GROUP
S5_STATE = 64
S5_DT_MIN = 1e-3
S5_DT_MAX = 1e-1
DIFF_HEAD_DIM = 64
DIFF_HEADS = D_MODEL // (2 * DIFF_HEAD_DIM)
DIFF_V_DIM = 2 * DIFF_HEAD_DIM
ROPE_BASE = 10000.0
Q_BLOCK = 128
FOURIER_GROUPS = 4
FOURIER_CH = D_MODEL // FOURIER_GROUPS
N_S5_LAYERS = (DEPTH + 2) // 3
N_DIFF_LAYERS = (DEPTH + 1) // 3
N_FOURIER_LAYERS = DEPTH // 3

kernel_name = "hybrid_s5_diffattn_fourier_prefix_dit"


def _rmsnorm(x, g):
    x32 = x.astype(jnp.float32)
    y = x32 * lax.rsqrt(jnp.mean(x32 * x32, axis=-1, keepdims=True) + NORM_EPS)
    return (y * g.astype(jnp.float32)).astype(x.dtype)


def _modulate(h, shift, scale):
    return h * (1 + scale) + shift


def _sqrelu_mlp(h, w1, w2):
    a = jax.nn.relu(h @ w1)
    return (a * a) @ w2


def _s5_discretize(lam_re, lam_im, log_dt, b_re, b_im):
    f32 = jnp.float32
    lam_re = lam_re.astype(f32)
    lam_im = lam_im.astype(f32)
    dt = jnp.exp(log_dt.astype(f32))[:, None]
    mag = jnp.exp(lam_re * dt)
    a_re = mag * jnp.cos(lam_im * dt)
    a_im = mag * jnp.sin(lam_im * dt)
    n_re = a_re - 1.0
    n_im = a_im
    den = lam_re * lam_re + lam_im * lam_im
    k_re = (n_re * lam_re + n_im * lam_im) / den
    k_im = (n_im * lam_re - n_re * lam_im) / den
    b_re = b_re.astype(f32)
    b_im = b_im.astype(f32)
    bb_re = k_re[..., None] * b_re - k_im[..., None] * b_im
    bb_im = k_re[..., None] * b_im + k_im[..., None] * b_re
    return a_re, a_im, bb_re, bb_im


def _complex_combine(e1, e2):
    a1r, a1i, b1r, b1i = e1
    a2r, a2i, b2r, b2i = e2
    return (a2r * a1r - a2i * a1i,
            a2r * a1i + a2i * a1r,
            a2r * b1r - a2i * b1i + b2r,
            a2r * b1i + a2i * b1r + b2i)


def _s5_states(u, a_re, a_im, bb_re, bb_im, h0, reverse):
    bu_re = jnp.einsum('blgh,gph->blgp', u, bb_re)
    bu_im = jnp.einsum('blgh,gph->blgp', u, bb_im)
    if reverse:
        bu_re = jnp.flip(bu_re, 1)
        bu_im = jnp.flip(bu_im, 1)
    shape = (1, u.shape[1]) + a_re.shape
    ar = jnp.broadcast_to(a_re, shape)
    ai = jnp.broadcast_to(a_im, shape)
    acr, aci, hr, hi = lax.associative_scan(_complex_combine, (ar, ai, bu_re, bu_im), axis=1)
    if h0 is not None:
        h0r = h0[0][:, None]
        h0i = h0[1][:, None]
        hr = hr + acr * h0r - aci * h0i
        hi = hi + acr * h0i + aci * h0r
    final = (hr[:, -1], hi[:, -1])
    if reverse:
        hr = jnp.flip(hr, 1)
        hi = jnp.flip(hi, 1)
    return hr, hi, final


def _s5_readout(s_re, s_im, c_re, c_im):
    return jnp.einsum('blgp,ghp->blgh', s_re, c_re) - jnp.einsum('blgp,ghp->blgh', s_im, c_im)


def _s5_output(y, u, d, w_glu, dtype):
    bsz, n = y.shape[:2]
    z = jax.nn.gelu(y.reshape(bsz, n, D_MODEL) + d.astype(jnp.float32) * u.reshape(bsz, n, D_MODEL))
    g = z.astype(dtype) @ w_glu
    return g[..., :D_MODEL] * jax.nn.sigmoid(g[..., D_MODEL:])


def _s5_mixer(h_lat, h_ctx, lam_re, lam_im, log_dt, b_re, b_im, c_re, c_im, d, w_glu, ctx_out):
    f32 = jnp.float32
    bsz, n_lat, _ = h_lat.shape
    n_ctx = h_ctx.shape[1]
    u_lat = h_lat.astype(f32).reshape(bsz, n_lat, S5_GROUPS, S5_GROUP)
    u_ctx = h_ctx.astype(f32).reshape(bsz, n_ctx, S5_GROUPS, S5_GROUP)
    ys_lat = []
    ys_ctx = []
    for direction in range(2):
        reverse = direction == 1
        a_re, a_im, bb_re, bb_im = _s5_discretize(lam_re[direction], lam_im[direction], log_dt[direction], b_re[direction], b_im[direction])
        cr = c_re[direction].astype(f32)
        ci = c_im[direction].astype(f32)
        s_re, s_im, final = _s5_states(u_ctx, a_re, a_im, bb_re, bb_im, None, reverse)
        if ctx_out:
            ys_ctx.append(_s5_readout(s_re, s_im, cr, ci))
        s_re, s_im, _ = _s5_states(u_lat, a_re, a_im, bb_re, bb_im, final, reverse)
        ys_lat.append(_s5_readout(s_re, s_im, cr, ci))
    out_lat = _s5_output(ys_lat[0] + ys_lat[1], u_lat, d, w_glu, h_lat.dtype)
    out_ctx = _s5_output(ys_ctx[0] + ys_ctx[1], u_ctx, d, w_glu, h_ctx.dtype) if ctx_out else None
    return out_lat, out_ctx


def _axial_rope_tables(n_tokens):
    f32 = jnp.float32
    rows = n_tokens // GRID_W
    row = jnp.repeat(jnp.arange(rows, dtype=f32), GRID_W)
    col = jnp.tile(jnp.arange(GRID_W, dtype=f32), rows)
    half = DIFF_HEAD_DIM // 2
    inv = jnp.power(ROPE_BASE, -jnp.arange(0, half, 2, dtype=f32) / half)
    ang_r = row[:, None] * inv
    ang_c = col[:, None] * inv
    ex = lambda a: a[:, None, None, :]
    return (ex(jnp.cos(ang_r)), ex(jnp.sin(ang_r)), ex(jnp.cos(ang_c)), ex(jnp.sin(ang_c)))


def _rot_half(xh, cos, sin):
    x1, x2 = jnp.split(xh, 2, axis=-1)
    return jnp.concatenate([x1 * cos - x2 * sin, x1 * sin + x2 * cos], axis=-1)


def _axial_rope(x, rope):
    cr, sr, cc, sc = rope
    half = DIFF_HEAD_DIM // 2
    xf = x.astype(jnp.float32)
    out = jnp.concatenate([_rot_half(xf[..., :half], cr, sr), _rot_half(xf[..., half:], cc, sc)], axis=-1)
    return out.astype(x.dtype)


def _diff_qkv(h, w_qkv, q_norm, k_norm):
    bsz, n, _ = h.shape
    q, k, v = jnp.split(h @ w_qkv, 3, axis=-1)
    q = _rmsnorm(q.reshape(bsz, n, DIFF_HEADS, 2, DIFF_HEAD_DIM), q_norm)
    k = _rmsnorm(k.reshape(bsz, n, DIFF_HEADS, 2, DIFF_HEAD_DIM), k_norm)
    v = v.reshape(bsz, n, DIFF_HEADS, DIFF_V_DIM)
    return q, k, v


def _diff_attend(q, k, v, lam):
    s = jnp.einsum('bqhcd,bkhcd->bhcqk', q, k, preferred_element_type=jnp.float32) * (DIFF_HEAD_DIM ** -0.5)
    p = jax.nn.softmax(s, axis=-1)
    w = p[:, :, 0] - lam * p[:, :, 1]
    return jnp.einsum('bhqk,bkhe->bqhe', w.astype(v.dtype), v)


def _diff_mixer(h_lat, h_ctx, rope, w_qkv, q_norm, k_norm, lam_params, subln, w_o, lam_init, ctx_out):
    bsz, n_lat, _ = h_lat.shape
    q_l, k_l, v_l = _diff_qkv(h_lat, w_qkv, q_norm, k_norm)
    q_c, k_c, v_c = _diff_qkv(h_ctx, w_qkv, q_norm, k_norm)
    q_l = _axial_rope(q_l, rope)
    k_l = _axial_rope(k_l, rope)
    lp = lam_params.astype(jnp.float32)
    lam = jnp.exp(jnp.sum(lp[0] * lp[1])) - jnp.exp(jnp.sum(lp[2] * lp[3])) + lam_init
    k_all = jnp.concatenate([k_l, k_c], axis=1)
    v_all = jnp.concatenate([v_l, v_c], axis=1)
    n_blocks = n_lat // Q_BLOCK
    qb = q_l.reshape(bsz, n_blocks, Q_BLOCK, DIFF_HEADS, 2, DIFF_HEAD_DIM).transpose(1, 0, 2, 3, 4, 5)
    o = lax.map(lambda qq: _diff_attend(qq, k_all, v_all, lam), qb)
    o_l = o.transpose(1, 0, 2, 3, 4).reshape(bsz, n_lat, DIFF_HEADS, DIFF_V_DIM)

    def finish(oo):
        oo = _rmsnorm(oo, subln) * (1.0 - lam_init)
        return oo.reshape(oo.shape[0], oo.shape[1], D_MODEL) @ w_o

    out_l = finish(o_l)
    out_c = finish(_diff_attend(q_c, k_c, v_c, lam)) if ctx_out else None
    return out_l, out_c


def _fourier_mixer(h, w_f, b_f):
    bsz, n, _ = h.shape
    hg = h.astype(jnp.float32).reshape(bsz, n, FOURIER_GROUPS, FOURIER_CH)
    f = jnp.fft.fft2(hg, axes=(1, 3), norm='ortho').real
    return f.reshape(bsz, n, D_MODEL).astype(h.dtype) @ w_f + b_f


def setup_inputs(seed: int = 0) -> dict:
    key = jax.random.key(seed)
    ks = jax.random.split(key, 32)
    f32 = jnp.float32
    D = D_MODEL
    G, P, H = S5_GROUPS, S5_STATE, S5_GROUP
    nA, nB, nC = N_S5_LAYERS, N_DIFF_LAYERS, N_FOURIER_LAYERS

    def nrm(k, shape, std):
        return std * jax.random.normal(k, shape, f32)

    n_idx = jnp.arange(P, dtype=f32)
    return {
        'x': nrm(ks[0], (BATCH, SEQ, D), 1.0),
        'c': nrm(ks[1], (BATCH, D), 1.0),
        'ctx': nrm(ks[2], (BATCH, CTX_LEN, D), 1.0),
        'c_ctx': nrm(ks[3], (D,), 1.0),
        'w_mod': nrm(ks[4], (DEPTH, D, N_MOD * D), 0.5 * D ** -0.5),
        'b_mod': nrm(ks[5], (DEPTH, N_MOD * D), 0.02),
        'norm_g': 1.0 + nrm(ks[6], (DEPTH, 2, D), 0.02),
        'mlp_w1': nrm(ks[7], (DEPTH, D, D_FF), D ** -0.5),
        'mlp_w2': nrm(ks[8], (DEPTH, D_FF, D), D_FF ** -0.5),
        's5_lambda_re': -0.5 + nrm(ks[9], (nA, 2, G, P), 0.01),
        's5_lambda_im': math.pi * n_idx + nrm(ks[10], (nA, 2, G, P), 0.01),
        's5_log_dt': jax.random.uniform(ks[11], (nA, 2, G), f32, math.log(S5_DT_MIN), math.log(S5_DT_MAX)),
        's5_b_re': nrm(ks[12], (nA, 2, G, P, H), (2.0 * H) ** -0.5),
        's5_b_im': nrm(ks[13], (nA, 2, G, P, H), (2.0 * H) ** -0.5),
        's5_c_re': nrm(ks[14], (nA, 2, G, H, P), (2.0 * P) ** -0.5),
        's5_c_im': nrm(ks[15], (nA, 2, G, H, P), (2.0 * P) ** -0.5),
        's5_d': nrm(ks[16], (nA, D), 1.0),
        's5_w_glu': nrm(ks[17], (nA, D, 2 * D), D ** -0.5),
        'diff_w_qkv': nrm(ks[18], (nB, D, 3 * D), D ** -0.5),
        'diff_q_norm': 1.0 + nrm(ks[19], (nB, DIFF_HEAD_DIM), 0.02),
        'diff_k_norm': 1.0 + nrm(ks[20], (nB, DIFF_HEAD_DIM), 0.02),
        'diff_lambda': nrm(ks[21], (nB, 4, DIFF_HEAD_DIM), 0.1),
        'diff_subln': 1.0 + nrm(ks[22], (nB, DIFF_V_DIM), 0.02),
        'diff_w_o': nrm(ks[23], (nB, D, D), D ** -0.5),
        'fourier_w': nrm(ks[24], (nC, D, D), D ** -0.5),
        'fourier_b': nrm(ks[25], (nC, D), 0.02),
    }


def reference(x, c, ctx, c_ctx, w_mod, b_mod, norm_g, mlp_w1, mlp_w2,
              s5_lambda_re, s5_lambda_im, s5_log_dt, s5_b_re, s5_b_im, s5_c_re, s5_c_im,
              s5_d, s5_w_glu, diff_w_qkv, diff_q_norm, diff_k_norm, diff_lambda, diff_subln,
              diff_w_o, fourier_w, fourier_b):
    n_lat = x.shape[1]
    rope = _axial_rope_tables(n_lat)
    cond_lat = jax.nn.silu(c)
    cond_ctx = jax.nn.silu(c_ctx)
    for i in range(DEPTH):
        last = i == DEPTH - 1
        mod_l = (cond_lat @ w_mod[i] + b_mod[i]).reshape(-1, N_MOD, 1, D_MODEL)
        mod_c = (cond_ctx @ w_mod[i] + b_mod[i]).reshape(N_MOD, D_MODEL)
        h_l = _modulate(_rmsnorm(x, norm_g[i, 0]), mod_l[:, 0], mod_l[:, 1])
        h_c = _modulate(_rmsnorm(ctx, norm_g[i, 0]), mod_c[0], mod_c[1])
        kind = i % N_MIXERS
        j = i // N_MIXERS
        if kind == 0:
            o_l, o_c = _s5_mixer(h_l, h_c, s5_lambda_re[j], s5_lambda_im[j], s5_log_dt[j],
                                 s5_b_re[j], s5_b_im[j], s5_c_re[j], s5_c_im[j], s5_d[j],
                                 s5_w_glu[j], not last)
        elif kind == 1:
            lam_init = 0.8 - 0.6 * math.exp(-0.3 * i)
            o_l, o_c = _diff_mixer(h_l, h_c, rope, diff_w_qkv[j], diff_q_norm[j], diff_k_norm[j],
                                   diff_lambda[j], diff_subln[j], diff_w_o[j], lam_init, not last)
        else:
            o_l = _fourier_mixer(h_l, fourier_w[j], fourier_b[j])
            o_c = None if last else _fourier_mixer(h_c, fourier_w[j], fourier_b[j])
        x = x + mod_l[:, 2] * o_l
        x = x + mod_l[:, 5] * _sqrelu_mlp(
            _modulate(_rmsnorm(x, norm_g[i, 1]), mod_l[:, 3], mod_l[:, 4]), mlp_w1[i], mlp_w2[i])
        if not last:
            ctx = ctx + mod_c[2] * o_c
            ctx = ctx + mod_c[5] * _sqrelu_mlp(
                _modulate(_rmsnorm(ctx, norm_g[i, 1]), mod_c[3], mod_c[4]), mlp_w1[i], mlp_w2[i])
    return x
```

```cpp
#include <hip/hip_runtime.h>
#include <hip/hip_cooperative_groups.h>
#include <cstdio>
#include <cstdint>
namespace cg = cooperative_groups;

#define LAS __attribute__((address_space(3)))
typedef unsigned short bf16_t;
typedef short bf16x8 __attribute__((ext_vector_type(8)));
typedef float f32x2 __attribute__((ext_vector_type(2)));
typedef float f32x4 __attribute__((ext_vector_type(4)));
typedef float f32x16 __attribute__((ext_vector_type(16)));
typedef unsigned u32x2 __attribute__((ext_vector_type(2)));
typedef unsigned u32x4 __attribute__((ext_vector_type(4)));
typedef __bf16 bf16x2_t __attribute__((ext_vector_type(2)));

__device__ __forceinline__ unsigned pk2(float lo, float hi) { f32x2 v = {lo, hi}; bf16x2_t b = __builtin_convertvector(v, bf16x2_t); return __builtin_bit_cast(unsigned, b); }
__device__ __forceinline__ float bflo(unsigned w) { return __uint_as_float(w << 16); }
__device__ __forceinline__ float bfhi(unsigned w) { return __uint_as_float(w & 0xffff0000u); }
__device__ __forceinline__ float shx(float v, int lane, int m) { return __int_as_float(__builtin_amdgcn_ds_bpermute((lane ^ m) << 2, __float_as_int(v))); }
__device__ __forceinline__ float wave_sum(float v, int lane) {
#pragma unroll
    for (int o = 1; o < 64; o <<= 1) v += shx(v, lane, o);
    return v;
}
__device__ __forceinline__ float xhalf_max(float v) { auto rr = __builtin_amdgcn_permlane32_swap(__float_as_uint(v), __float_as_uint(v), false, false); return fmaxf(__uint_as_float(rr[0]), __uint_as_float(rr[1])); }
__device__ __forceinline__ float xhalf_sum(float v) { auto rr = __builtin_amdgcn_permlane32_swap(__float_as_uint(v), __float_as_uint(v), false, false); return __uint_as_float(rr[0]) + __uint_as_float(rr[1]); }
__device__ __forceinline__ int fresh_tid(int wave0) { int l; asm volatile("v_mbcnt_lo_u32_b32 %0, -1, 0\n\tv_mbcnt_hi_u32_b32 %0, -1, %0" : "=v"(l)); return wave0 * 64 + l; }
#define LAUNDER_V(x) asm volatile("" : "+v"(x))
__device__ __forceinline__ float max3f(float a, float b, float c) { float r; asm("v_max3_f32 %0, %1, %2, %3" : "=v"(r) : "v"(a), "v"(b), "v"(c)); return r; }
__device__ __forceinline__ float sigmoidf_(float x) { return 1.0f / (1.0f + __expf(-x)); }
__device__ __forceinline__ float gelu_tanh(float x) { const float u = 0.7978845608028654f * (x + 0.044715f * x * x * x); return x * sigmoidf_(2.0f * u); }

constexpr int D = 1024, TL = 32768, TC = 2048, TA = TL + TC, DFF = 4096, NMOD = 6;
constexpr int NCH = 1088;
constexpr int UGP = 768;
constexpr float EPS = 1e-6f;
constexpr float LAM_INIT = 0.35550906759f;
constexpr float QSCALE = 0.125f * 1.4426950408889634f;
#ifndef REP_MASK
#define REP_MASK 0
#endif
#define NREP(bit) ((REP_MASK >> (bit)) & 1 ? 2 : 1)
#ifndef ATT_THR
#define ATT_THR 16.0f
#endif

constexpr size_t MiB = 1u << 20;
constexpr size_t WS_W1T = 0, WS_W2T = 32 * MiB, WS_GLUT = 64 * MiB, WS_QKVT = 72 * MiB, WS_WOT = 78 * MiB, WS_FWT = 80 * MiB;
constexpr size_t WS_ZERO = 474 * MiB, WS_CTL = 475 * MiB, CTL_BYTES = 16384;
constexpr size_t WS_PART = 476 * MiB;
constexpr int KSPLIT = 8;
constexpr size_t WS_MOD = 82 * MiB, WS_KTAB = 83 * MiB, WS_XCTX = 91 * MiB, WS_HN = 99 * MiB, WS_H = 202 * MiB, WS_END = 474 * MiB;
constexpr size_t WS_SLOC = WS_H, WS_W1S = WS_H + 68 * MiB, WS_W3S = WS_H + 84 * MiB, WS_Z = WS_H + 132 * MiB;
constexpr size_t WS_QK = WS_H, WS_VT = WS_H + 136 * MiB;
constexpr size_t WS_PQT = WS_H, WS_PQC = WS_H + 128 * MiB, WS_B2 = WS_H + 136 * MiB, WS_CS = WS_H + 264 * MiB, WS_CN256 = WS_H + 265 * MiB, WS_W1M = WS_H + 266 * MiB, WS_W2M = WS_H + 267 * MiB;

constexpr int LDS_BYTES = 147456;

struct Params {
    const float *x, *c, *ctx, *c_ctx, *w_mod, *b_mod, *norm_g, *mlp_w1, *mlp_w2;
    const float *s5_lre, *s5_lim, *s5_ldt, *s5_bre, *s5_bim, *s5_cre, *s5_cim, *s5_d, *s5_wglu;
    const float *wqkv, *qn, *kn, *dlam, *subln, *wo, *fw, *fb;
    float* out; unsigned char* ws;
    int ph_lo, ph_hi;
};

namespace pg8 {
constexpr int BM = 256, BK = 64, HALF = 128, HTB = HALF * BK * 2, STAGE_BYTES = 8 * HTB, NXCD = 8, WGM = 8;
__host__ __device__ __forceinline__ int lds_byte(int r, int c) { const int st = (r >> 4) * 2 + (c >> 5), rr = r & 15, cc = c & 31, ob = rr * 64 + cc * 2; return st * 1024 + (ob ^ (((ob >> 9) & 1) << 5)); }
__host__ __device__ __forceinline__ void stage_rc(int b, int& R, int& C) { const int st = b / 1024, sb = b % 1024, swz = sb ^ (((sb >> 9) & 1) << 5); R = (st >> 1) * 16 + swz / 64; C = (st & 1) * 32 + (swz % 64) / 2; }
__host__ __device__ __forceinline__ int perm32(int rho) { const int n = rho >> 4, i = rho & 15; return 8 * (i >> 2) + 4 * n + (i & 3); }

struct Unit { int pm, pn, pb; };
struct Gemm { const bf16_t* A; const bf16_t* Bt; int lda, ldb, K; size_t batchA, batchB; };
struct Sched {
    int nM, nN, nwg, G, c;
    int pm0;
    __device__ __forceinline__ void init(int nM_, int nN_, int nB_, int pm0_ = 0, int coff = 0) { nM = nM_; nN = nN_; nwg = nM_ * nN_ * nB_; G = gridDim.x; c = (blockIdx.x + coff) % gridDim.x; pm0 = pm0_; }
    __device__ __forceinline__ bool next(int i, Unit& u) const {
        const long L = (long)i * G + c; if (L >= nwg) return false;
        int wgid = (int)L; { const int q = nwg / NXCD, r = nwg % NXCD, xcd = wgid % NXCD, off = wgid / NXCD; wgid = (xcd < r ? xcd * (q + 1) : r * (q + 1) + (xcd - r) * q) + off; }
        const int upb = nM * nN; u.pb = wgid / upb; const int w = wgid - u.pb * upb;
        const int nig = WGM * nN, gid = w / nig, fm = gid * WGM, gsz = (nM - fm) < WGM ? (nM - fm) : WGM;
        u.pm = pm0 + fm + ((w % nig) % gsz); u.pn = (w % nig) / gsz; return true;
    }
};

template <class Epi>
__device__ __forceinline__ void gemm_phase(LAS unsigned char* lds, const Gemm g, const Sched& S, const Epi& E, int wave0) {
    const int tid = fresh_tid(wave0), wid = __builtin_amdgcn_readfirstlane(tid >> 6), lane = tid & 63, wr = wid >> 2, wc = wid & 3, fr = lane & 15, fq = lane >> 4;
    const int nt = g.K / BK;
    unsigned voffA[2], voffB[2];
#pragma unroll
    for (int i = 0; i < 2; ++i) { int R, C; stage_rc(tid * 16 + i * 8192, R, C); const int Rb = Epi::PERM ? ((R & ~31) + perm32(R & 31)) : R;
        voffA[i] = (unsigned)(R * g.lda + C) * 2u; voffB[i] = (unsigned)(Rb * g.ldb + C) * 2u; }
    const size_t kstep = (size_t)(BK * 2);
    const size_t hstepA = (size_t)HALF * g.lda * 2, hstepB = (size_t)HALF * g.ldb * 2;
    const unsigned ldsw = (unsigned)wid * 1024u;
    const int aoff = lds_byte(wr * 64 + fr, fq * 8), boff = lds_byte(wc * 32 + fr, fq * 8);
#define PG8_APTR(u) ((const char*)(g.A + (size_t)(u).pb * g.batchA + (size_t)(u).pm * BM * g.lda))
#define PG8_BPTR(u) ((const char*)(g.Bt + (size_t)(u).pb * g.batchB + (size_t)(u).pn * BM * g.ldb))
#define PG8_SA(b, h) (((b) * 2 + (h)) * HTB)
#define PG8_SB(b, h) ((4 + (b) * 2 + (h)) * HTB)
#define PG8_STAGE(bufoff, gbase, voff) do { const char* gb_ = (const char*)(gbase); asm volatile("" : "+s"(gb_)); _Pragma("unroll") for (int _i = 0; _i < 2; ++_i) \
        __builtin_amdgcn_global_load_lds((const unsigned*)(gb_ + (voff)[_i]), (LAS unsigned*)(lds + (bufoff) + ldsw + _i * 8192), 16, 0, 0); } while (0)
#define PG8_LDA(dst, b, h) do { _Pragma("unroll") for (int m = 0; m < 4; ++m) _Pragma("unroll") for (int k = 0; k < 2; ++k) dst[m][k] = *(const LAS bf16x8*)(lds + PG8_SA(b, h) + aoff + m * 2048 + k * 1024); } while (0)
#define PG8_LDB(dst, b, h) do { _Pragma("unroll") for (int n = 0; n < 2; ++n) _Pragma("unroll") for (int k = 0; k < 2; ++k) dst[n][k] = *(const LAS bf16x8*)(lds + PG8_SB(b, h) + boff + n * 2048 + k * 1024); } while (0)
#define PG8_MMA(ai, bj, At, Bt) do { __builtin_amdgcn_s_setprio(1); _Pragma("unroll") for (int m = 0; m < 4; ++m) _Pragma("unroll") for (int n = 0; n < 2; ++n) _Pragma("unroll") for (int k = 0; k < 2; ++k) \
        acc[ai][bj][m][n] = __builtin_amdgcn_mfma_f32_16x16x32_bf16(Bt[n][k], At[m][k], acc[ai][bj][m][n], 0, 0, 0); __builtin_amdgcn_s_setprio(0); } while (0)
#define PG8_WAIT_V(n) asm volatile("s_waitcnt vmcnt(" #n ")" ::: "memory")
#define PG8_WAIT_L(n) asm volatile("s_waitcnt lgkmcnt(" #n ")" ::: "memory")
#define PG8_BAR __builtin_amdgcn_s_barrier()
#define PG8_SCHED __builtin_amdgcn_sched_barrier(0)
    Unit cur, nxt; int ui = 0;
    if (!S.next(0, cur)) return;
    f32x4 acc[2][2][4][2];
#pragma unroll
    for (int a = 0; a < 2; ++a)
#pragma unroll
        for (int b = 0; b < 2; ++b)
#pragma unroll
            for (int m = 0; m < 4; ++m)
#pragma unroll
                for (int n = 0; n < 2; ++n) acc[a][b][m][n] = (f32x4){0.f, 0.f, 0.f, 0.f};
    bf16x8 At[4][2], B0[2][2], B1[2][2];
    const char* cA = PG8_APTR(cur); const char* cB = PG8_BPTR(cur);
    PG8_STAGE(PG8_SB(0, 0), cB, voffB); PG8_STAGE(PG8_SB(0, 1), cB + hstepB, voffB); PG8_STAGE(PG8_SA(0, 0), cA, voffA); PG8_STAGE(PG8_SA(0, 1), cA + hstepA, voffA);
    if (wr == 1) PG8_BAR;
    PG8_WAIT_V(2); PG8_BAR;
    PG8_STAGE(PG8_SB(1, 0), cB + kstep, voffB); PG8_STAGE(PG8_SA(1, 0), cA + kstep, voffA); PG8_STAGE(PG8_SB(1, 1), cB + hstepB + kstep, voffB);
    PG8_WAIT_V(6); PG8_BAR;
    for (;;) {
        const bool has_next = S.next(ui + 1, nxt);
        const char* nA = has_next ? PG8_APTR(nxt) : cA; const char* nB = has_next ? PG8_BPTR(nxt) : cB;
        for (int t = 0; t < nt; t += 2) {
            const bool last = (t == nt - 2);
            const char* a1 = cA + (size_t)(t + 1) * kstep;
            const char* a2 = last ? nA : cA + (size_t)(t + 2) * kstep; const char* b2 = last ? nB : cB + (size_t)(t + 2) * kstep;
            const char* a3 = a2 + kstep; const char* b3 = b2 + kstep;
            PG8_LDB(B0, 0, 0); PG8_LDB(B1, 0, 1); PG8_SCHED; PG8_LDA(At, 0, 0); PG8_STAGE(PG8_SA(1, 1), a1 + hstepA, voffA);
            PG8_WAIT_V(8); PG8_WAIT_L(0); PG8_BAR; PG8_MMA(0, 0, At, B0); PG8_MMA(0, 1, At, B1); PG8_BAR; PG8_SCHED;
            PG8_LDA(At, 0, 1); PG8_STAGE(PG8_SB(0, 0), b2, voffB); PG8_STAGE(PG8_SB(0, 1), b2 + hstepB, voffB); PG8_STAGE(PG8_SA(0, 0), a2, voffA);
            PG8_WAIT_V(8); PG8_WAIT_L(0); PG8_BAR; PG8_MMA(1, 0, At, B0); PG8_MMA(1, 1, At, B1); PG8_BAR; PG8_SCHED;
            PG8_LDB(B0, 1, 0); PG8_LDB(B1, 1, 1); PG8_SCHED; PG8_LDA(At, 1, 0); PG8_STAGE(PG8_SA(0, 1), a2 + hstepA, voffA);
            PG8_WAIT_V(8); PG8_WAIT_L(0); PG8_BAR; PG8_MMA(0, 0, At, B0); PG8_MMA(0, 1, At, B1); PG8_BAR; PG8_SCHED;
            PG8_LDA(At, 1, 1); PG8_STAGE(PG8_SB(1, 0), b3, voffB); PG8_STAGE(PG8_SB(1, 1), b3 + hstepB, voffB); PG8_STAGE(PG8_SA(1, 0), a3, voffA);
            PG8_WAIT_V(8); PG8_WAIT_L(0); PG8_BAR; PG8_MMA(1, 0, At, B0); PG8_MMA(1, 1, At, B1); PG8_BAR; PG8_SCHED;
        }
        if (wr == 0) PG8_BAR;
        { int l2_; asm volatile("v_mbcnt_lo_u32_b32 %0, -1, 0\n\tv_mbcnt_hi_u32_b32 %0, -1, %0" : "=v"(l2_)); E(acc, cur, wr, wc, l2_ & 15, l2_ >> 4); }
        if (!has_next) break;
#pragma unroll
        for (int a = 0; a < 2; ++a)
#pragma unroll
            for (int b = 0; b < 2; ++b)
#pragma unroll
                for (int m = 0; m < 4; ++m)
#pragma unroll
                    for (int n = 0; n < 2; ++n) acc[a][b][m][n] = (f32x4){0.f, 0.f, 0.f, 0.f};
        cur = nxt; cA = nA; cB = nB; ++ui;
        if (wr == 1) PG8_BAR;
    }
    PG8_WAIT_V(0);
    PG8_BAR;
#undef PG8_APTR
#undef PG8_BPTR
#undef PG8_SA
#undef PG8_SB
#undef PG8_STAGE
#undef PG8_LDA
#undef PG8_LDB
#undef PG8_MMA
#undef PG8_WAIT_V
#undef PG8_WAIT_L
#undef PG8_BAR
#undef PG8_SCHED
}

typedef f32x4 Acc[2][2][4][2];

template <int ACT  > struct EpiStore {
    static constexpr bool PERM = true;
    bf16_t* O; size_t ldc, bstride;
    __device__ __forceinline__ void operator()(const Acc& acc, const Unit& u, int wr, int wc, int fr, int fq) const {
        LAUNDER_V(fr); LAUNDER_V(fq);
        const int row0 = u.pm * BM + wr * 64 + fr, col0 = u.pn * BM + wc * 32 + 8 * fq;
        bf16_t* base = O + (size_t)u.pb * bstride;
#pragma unroll
        for (int ai = 0; ai < 2; ++ai)
#pragma unroll
            for (int m = 0; m < 4; ++m) { bf16_t* rowp = base + (size_t)(row0 + ai * HALF + m * 16) * ldc + col0;
#pragma unroll
                for (int bj = 0; bj < 2; ++bj) { f32x4 v0 = acc[ai][bj][m][0], v1 = acc[ai][bj][m][1];
                    if (ACT == 1) {
#pragma unroll
                        for (int e = 0; e < 4; ++e) { float a = fmaxf(v0[e], 0.f), b = fmaxf(v1[e], 0.f); v0[e] = a * a; v1[e] = b * b; } }
                    u32x4 w; w.x = pk2(v0[0], v0[1]); w.y = pk2(v0[2], v0[3]); w.z = pk2(v1[0], v1[1]); w.w = pk2(v1[2], v1[3]);
                    *(u32x4*)(rowp + bj * HALF) = w; } }
    }
};

struct EpiResid {
    static constexpr bool PERM = false;
    const float* base_lat; const float* base_ctx; float* out_lat; float* out_ctx; const float* gate; const float* bias;
    __device__ __forceinline__ void operator()(const Acc& acc, const Unit& u, int wr, int wc, int fr, int fq) const {
        LAUNDER_V(fr); LAUNDER_V(fq);
        const float* bp; float* op; int rbase, mi;
        if (u.pm < 128) { bp = base_lat; op = out_lat; rbase = u.pm * BM; mi = u.pm >> 4; } else { bp = base_ctx; op = out_ctx; rbase = (u.pm - 128) * BM; mi = 8; }
        const int col0 = u.pn * BM + wc * 32 + 4 * fq;
        f32x4 gv[2][2], bv[2][2];
#pragma unroll
        for (int bj = 0; bj < 2; ++bj)
#pragma unroll
            for (int n = 0; n < 2; ++n) { gv[bj][n] = *(const f32x4*)(gate + mi * (NMOD * D) + col0 + bj * HALF + n * 16);
                bv[bj][n] = bias ? *(const f32x4*)(bias + col0 + bj * HALF + n * 16) : (f32x4){0.f, 0.f, 0.f, 0.f}; }
#pragma unroll
        for (int ai = 0; ai < 2; ++ai)
#pragma unroll
            for (int m = 0; m < 4; ++m) { const size_t off = (size_t)(rbase + ai * HALF + wr * 64 + m * 16 + fr) * D + col0;
#pragma unroll
                for (int bj = 0; bj < 2; ++bj)
#pragma unroll
                    for (int n = 0; n < 2; ++n) { const f32x4 xv = *(const f32x4*)(bp + off + bj * HALF + n * 16);
                        *(f32x4*)(op + off + bj * HALF + n * 16) = xv + gv[bj][n] * (acc[ai][bj][m][n] + bv[bj][n]); } }
    }
};

struct EpiQK {
    static constexpr bool PERM = false;
    bf16_t* QKo; const float* qn; const float* kn;
    __device__ __forceinline__ void operator()(const Acc& acc, const Unit& u, int wr, int wc, int fr, int fq) const {
        LAUNDER_V(fr); LAUNDER_V(fq);
        const int lane = fq * 16 + fr, hc = u.pn * 4 + wc; const bool isq = hc < 16;
        const float* nwp = (isq ? qn : kn) + 4 * fq;
        f32x4 nw[2][2];
#pragma unroll
        for (int bj = 0; bj < 2; ++bj)
#pragma unroll
            for (int n = 0; n < 2; ++n) nw[bj][n] = *(const f32x4*)(nwp + 32 * bj + 16 * n);
        float invf[4];
#pragma unroll
        for (int i = 0; i < 4; ++i) invf[i] = __builtin_amdgcn_exp2f(-(float)(4 * fq + i) * 0.8304820237218406f) * 0.15915494309189535f;
        const float qs = isq ? QSCALE : 1.f;
#pragma unroll
        for (int ai = 0; ai < 2; ++ai)
#pragma unroll
            for (int m = 0; m < 4; ++m) { const int row = u.pm * BM + ai * HALF + wr * 64 + m * 16 + fr;
                float ss = 0.f;
#pragma unroll
                for (int bj = 0; bj < 2; ++bj)
#pragma unroll
                    for (int n = 0; n < 2; ++n) { const f32x4 a = acc[ai][bj][m][n]; ss += (a[0] * a[0] + a[1] * a[1]) + (a[2] * a[2] + a[3] * a[3]); }
                ss += shx(ss, lane, 16); ss += shx(ss, lane, 32);
                const float rstd = rsqrtf(ss * (1.f / 64.f) + EPS) ;
                const int l = row & 4095; const float posr = (float)(l >> 6), posc = (float)(l & 63);
                bf16_t* op = QKo + (size_t)row * 2048 + hc * 64 + 4 * fq;
#pragma unroll
                for (int bj = 0; bj < 2; ++bj) { f32x4 x1 = acc[ai][bj][m][0] * rstd * nw[bj][0], x2 = acc[ai][bj][m][1] * rstd * nw[bj][1];
                    if (row < TL) { const float pos = bj ? posc : posr;
#pragma unroll
                        for (int i = 0; i < 4; ++i) { const float rev = pos * invf[i]; const float cs = __builtin_amdgcn_cosf(rev), sn = __builtin_amdgcn_sinf(rev);
                            const float a = x1[i], b = x2[i]; x1[i] = a * cs - b * sn; x2[i] = a * sn + b * cs; } }
                    x1 *= qs; x2 *= qs;
                    *(u32x2*)(op + 32 * bj) = (u32x2){pk2(x1[0], x1[1]), pk2(x1[2], x1[3])};
                    *(u32x2*)(op + 32 * bj + 16) = (u32x2){pk2(x2[0], x2[1]), pk2(x2[2], x2[3])}; } }
    }
};

struct EpiPart {
    static constexpr bool PERM = false;
    bf16_t* P;
    __device__ __forceinline__ void operator()(const Acc& acc, const Unit& u, int wr, int wc, int fr, int fq) const {
        LAUNDER_V(fr); LAUNDER_V(fq);
        const int col0 = u.pn * BM + wc * 32 + 4 * fq;
#pragma unroll
        for (int ai = 0; ai < 2; ++ai)
#pragma unroll
            for (int m = 0; m < 4; ++m) { bf16_t* rp = P + ((size_t)u.pb * TC + (u.pm - 128) * BM + ai * HALF + wr * 64 + m * 16 + fr) * D + col0;
#pragma unroll
                for (int bj = 0; bj < 2; ++bj)
#pragma unroll
                    for (int n = 0; n < 2; ++n) { const f32x4 v = acc[ai][bj][m][n]; *(u32x2*)(rp + bj * HALF + n * 16) = (u32x2){pk2(v[0], v[1]), pk2(v[2], v[3])}; } }
    }
};

struct EpiGlu {
    static constexpr bool PERM = false;
    const float* base_lat; const float* base_ctx; float* out_lat; float* out_ctx; const float* gate;
    __device__ __forceinline__ void operator()(const Acc& acc, const Unit& u, int wr, int wc, int fr, int fq) const {
        LAUNDER_V(fr); LAUNDER_V(fq);
        const float* bp; float* op; int rbase, mi;
        if (u.pm < 128) { bp = base_lat; op = out_lat; rbase = u.pm * BM; mi = u.pm >> 4; } else { bp = base_ctx; op = out_ctx; rbase = (u.pm - 128) * BM; mi = 8; }
        const int col0 = u.pn * HALF + wc * 32 + 4 * fq;
        f32x4 gv[2];
#pragma unroll
        for (int n = 0; n < 2; ++n) gv[n] = *(const f32x4*)(gate + mi * (NMOD * D) + col0 + n * 16);
#pragma unroll
        for (int ai = 0; ai < 2; ++ai)
#pragma unroll
            for (int m = 0; m < 4; ++m) { const size_t off = (size_t)(rbase + ai * HALF + wr * 64 + m * 16 + fr) * D + col0;
#pragma unroll
                for (int n = 0; n < 2; ++n) { const f32x4 xv = *(const f32x4*)(bp + off + n * 16); const f32x4 v = acc[ai][0][m][n], gt = acc[ai][1][m][n]; f32x4 o;
#pragma unroll
                    for (int e = 0; e < 4; ++e) o[e] = xv[e] + gv[n][e] * v[e] * sigmoidf_(gt[e]);
                    *(f32x4*)(op + off + n * 16) = o; } }
    }
};

struct EpiSloc {
    static constexpr bool PERM = false;
    float* S;
    __device__ __forceinline__ void operator()(const Acc& acc, const Unit& u, int wr, int wc, int fr, int fq) const {
        LAUNDER_V(fr); LAUNDER_V(fq);
        const int col0 = wc * 32 + 4 * fq;
#pragma unroll
        for (int ai = 0; ai < 2; ++ai)
#pragma unroll
            for (int m = 0; m < 4; ++m) { const int ci = u.pm * BM + ai * HALF + wr * 64 + m * 16 + fr;
                if (ci < NCH) { float* rp = S + ((size_t)u.pb * NCH + ci) * 256 + col0;
#pragma unroll
                    for (int bj = 0; bj < 2; ++bj)
#pragma unroll
                        for (int n = 0; n < 2; ++n) *(f32x4*)(rp + bj * HALF + n * 16) = acc[ai][bj][m][n]; } }
    }
};

struct EpiZ {
    static constexpr bool PERM = false;
    bf16_t* Z;
    __device__ __forceinline__ void operator()(const Acc& acc, const Unit& u, int wr, int wc, int fr, int fq) const {
        LAUNDER_V(fr); LAUNDER_V(fq);
#pragma unroll
        for (int ai = 0; ai < 2; ++ai)
#pragma unroll
            for (int m = 0; m < 4; ++m) { const int ci = u.pm * BM + ai * HALF + wr * 64 + m * 16 + fr;
                if (ci < NCH) { const int b = ci / 136, cc = ci - b * 136; const int tok0 = cc < 8 ? TL + b * 256 + cc * 32 : b * 4096 + (cc - 8) * 32;
#pragma unroll
                    for (int bj = 0; bj < 2; ++bj)
#pragma unroll
                        for (int n = 0; n < 2; ++n) { const int t = 16 * u.pn + 8 * bj + 2 * wc + n; const f32x4 v = acc[ai][bj][m][n];
                            u32x2 w; w.x = pk2(gelu_tanh(v[0]), gelu_tanh(v[1])); w.y = pk2(gelu_tanh(v[2]), gelu_tanh(v[3]));
                            *(u32x2*)(Z + (size_t)(tok0 + t) * D + u.pb * 16 + 4 * fq) = w; } } }
    }
};

struct EpiChanDft {
    static constexpr bool PERM = true;
    bf16_t* PQ1; bf16_t* PQC;
    __device__ __forceinline__ void operator()(const Acc& acc, const Unit& u, int wr, int wc, int fr, int fq) const {
        LAUNDER_V(fr); LAUNDER_V(fq);
        if (u.pn < 128) {
            const int b = u.pn >> 4;
#pragma unroll
            for (int ai = 0; ai < 2; ++ai)
#pragma unroll
                for (int m = 0; m < 4; ++m) { const int kc = ai * HALF + wr * 64 + m * 16 + fr;
                    bf16_t* rowp = PQ1 + (size_t)(b * 1024 + u.pb * 256 + kc) * 8192 + u.pm * 64;
#pragma unroll
                    for (int bj = 0; bj < 2; ++bj) { const int tp = (u.pn & 15) * 256 + bj * HALF + wc * 32 + 8 * fq;
                        const f32x4 v0 = acc[ai][bj][m][0], v1 = acc[ai][bj][m][1];
                        u32x4 w; w.x = pk2(v0[0], v0[1]); w.y = pk2(v0[2], v0[3]); w.z = pk2(v1[0], v1[1]); w.w = pk2(v1[2], v1[3]);
                        *(u32x4*)(rowp + (tp >> 6) * 128 + (tp & 63)) = w; } }
        } else {
            const int b = u.pn - 128;
            bf16_t* base = PQC + (size_t)(b * 1024 + u.pb * 256) * 512 + (size_t)u.pm * 256 + wc * 32 + 8 * fq;
#pragma unroll
            for (int ai = 0; ai < 2; ++ai)
#pragma unroll
                for (int m = 0; m < 4; ++m) { bf16_t* rowp = base + (size_t)(ai * HALF + wr * 64 + m * 16 + fr) * 512;
#pragma unroll
                    for (int bj = 0; bj < 2; ++bj) { const f32x4 v0 = acc[ai][bj][m][0], v1 = acc[ai][bj][m][1];
                        u32x4 w; w.x = pk2(v0[0], v0[1]); w.y = pk2(v0[2], v0[3]); w.z = pk2(v1[0], v1[1]); w.w = pk2(v1[2], v1[3]);
                        *(u32x4*)(rowp + bj * HALF) = w; } }
        }
    }
};

struct EpiFft1 {
    static constexpr bool PERM = true;
    bf16_t* B2;
    __device__ __forceinline__ void operator()(const Acc& acc, const Unit& u, int wr, int wc, int fr, int fq) const {
        LAUNDER_V(fr); LAUNDER_V(fq);
        if (wr != 0) return;
#pragma unroll
        for (int m = 0; m < 4; ++m) { const int m2 = 16 * m + fr;
#pragma unroll
            for (int bj = 0; bj < 2; ++bj) { const int n0 = u.pn * BM + bj * HALF + wc * 32 + 8 * fq; const int k2 = n0 & 63, c = (n0 >> 6) & 1023, b = n0 >> 16;
                float br[8], bi[8];
#pragma unroll
                for (int e = 0; e < 8; ++e) { const float ar = acc[0][bj][m][e >> 2][e & 3], ai_ = acc[1][bj][m][e >> 2][e & 3];
                    const float rev = (float)(m2 * (k2 + e)) * (1.f / 4096.f); const float cs = __builtin_amdgcn_cosf(rev), sn = __builtin_amdgcn_sinf(rev);
                    br[e] = (ar * cs + ai_ * sn) * (1.f / 64.f); bi[e] = (ai_ * cs - ar * sn) * (1.f / 64.f); }
                bf16_t* op = B2 + ((size_t)(b * 64 + m2) * 1024 + c) * 128 + k2;
                *(u32x4*)(op) = (u32x4){pk2(br[0], br[1]), pk2(br[2], br[3]), pk2(br[4], br[5]), pk2(br[6], br[7])};
                *(u32x4*)(op + 64) = (u32x4){pk2(bi[0], bi[1]), pk2(bi[2], bi[3]), pk2(bi[4], bi[5]), pk2(bi[6], bi[7])}; } }
    }
};

struct EpiFft2 {
    static constexpr bool PERM = true;
    bf16_t* F;
    __device__ __forceinline__ void operator()(const Acc& acc, const Unit& u, int wr, int wc, int fr, int fq) const {
        LAUNDER_V(fr); LAUNDER_V(fq);
        if (wr != 0) return;
#pragma unroll
        for (int m = 0; m < 4; ++m) { const int m1 = 16 * m + fr;
#pragma unroll
            for (int bj = 0; bj < 2; ++bj) { const int n0 = u.pn * BM + bj * HALF + wc * 32 + 8 * fq; const int c = n0 & 1023, m2 = (n0 >> 10) & 63, b = n0 >> 16;
                const f32x4 v0 = acc[0][bj][m][0], v1 = acc[0][bj][m][1];
                *(u32x4*)(F + (size_t)(b * 4096 + 64 * m1 + m2) * D + c) = (u32x4){pk2(v0[0], v0[1]), pk2(v0[2], v0[3]), pk2(v1[0], v1[1]), pk2(v1[2], v1[3])}; } }
    }
};
}

__device__ __forceinline__ void transpose_item(const float* W, int K, int N, bf16_t* WT, int glu, LAS float* scr, int item, int lane) {
    const int nblk = N / 32, kb = item / nblk, nb = item % nblk, k0 = 64 * kb, n0 = 32 * nb;
#pragma unroll 8
    for (int i = 0; i < 32; ++i) { const int kk = 2 * i + (lane >> 5); scr[kk * 33 + (lane & 31)] = W[(size_t)(k0 + kk) * N + n0 + (lane & 31)]; }
    asm volatile("s_waitcnt lgkmcnt(0)" ::: "memory");
    const int n0p = glu == 1 ? (((n0 & 1023) >> 7) * 256 + (n0 >> 10) * 128 + (n0 & 127))
                  : (glu == 2 && n0 < 2048) ? ((n0 & ~255) | (((n0 >> 5) & 1) << 7) | (((n0 >> 6) & 3) << 5)) : n0;
    const int c = lane & 7;
#pragma unroll
    for (int j = 0; j < 4; ++j) { const int n = (lane >> 3) + 8 * j; const LAS float* s = scr + (8 * c) * 33 + n;
        u32x4 o; o.x = pk2(s[0 * 33], s[1 * 33]); o.y = pk2(s[2 * 33], s[3 * 33]); o.z = pk2(s[4 * 33], s[5 * 33]); o.w = pk2(s[6 * 33], s[7 * 33]);
        *(u32x4*)(WT + (size_t)(n0p + n) * K + k0 + 8 * c) = o; }
    asm volatile("s_waitcnt lgkmcnt(0)" ::: "memory");
}

__device__ __forceinline__ const float* xrow_ptr(const float* xl, const float* xc, int row) { return row < TL ? xl + (size_t)row * D : xc + (size_t)(row - TL) * D; }

struct CtxFix { const bf16_t* part; const float* pgate; const float* pbias; float* xw; };
__device__ __forceinline__ void norm_rows_tok(const float* xl, const float* xc, const float* g, const float* modl  , int sidx, bf16_t* out, int nrows, int gw, int ngw, int lane, bool perm64, const CtxFix fx) {
    for (int row = gw; row < nrows; row += ngw) {
        const f32x4* xr = (const f32x4*)xrow_ptr(xl, xc, row) + lane;
        f32x4 v[4]; float ss = 0.f;
#pragma unroll
        for (int j = 0; j < 4; ++j) v[j] = xr[64 * j];
        if (fx.part && row >= TL) {
#pragma unroll
            for (int j = 0; j < 4; ++j) { const int c = 4 * lane + 256 * j; f32x4 s = fx.pbias ? *(const f32x4*)(fx.pbias + c) : (f32x4){0.f, 0.f, 0.f, 0.f};
#pragma unroll
                for (int k = 0; k < KSPLIT; ++k) { const u32x2 w = *(const u32x2*)(fx.part + ((size_t)k * TC + (row - TL)) * D + c); s += (f32x4){bflo(w.x), bfhi(w.x), bflo(w.y), bfhi(w.y)}; }
                v[j] += *(const f32x4*)(fx.pgate + c) * s;
                *(f32x4*)(fx.xw + (size_t)(row - TL) * D + c) = v[j]; } }
#pragma unroll
        for (int j = 0; j < 4; ++j) ss += (v[j].x * v[j].x + v[j].y * v[j].y) + (v[j].z * v[j].z + v[j].w * v[j].w);
        const float rstd = rsqrtf(wave_sum(ss, lane) * (1.f / D) + EPS);
        const int mi = row < TL ? row >> 12 : 8;
        const float* sh = modl + mi * (NMOD * D) + sidx * D; const float* sc = sh + D;
        const int orow = (perm64 && row < TL) ? ((row & ~4095) | ((row & 63) << 6) | ((row & 4095) >> 6)) : row;
        unsigned long long* o8 = (unsigned long long*)(out + (size_t)orow * D) + lane;
#pragma unroll
        for (int j = 0; j < 4; ++j) { const int c = 4 * lane + 256 * j; const f32x4 gg = *(const f32x4*)(g + c), s1 = *(const f32x4*)(sc + c), s0 = *(const f32x4*)(sh + c);
            f32x4 y;
#pragma unroll
            for (int e = 0; e < 4; ++e) y[e] = v[j][e] * rstd * gg[e] * (1.f + s1[e]) + s0[e];
            o8[64 * j] = (unsigned long long)pk2(y[0], y[1]) | ((unsigned long long)pk2(y[2], y[3]) << 32); }
    }
}
__device__ __forceinline__ void norm_rows_s5(const float* xl, const float* xc, const float* g, const float* modl, bf16_t* ug, int gw, int ngw, int lane, const CtxFix fx) {
    for (int row = gw; row < TA; row += ngw) {
        const f32x4* xr = (const f32x4*)xrow_ptr(xl, xc, row) + 4 * lane;
        f32x4 v[4]; float ss = 0.f;
#pragma unroll
        for (int j = 0; j < 4; ++j) v[j] = xr[j];
        if (fx.part && row >= TL) {
#pragma unroll
            for (int j = 0; j < 4; ++j) { const int c = 16 * lane + 4 * j; f32x4 s = fx.pbias ? *(const f32x4*)(fx.pbias + c) : (f32x4){0.f, 0.f, 0.f, 0.f};
#pragma unroll
                for (int k = 0; k < KSPLIT; ++k) { const u32x2 w = *(const u32x2*)(fx.part + ((size_t)k * TC + (row - TL)) * D + c); s += (f32x4){bflo(w.x), bfhi(w.x), bflo(w.y), bfhi(w.y)}; }
                v[j] += *(const f32x4*)(fx.pgate + c) * s;
                *(f32x4*)(fx.xw + (size_t)(row - TL) * D + c) = v[j]; } }
#pragma unroll
        for (int j = 0; j < 4; ++j) ss += (v[j].x * v[j].x + v[j].y * v[j].y) + (v[j].z * v[j].z + v[j].w * v[j].w);
        const float rstd = rsqrtf(wave_sum(ss, lane) * (1.f / D) + EPS);
        int mi, b, pos; if (row < TL) { b = row >> 12; pos = 256 + (row & 4095); mi = b; } else { b = (row - TL) >> 8; pos = (row - TL) & 255; mi = 8; }
        const float* sh = modl + mi * (NMOD * D); const float* sc = sh + D;
        const int chunk = b * 136 + (pos >> 5), s = pos & 31;
        unsigned w[8];
#pragma unroll
        for (int j = 0; j < 4; ++j) { const int c = 16 * lane + 4 * j; const f32x4 gg = *(const f32x4*)(g + c), s1 = *(const f32x4*)(sc + c), s0 = *(const f32x4*)(sh + c);
            f32x4 y;
#pragma unroll
            for (int e = 0; e < 4; ++e) y[e] = v[j][e] * rstd * gg[e] * (1.f + s1[e]) + s0[e];
            w[2 * j] = pk2(y[0], y[1]); w[2 * j + 1] = pk2(y[2], y[3]); }
        u32x4* op = (u32x4*)(ug + ((size_t)lane * NCH + chunk) * UGP + s * 16);
        op[0] = (u32x4){w[0], w[1], w[2], w[3]}; op[1] = (u32x4){w[4], w[5], w[6], w[7]};
    }
}

__device__ __forceinline__ void cpow(float lr_dt, float li_dt, float k, float& re, float& im) {
    const float mag = __expf(k * lr_dt); const float rev = k * li_dt * 0.15915494309189535f;
    re = mag * __builtin_amdgcn_cosf(rev); im = mag * __builtin_amdgcn_sinf(rev);
}
__device__ __forceinline__ void s5_kcoef(float lr, float li, float dt, float& kr, float& ki) {
    const float th = li * dt; const float rv = th * 0.15915494309189535f;
    const float c = __builtin_amdgcn_cosf(rv), s = __builtin_amdgcn_sinf(rv), sh = __builtin_amdgcn_sinf(0.5f * rv);
    const float em1 = expm1f(lr * dt);
    const float nre = em1 * c - 2.f * sh * sh, nim = (em1 + 1.f) * s;
    const float den = lr * lr + li * li;
    kr = (nre * lr + nim * li) / den; ki = (nim * lr - nre * li) / den;
}


#define XB_TMO      128
#define XB_XCNT(j)  (256  + 64 * (j))
#define XB_XSUB(j)  (1280 + 64 * (j))
#define XB_XGEN(j)  (2304 + 64 * (j))
#define XB_TOP      3328
#define XB_TOPGEN   3392
#define XCD_BAR_WORDS 3456
#define XB_SPIN_CAP (1u << 18)
__device__ __forceinline__ unsigned xb_ld(unsigned* p)              { return __hip_atomic_load(p, __ATOMIC_RELAXED, __HIP_MEMORY_SCOPE_AGENT); }
__device__ __forceinline__ unsigned xb_add(unsigned* p, unsigned v) { return __hip_atomic_fetch_add(p, v, __ATOMIC_RELAXED, __HIP_MEMORY_SCOPE_AGENT); }
__device__ __forceinline__ unsigned xb_xcc_id() { return (unsigned)__builtin_amdgcn_s_getreg((3 << 11) | 20) & 0xFu; }
#define XB_SPIN(cond, bar) do { unsigned _sp = 0; while (cond) { __builtin_amdgcn_s_sleep(1); \
    if ((++_sp & 255u) == 0u) { if (xb_ld(&(bar)[XB_TMO])) break; if (_sp > XB_SPIN_CAP) { atomicAdd(&(bar)[XB_TMO], 1u); break; } } } } while (0)
struct XcdBarrier { unsigned* bar; unsigned x; volatile LAS unsigned* st; };
__device__ __forceinline__ XcdBarrier xcd_barrier_post(unsigned* bar, volatile LAS unsigned* st) {
    XcdBarrier b; b.bar = bar; b.x = xb_xcc_id(); b.st = st;
    if (threadIdx.x == 0) (void)xb_add(&bar[XB_XCNT(b.x)], 1u);
    return b;
}
__device__ __forceinline__ void xcd_barrier_complete(unsigned* bar, unsigned x, unsigned& nloc, unsigned& nx) {
    const unsigned G = gridDim.x * gridDim.y * gridDim.z;
    unsigned sum, cnt, mine, sp = 0u;
    for (;;) {
        sum = 0u; cnt = 0u; mine = 0u;
#pragma unroll
        for (unsigned j = 0; j < 16; ++j) { const unsigned c = xb_ld(&bar[XB_XCNT(j)]); sum += c; cnt += (c > 0u) ? 1u : 0u; mine = (j == x) ? c : mine; }
        if (sum == G) break;
        __builtin_amdgcn_s_sleep(1);
        if ((++sp & 255u) == 0u) { if (xb_ld(&bar[XB_TMO])) break; if (sp > XB_SPIN_CAP) { atomicAdd(&bar[XB_TMO], 1u); break; } }
    }
    nloc = mine > 0u ? mine : 1u; nx = cnt > 0u ? cnt : 1u;
}
__device__ __forceinline__ void xcd_barrier(const XcdBarrier& b) {
    asm volatile("s_waitcnt vmcnt(0)" ::: "memory");
    __syncthreads();
    if (threadIdx.x == 0) {
        unsigned* bar = b.bar;
        __builtin_amdgcn_s_waitcnt(0);
        unsigned nloc = b.st[0], nx = b.st[1];
        if (nloc == 0u) { xcd_barrier_complete(bar, b.x, nloc, nx); b.st[0] = nloc; b.st[1] = nx; }
        const unsigned old = xb_add(&bar[XB_XSUB(b.x)], 1u);
        const unsigned gen = old / nloc;
        if (old + 1u == (gen + 1u) * nloc) {
            __builtin_amdgcn_fence(__ATOMIC_RELEASE, "agent");
            asm volatile("s_waitcnt vmcnt(0)" ::: "memory");
            const unsigned og = xb_add(&bar[XB_TOP], 1u);
            const unsigned tg = og / nx;
            if (og + 1u == (tg + 1u) * nx) xb_add(&bar[XB_TOPGEN], 1u);
            else XB_SPIN(xb_ld(&bar[XB_TOPGEN]) == tg, bar);
            __builtin_amdgcn_fence(__ATOMIC_ACQUIRE, "agent");
            xb_add(&bar[XB_XGEN(b.x)], 1u);
            asm volatile("s_waitcnt vmcnt(0)" ::: "memory");
        } else {
            XB_SPIN(xb_ld(&bar[XB_XGEN(b.x)]) == gen, bar);
            __builtin_amdgcn_fence(__ATOMIC_ACQUIRE, "agent");
            asm volatile("s_waitcnt vmcnt(0)" ::: "memory");
        }
    }
    __syncthreads();
}

__global__ void __launch_bounds__(512) mega_fwd(Params p) {
    extern __shared__ __attribute__((aligned(16))) unsigned char lds_raw[];
    LAS unsigned char* lds = (LAS unsigned char*)lds_raw;
    cg::grid_group grid = cg::this_grid();
    const int G = gridDim.x, bid = blockIdx.x, NGW = G * 8;
    const int wave0 = __builtin_amdgcn_readfirstlane(threadIdx.x >> 6);
#define FRESH_IDS const int tid = fresh_tid(wave0), lane = tid & 63, wave = __builtin_amdgcn_readfirstlane(tid >> 6), gw = bid * 8 + wave; (void)lane; (void)gw
    unsigned char* ws = p.ws;
    bf16_t* W1T = (bf16_t*)(ws + WS_W1T); bf16_t* W2T = (bf16_t*)(ws + WS_W2T); bf16_t* GLUT = (bf16_t*)(ws + WS_GLUT);
    bf16_t* QKVT = (bf16_t*)(ws + WS_QKVT); bf16_t* WOT = (bf16_t*)(ws + WS_WOT); bf16_t* FWT = (bf16_t*)(ws + WS_FWT);
    float* MOD = (float*)(ws + WS_MOD); float* KTAB = (float*)(ws + WS_KTAB); float* XCTX = (float*)(ws + WS_XCTX);
    bf16_t* HN = (bf16_t*)(ws + WS_HN); bf16_t* HB = (bf16_t*)(ws + WS_H);
    int ph = 0;
#define PH_ON (ph >= p.ph_lo && ph < p.ph_hi)
    volatile LAS unsigned* bst = (volatile LAS unsigned*)(lds + LDS_BYTES - 64);
    if (threadIdx.x < 2) bst[threadIdx.x] = 0u;
    __syncthreads();
    const XcdBarrier xbar = xcd_barrier_post((unsigned*)(ws + WS_CTL), bst);
#define PH_END do { if (ph >= p.ph_lo && ph + 1 < p.ph_hi) { for (int r_ = 0; r_ < NREP(8); ++r_) { if (ph == 0) grid.sync(); else xcd_barrier(xbar); } } ++ph; } while (0)

    if (PH_ON) {
        FRESH_IDS;
        {
            LAS float* scr = (LAS float*)(lds + wave * 16384);
            constexpr int I_W1 = 16 * 128, I_W2 = 64 * 32, I_GLU = 16 * 64, I_QKV = 16 * 96, I_SQ = 16 * 32;
            constexpr int NIT = 4 * (I_W1 + I_W2) + 2 * I_GLU + I_QKV + 2 * I_SQ;
            for (int it = gw; it < NIT; it += NGW) {
                int r = it;
                if (r < 4 * I_W1) { const int l = r / I_W1; transpose_item(p.mlp_w1 + (size_t)l * D * DFF, D, DFF, W1T + (size_t)l * D * DFF, 0, scr, r % I_W1, lane); continue; } r -= 4 * I_W1;
                if (r < 4 * I_W2) { const int l = r / I_W2; transpose_item(p.mlp_w2 + (size_t)l * D * DFF, DFF, D, W2T + (size_t)l * D * DFF, 0, scr, r % I_W2, lane); continue; } r -= 4 * I_W2;
                if (r < 2 * I_GLU) { const int l = r / I_GLU; transpose_item(p.s5_wglu + (size_t)l * D * 2 * D, D, 2 * D, GLUT + (size_t)l * D * 2 * D, 1, scr, r % I_GLU, lane); continue; } r -= 2 * I_GLU;
                if (r < I_QKV) { transpose_item(p.wqkv, D, 3 * D, QKVT, 2, scr, r, lane); continue; } r -= I_QKV;
                if (r < I_SQ) { transpose_item(p.wo, D, D, WOT, 0, scr, r, lane); continue; } r -= I_SQ;
                transpose_item(p.fw, D, D, FWT, 0, scr, r, lane);
            }
        }
        if (REP_MASK) { for (int e = bid * 512 + tid; e < 9 * NMOD * D; e += G * 512) ((float*)(ws + WS_ZERO))[e] = 0.f; }
        __syncthreads();
        {
            LAS float* sc = (LAS float*)lds;
            LAS float* red = (LAS float*)(lds + 9 * 4096);
            for (int e = tid; e < 9 * D; e += 512) { const float v = e < 8 * D ? p.c[e] : p.c_ctx[e - 8 * D]; sc[e] = v * sigmoidf_(v); }
            __syncthreads();
            const int col = tid & 63, kp = tid >> 6;
            for (int item = bid; item < 4 * 96; item += G) {
                const int i = item / 96, nb = item % 96;
                float a[9];
#pragma unroll
                for (int r = 0; r < 9; ++r) a[r] = 0.f;
                const float* wp = p.w_mod + ((size_t)i * D + kp * 128) * (NMOD * D) + nb * 64 + col;
#pragma unroll 8
                for (int k = 0; k < 128; ++k) { const float w = wp[(size_t)k * (NMOD * D)];
#pragma unroll
                    for (int r = 0; r < 9; ++r) a[r] += sc[r * D + kp * 128 + k] * w; }
#pragma unroll
                for (int r = 0; r < 9; ++r) red[(kp * 64 + col) * 9 + r] = a[r];
                __syncthreads();
                for (int e = tid; e < 576; e += 512) { const int r = e >> 6, cc = e & 63; float s = p.b_mod[i * (NMOD * D) + nb * 64 + cc];
#pragma unroll
                    for (int q = 0; q < 8; ++q) s += red[(q * 64 + cc) * 9 + r];
                    MOD[((size_t)i * 9 + r) * (NMOD * D) + nb * 64 + cc] = s; }
                __syncthreads();
            }
        }
        {
            LAS float* Bb = (LAS float*)lds;
            LAS float* Cc = (LAS float*)(lds + 8192);
            LAS float* ap = (LAS float*)(lds + 16384);
            for (int item = bid; item < 256; item += G) {
                const int j = item >> 7, g = (item >> 1) & 63, dir = item & 1;
                const int pg = (j * 2 + dir) * 64 + g;
                const float dt = __expf(p.s5_ldt[pg]);
                __syncthreads();
                for (int e = tid; e < 1024; e += 512) { const int pp = e >> 4, h = e & 15; float kr, ki; s5_kcoef(p.s5_lre[pg * 64 + pp], p.s5_lim[pg * 64 + pp], dt, kr, ki);
                    const float br = p.s5_bre[((size_t)pg * 64 + pp) * 16 + h], bi = p.s5_bim[((size_t)pg * 64 + pp) * 16 + h];
                    Bb[e * 2] = kr * br - ki * bi; Bb[e * 2 + 1] = kr * bi + ki * br;
                    const int h2 = e >> 6, p2 = e & 63; Cc[e * 2] = p.s5_cre[((size_t)pg * 16 + h2) * 64 + p2]; Cc[e * 2 + 1] = p.s5_cim[((size_t)pg * 16 + h2) * 64 + p2]; }
                for (int e = tid; e < 2048; e += 512) { const int tau = e >> 6, pp = e & 63; float re, im; cpow(p.s5_lre[pg * 64 + pp] * dt, p.s5_lim[pg * 64 + pp] * dt, (float)tau, re, im); ap[e * 2] = re; ap[e * 2 + 1] = im; }
                __syncthreads();
                const int hh = tid & 255, h = hh >> 4, hp = hh & 15, th = tid >> 8;
                float a[16];
#pragma unroll
                for (int q = 0; q < 16; ++q) a[q] = 0.f;
                for (int pp = 0; pp < 64; ++pp) { const float cr = Cc[(h * 64 + pp) * 2], ci = Cc[(h * 64 + pp) * 2 + 1], br = Bb[(pp * 16 + hp) * 2], bi = Bb[(pp * 16 + hp) * 2 + 1];
                    const float cbr = cr * br - ci * bi, cbi = cr * bi + ci * br;
#pragma unroll
                    for (int q = 0; q < 16; ++q) { const float ar = ap[((th * 16 + q) * 64 + pp) * 2], ai = ap[((th * 16 + q) * 64 + pp) * 2 + 1]; a[q] += cbr * ar - cbi * ai; } }
#pragma unroll
                for (int q = 0; q < 16; ++q) KTAB[((((size_t)j * 64 + g) * 2 + dir) * 32 + th * 16 + q) * 256 + hh] = a[q];
            }
            __syncthreads();
        }
    }
    PH_END;

    for (int li = 0; li < 4; ++li) {
        const int kind = li % 3, jj = li / 3; const bool last = (li == 3);
        const float* xl = li == 0 ? p.x : p.out; const float* xc = li == 0 ? p.ctx : XCTX;
        const float* modl = MOD + (size_t)li * 9 * (NMOD * D);
        const float* ng = p.norm_g + (size_t)li * 2 * D;
        bf16_t* PART = (bf16_t*)(ws + WS_PART);
        const CtxFix fxA{li > 0 ? PART : nullptr, MOD + ((size_t)(li - 1) * 9 + 8) * (NMOD * D) + 5 * D, nullptr, XCTX};
        const CtxFix fxF{(kind != 0 && !last) ? PART : nullptr, modl + 8 * (NMOD * D) + 2 * D, kind == 2 ? p.fb : nullptr, XCTX};

        if (PH_ON) {
            FRESH_IDS;
            if (kind == 0) {
                for (int rep = 0; rep < NREP(3); ++rep) norm_rows_s5(xl, xc, ng, modl, HN, gw, NGW, lane, fxA);
                bf16_t* W1S = (bf16_t*)(ws + WS_W1S); bf16_t* W3S = (bf16_t*)(ws + WS_W3S);
                LAS float* apf = (LAS float*)lds;
                LAS float* apb = (LAS float*)(lds + 16896);
                LAS float* Cf = (LAS float*)(lds + 33792);
                LAS float* Cb = (LAS float*)(lds + 41984);
                LAS float* Bbf = (LAS float*)(lds + 50176);
                LAS float* Bbb = (LAS float*)(lds + 58368);
                for (int item = bid; item < 256; item += G) {
                    const int g = item >> 2, tq = item & 3;
                    __syncthreads();
                    for (int e = tid; e < 2 * 33 * 64; e += 512) { const int dir = e / (33 * 64), r = e % (33 * 64), k = r >> 6, pp = r & 63; const int pg = (jj * 2 + dir) * 64 + g;
                        const float dt = __expf(p.s5_ldt[pg]); float re, im; cpow(p.s5_lre[pg * 64 + pp] * dt, p.s5_lim[pg * 64 + pp] * dt, (float)k, re, im);
                        LAS float* d = dir ? apb : apf; d[r * 2] = re; d[r * 2 + 1] = im; }
                    for (int e = tid; e < 2048; e += 512) { const int dir = e >> 10, r = e & 1023; const int pg = (jj * 2 + dir) * 64 + g;
                        { const int h2 = r >> 6, p2 = r & 63; LAS float* d = dir ? Cb : Cf; d[r * 2] = p.s5_cre[((size_t)pg * 16 + h2) * 64 + p2]; d[r * 2 + 1] = p.s5_cim[((size_t)pg * 16 + h2) * 64 + p2]; }
                        { const int pp = r >> 4, h = r & 15; const float dt = __expf(p.s5_ldt[pg]); float kr, ki; s5_kcoef(p.s5_lre[pg * 64 + pp], p.s5_lim[pg * 64 + pp], dt, kr, ki);
                          const float br = p.s5_bre[((size_t)pg * 64 + pp) * 16 + h], bi = p.s5_bim[((size_t)pg * 64 + pp) * 16 + h];
                          LAS float* d = dir ? Bbb : Bbf; d[r * 2] = kr * br - ki * bi; d[r * 2 + 1] = kr * bi + ki * br; } }
                    __syncthreads();
                    for (int e = tid; e < 4096; e += 512) { const int ee = tq * 4096 + e; const int hh = ee & 1, s = (ee >> 1) & 31, pp = (ee >> 6) & 63, ri = (ee >> 12) & 1, dir = ee >> 13;
                        const int ex = dir ? s : 31 - s; const LAS float* apd = dir ? apb : apf; const LAS float* bd = dir ? Bbb : Bbf;
                        const float ar = apd[(ex * 64 + pp) * 2], ai = apd[(ex * 64 + pp) * 2 + 1];
                        float v[8];
#pragma unroll
                        for (int i = 0; i < 8; ++i) { const float br = bd[(pp * 16 + hh * 8 + i) * 2], bi = bd[(pp * 16 + hh * 8 + i) * 2 + 1]; v[i] = ri ? ar * bi + ai * br : ar * br - ai * bi; }
                        *(u32x4*)(W1S + ((size_t)(g * 256 + dir * 128 + ri * 64 + pp)) * 512 + s * 16 + hh * 8) = (u32x4){pk2(v[0], v[1]), pk2(v[2], v[3]), pk2(v[4], v[5]), pk2(v[6], v[7])}; }
                    const float* ktf = KTAB + (((size_t)jj * 64 + g) * 2 + 0) * 32 * 256; const float* ktb = ktf + 32 * 256;
                    for (int e = tid; e < 128 * 96; e += 512) { const int kc = e % 96, rowi = e / 96, t = tq * 8 + (rowi >> 4), h = rowi & 15;
                        float v[8];
                        if (kc < 64) { const int s = kc >> 1, h0 = (kc & 1) * 8;
#pragma unroll
                            for (int i = 0; i < 8; ++i) v[i] = 0.f;
                            if (s <= t) { const f32x4* kp = (const f32x4*)(ktf + (t - s) * 256 + h * 16 + h0); const f32x4 a = kp[0], b = kp[1];
#pragma unroll
                                for (int i = 0; i < 4; ++i) { v[i] += a[i]; v[4 + i] += b[i]; } }
                            if (s >= t) { const f32x4* kp = (const f32x4*)(ktb + (s - t) * 256 + h * 16 + h0); const f32x4 a = kp[0], b = kp[1];
#pragma unroll
                                for (int i = 0; i < 4; ++i) { v[i] += a[i]; v[4 + i] += b[i]; } }
                            if (s == t) { const float dd = p.s5_d[jj * D + g * 16 + h];
#pragma unroll
                                for (int i = 0; i < 8; ++i) if (h0 + i == h) v[i] += dd; }
                        } else { const int q = kc - 64, dir = q >> 4, ri = (q >> 3) & 1, p0 = (q & 7) * 8; const int ex = dir ? 32 - t : t + 1;
                            const LAS float* apd = dir ? apb : apf; const LAS float* cd = dir ? Cb : Cf;
#pragma unroll
                            for (int i = 0; i < 8; ++i) { const int pp = p0 + i; const float ar = apd[(ex * 64 + pp) * 2], ai = apd[(ex * 64 + pp) * 2 + 1], cr = cd[(h * 64 + pp) * 2], ci = cd[(h * 64 + pp) * 2 + 1];
                                v[i] = ri ? -(cr * ai + ci * ar) : cr * ar - ci * ai; } }
                        *(u32x4*)(W3S + ((size_t)(g * 512 + t * 16 + h)) * UGP + kc * 8) = (u32x4){pk2(v[0], v[1]), pk2(v[2], v[3]), pk2(v[4], v[5]), pk2(v[6], v[7])}; }
                }
                __syncthreads();
            } else {
                for (int rep = 0; rep < NREP(3); ++rep) norm_rows_tok(xl, xc, ng, modl, 0, HN, TA, gw, NGW, lane, kind == 2, fxA);
                if (kind == 2) {
                    bf16_t* CS = (bf16_t*)(ws + WS_CS); bf16_t* CN2 = (bf16_t*)(ws + WS_CN256); bf16_t* W1M = (bf16_t*)(ws + WS_W1M); bf16_t* W2M = (bf16_t*)(ws + WS_W2M);
                    const int gt = bid * 512 + tid, NT = G * 512;
                    for (int e = gt; e < 2 * 256 * 16; e += NT) { const int which = e >> 12, r = (e >> 4) & 255, kc = e & 15, k0 = (kc & 7) * 8, hs = kc >> 3; float v[8];
#pragma unroll
                        for (int i = 0; i < 8; ++i) { const int mm = r & 63; const float rev = (float)((mm * (k0 + i)) & 63) * (1.f / 64.f); const float cs = __builtin_amdgcn_cosf(rev), sn = __builtin_amdgcn_sinf(rev);
                            float val = 0.f;
                            if (which == 0) { if (r < 64) val = hs ? -sn : cs; else if (r >= 128 && r < 192) val = hs ? -cs : -sn; }
                            else { if (r < 64) val = hs ? sn : cs; }
                            v[i] = val; }
                        *(u32x4*)((which ? W2M : W1M) + (size_t)r * 128 + kc * 8) = (u32x4){pk2(v[0], v[1]), pk2(v[2], v[3]), pk2(v[4], v[5]), pk2(v[6], v[7])}; }
                    for (int e = gt; e < 512 * 32; e += NT) { const int m = e >> 5, kc = m & 255, isS = m >> 8, k0 = (e & 31) * 8; float v[8];
#pragma unroll
                        for (int i = 0; i < 8; ++i) { const float rev = (float)((kc * (k0 + i)) & 255) * (1.f / 256.f); v[i] = (isS ? __builtin_amdgcn_sinf(rev) : __builtin_amdgcn_cosf(rev)) * (1.f / 16.f); }
                        *(u32x4*)(CS + (size_t)m * 256 + k0) = (u32x4){pk2(v[0], v[1]), pk2(v[2], v[3]), pk2(v[4], v[5]), pk2(v[6], v[7])}; }
                    for (int e = gt; e < 256 * 64; e += NT) { const int m = e >> 6, kc = e & 63, k0 = (kc & 31) * 8, isS = kc >> 5; float v[8];
#pragma unroll
                        for (int i = 0; i < 8; ++i) { const float rev = (float)((m * (k0 + i)) & 255) * (1.f / 256.f); v[i] = (isS ? -__builtin_amdgcn_sinf(rev) : __builtin_amdgcn_cosf(rev)) * (1.f / 16.f); }
                        *(u32x4*)(CN2 + (size_t)m * 512 + kc * 8) = (u32x4){pk2(v[0], v[1]), pk2(v[2], v[3]), pk2(v[4], v[5]), pk2(v[6], v[7])}; }
                }
            }
        }
        PH_END;

        if (kind == 0) {
            if (PH_ON) {
                pg8::Gemm g{HN, (const bf16_t*)(ws + WS_W1S), UGP, 512, 512, (size_t)NCH * UGP, (size_t)256 * 512};
                pg8::Sched S; S.init(5, 1, 64);
                pg8::EpiSloc E{(float*)(ws + WS_SLOC)};
                pg8::gemm_phase(lds, g, S, E, wave0);
            }
            PH_END;
            if (PH_ON) {
                FRESH_IDS;
                const float* SL = (const float*)(ws + WS_SLOC);
                for (int id = bid * 512 + tid; id < 8 * 64 * 2 * 64; id += G * 512) {
                    const int pp = id & 63, dir = (id >> 6) & 1, g = (id >> 7) & 63, b = id >> 13;
                    const int pg = (jj * 2 + dir) * 64 + g; const float dt = __expf(p.s5_ldt[pg]);
                    float ar, ai; cpow(p.s5_lre[pg * 64 + pp] * dt, p.s5_lim[pg * 64 + pp] * dt, 32.f, ar, ai);
                    float sr = 0.f, si = 0.f;
                    const size_t rb = (size_t)g * NCH + b * 136;
                    for (int k0 = 0; k0 < 136; k0 += 8) {
                        float lr[8], lim[8];
#pragma unroll
                        for (int q = 0; q < 8; ++q) { const int k = k0 + q; const int cc = dir == 0 ? k : (k < 8 ? 7 - k : 143 - k);
                            lr[q] = SL[(rb + cc) * 256 + dir * 128 + pp]; lim[q] = SL[(rb + cc) * 256 + dir * 128 + 64 + pp]; }
#pragma unroll
                        for (int q = 0; q < 8; ++q) { const int k = k0 + q; const int cc = dir == 0 ? k : (k < 8 ? 7 - k : 143 - k);
                            bf16_t* o = HN + (rb + cc) * UGP + 512 + dir * 128 + pp;
                            o[0] = (bf16_t)(pk2(sr, 0.f) & 0xffffu); o[64] = (bf16_t)(pk2(si, 0.f) & 0xffffu);
                            const float nr = ar * sr - ai * si + lr[q], ni = ar * si + ai * sr + lim[q]; sr = nr; si = ni; }
                    }
                }
            }
            PH_END;
            if (PH_ON) {
                pg8::Gemm g{HN, (const bf16_t*)(ws + WS_W3S), UGP, UGP, UGP, (size_t)NCH * UGP, (size_t)512 * UGP};
                pg8::Sched S; S.init(5, 2, 64);
                pg8::EpiZ E{(bf16_t*)(ws + WS_Z)};
                pg8::gemm_phase(lds, g, S, E, wave0);
            }
            PH_END;
            if (PH_ON) {
                pg8::Gemm g{(const bf16_t*)(ws + WS_Z), GLUT + (size_t)jj * D * 2 * D, D, D, D, 0, 0};
                pg8::Sched S; S.init(last ? 128 : 136, 8, 1);
                pg8::EpiGlu E{xl, xc, p.out, XCTX, modl + 2 * D};
                pg8::gemm_phase(lds, g, S, E, wave0);
            }
            PH_END;
        } else if (kind == 1) {
            bf16_t* QK = (bf16_t*)(ws + WS_QK); bf16_t* VT = (bf16_t*)(ws + WS_VT);
            if (PH_ON) {
                { pg8::Gemm g{HN, QKVT, D, D, D, 0, 0}; pg8::Sched S; S.init(136, 8, 1); pg8::EpiQK E{QK, p.qn, p.kn}; pg8::gemm_phase(lds, g, S, E, wave0); }
                { pg8::Gemm g{QKVT + (size_t)2048 * D, HN, D, D, D, 0, 0}; pg8::Sched S; S.init(4, 136, 1, 0, 128); pg8::EpiStore<0> E{VT, (size_t)TA, 0}; pg8::gemm_phase(lds, g, S, E, wave0); }
            }
            PH_END;
            if (PH_ON) {
                FRESH_IDS;
                const int l31 = lane & 31, hi = lane >> 5, comp = wave >> 2, wq = wave & 3;
                float lamv; { const float a = wave_sum(p.dlam[lane] * p.dlam[64 + lane], lane), b = wave_sum(p.dlam[128 + lane] * p.dlam[192 + lane], lane); lamv = __expf(a) - __expf(b) + LAM_INIT; }
                const int vcu = (G % 8 == 0) ? (bid % 8) * (G / 8) + bid / 8 : bid;
                constexpr int KROW = 144, KTILE = 64 * KROW, VTILE = 128 * KROW, VRING = 4 * KTILE;
                const int kr = tid >> 3, kch = tid & 7;
                const int kst = kr * KROW + kch * 16, vst = kr * KROW + ((kch >> 1) * 32 + (kch & 1) * 8);
                for (int rep = 0; rep < NREP(2); ++rep)
                for (int u = vcu; u < 2176; u += G) {
                    int b, head, qrow0, j0;
                    if (u < 2048) { b = u >> 8; head = (u >> 5) & 7; qrow0 = b * 4096 + (u & 31) * 128; j0 = 0; }
                    else { const int v = u - 2048; b = v >> 4; head = (v >> 1) & 7; qrow0 = TL + b * 256 + (v & 1) * 128; j0 = 64; }
                    bf16x8 qf[4];
                    { const bf16_t* qp = QK + (size_t)(qrow0 + wq * 32 + l31) * 2048 + head * 128 + comp * 64 + hi * 8;
#pragma unroll
                      for (int ds = 0; ds < 4; ++ds) qf[ds] = *(const bf16x8*)(qp + ds * 16); }
                    const bf16_t* kbase = QK + (size_t)kr * 2048 + 1024 + head * 128 + kch * 8;
                    const bf16_t* vbase = VT + (size_t)(head * 128 + kr) * TA + kch * 8;
                    u32x4 pk0, pk1, pv0, pv1;
#define ATT_TOKBASE(j) ((j) < 64 ? b * 4096 + 64 * (j) : TL + b * 256 + 64 * ((j) - 64))
#define ATT_LOADK(j) do { const bf16_t* kp_ = kbase + (size_t)ATT_TOKBASE(j) * 2048; pk0 = *(const u32x4*)kp_; pk1 = *(const u32x4*)(kp_ + 64); } while (0)
#define ATT_LOADV(j) do { const bf16_t* vp_ = vbase + ATT_TOKBASE(j); pv0 = *(const u32x4*)vp_; pv1 = *(const u32x4*)(vp_ + (size_t)64 * TA); } while (0)
#define ATT_STOREK(sl) do { LAS unsigned char* bb_ = lds + (sl) * (2 * KTILE) + kst; *(LAS u32x4*)(bb_) = pk0; *(LAS u32x4*)(bb_ + KTILE) = pk1; } while (0)
#define ATT_STOREV(sl) do { LAS unsigned char* vb_ = lds + VRING + (sl) * VTILE + vst; \
                        *(LAS u32x2*)(vb_) = (u32x2){pv0.x, pv0.y}; *(LAS u32x2*)(vb_ + 16) = (u32x2){pv0.z, pv0.w}; \
                        *(LAS u32x2*)(vb_ + 64 * KROW) = (u32x2){pv1.x, pv1.y}; *(LAS u32x2*)(vb_ + 64 * KROW + 16) = (u32x2){pv1.z, pv1.w}; } while (0)
#define ATT_QK(S0, S1, sl, CI) do { const LAS unsigned char* kb_ = lds + (sl) * (2 * KTILE) + comp * KTILE + l31 * KROW + hi * 16; bf16x8 kf_[8]; \
                        _Pragma("unroll") for (int ds = 0; ds < 4; ++ds) { kf_[2 * ds] = *(const LAS bf16x8*)(kb_ + ds * 32); kf_[2 * ds + 1] = *(const LAS bf16x8*)(kb_ + 32 * KROW + ds * 32); } \
                        __builtin_amdgcn_sched_barrier(0); \
                        _Pragma("unroll") for (int ds = 0; ds < 4; ++ds) { \
                            S0 = __builtin_amdgcn_mfma_f32_32x32x16_bf16(kf_[2 * ds], qf[ds], ds == 0 ? CI : S0, 0, 0, 0); S1 = __builtin_amdgcn_mfma_f32_32x32x16_bf16(kf_[2 * ds + 1], qf[ds], ds == 0 ? CI : S1, 0, 0, 0); } } while (0)
#define ATT_PV(sl) do { const LAS unsigned char* vb_ = lds + VRING + (sl) * VTILE + l31 * KROW + hi * 16; \
                        _Pragma("unroll") for (int ks = 0; ks < 4; ++ks) _Pragma("unroll") for (int dt = 0; dt < 4; ++dt) { const bf16x8 a_ = *(const LAS bf16x8*)(vb_ + dt * 32 * KROW + ks * 32); \
                            o[dt] = __builtin_amdgcn_mfma_f32_32x32x16_bf16(a_, pp[ks], o[dt], 0, 0, 0); } } while (0)
#define ATT_SOFT(S0, S1, PD) do { f32x2 ls_ = {0.f, 0.f}; \
                        _Pragma("unroll") for (int r = 0; r < 16; ++r) { S0[r] = __builtin_amdgcn_exp2f(S0[r]); S1[r] = __builtin_amdgcn_exp2f(S1[r]); } \
                        _Pragma("unroll") for (int r = 0; r < 16; r += 2) { ls_ += (f32x2){S0[r], S0[r + 1]}; ls_ += (f32x2){S1[r], S1[r + 1]}; } \
                        l_run += ls_.x + ls_.y; \
                        { u32x4 w_; \
                          w_ = (u32x4){pk2(S0[0], S0[1]), pk2(S0[2], S0[3]), pk2(S0[4], S0[5]), pk2(S0[6], S0[7])}; PD[0] = __builtin_bit_cast(bf16x8, w_); \
                          w_ = (u32x4){pk2(S0[8], S0[9]), pk2(S0[10], S0[11]), pk2(S0[12], S0[13]), pk2(S0[14], S0[15])}; PD[1] = __builtin_bit_cast(bf16x8, w_); \
                          w_ = (u32x4){pk2(S1[0], S1[1]), pk2(S1[2], S1[3]), pk2(S1[4], S1[5]), pk2(S1[6], S1[7])}; PD[2] = __builtin_bit_cast(bf16x8, w_); \
                          w_ = (u32x4){pk2(S1[8], S1[9]), pk2(S1[10], S1[11]), pk2(S1[12], S1[13]), pk2(S1[14], S1[15])}; PD[3] = __builtin_bit_cast(bf16x8, w_); } } while (0)
                    f32x16 o[4];
#pragma unroll
                    for (int dt = 0; dt < 4; ++dt)
#pragma unroll
                        for (int r = 0; r < 16; ++r) o[dt][r] = 0.f;
                    float m_ref, l_run = 0.f;
                    f32x16 negm, zero16;
#pragma unroll
                    for (int r = 0; r < 16; ++r) zero16[r] = 0.f;
                    bf16x8 pp[4];
                    __syncthreads();
                    ATT_LOADK(j0); ATT_STOREK(j0 & 1);
                    __syncthreads();
                    {
                        ATT_LOADK(j0 + 1); ATT_LOADV(j0);
                        f32x16 s0, s1;
                        ATT_QK(s0, s1, j0 & 1, zero16);
                        float mx = fmaxf(s0[0], s1[0]);
#pragma unroll
                        for (int r = 1; r < 16; ++r) mx = fmaxf(mx, fmaxf(s0[r], s1[r]));
                        m_ref = xhalf_max(mx);
#pragma unroll
                        for (int r = 0; r < 16; ++r) { s0[r] -= m_ref; s1[r] -= m_ref; negm[r] = -m_ref; }
                        ATT_SOFT(s0, s1, pp);
                        ATT_STOREK((j0 + 1) & 1); ATT_STOREV(j0 & 1);
                        __syncthreads();
                    }
                    for (int j = j0 + 1; j < 68; ++j) {
                        const int jn = j + 1 < 68 ? j + 1 : 67;
                        ATT_LOADK(jn); ATT_LOADV(j);
                        f32x16 s0, s1;
                        ATT_QK(s0, s1, j & 1, negm);
                        float mx = max3f(s0[0], s1[0], s0[1]), mx2 = max3f(s1[1], s0[2], s1[2]);
#pragma unroll
                        for (int r = 3; r < 15; r += 2) { mx = max3f(mx, s0[r], s1[r]); mx2 = max3f(mx2, s0[r + 1], s1[r + 1]); }
                        mx = max3f(mx, s0[15], s1[15]); mx = fmaxf(mx, mx2);
                        mx = xhalf_max(mx);
                        if (__builtin_expect(__any(mx > ATT_THR), 0)) {
                            const float dl = ceilf(fmaxf(mx, 0.f)), f = __builtin_amdgcn_exp2f(-dl);
                            m_ref += dl; l_run *= f;
#pragma unroll
                            for (int r = 0; r < 16; ++r) { s0[r] -= dl; s1[r] -= dl; negm[r] = -m_ref; }
#pragma unroll
                            for (int dt = 0; dt < 4; ++dt)
#pragma unroll
                                for (int r = 0; r < 16; ++r) o[dt][r] *= f;
#pragma unroll
                            for (int ks = 0; ks < 4; ++ks) { u32x4 w = __builtin_bit_cast(u32x4, pp[ks]);
                                w.x = pk2(bflo(w.x) * f, bfhi(w.x) * f); w.y = pk2(bflo(w.y) * f, bfhi(w.y) * f); w.z = pk2(bflo(w.z) * f, bfhi(w.z) * f); w.w = pk2(bflo(w.w) * f, bfhi(w.w) * f);
                                pp[ks] = __builtin_bit_cast(bf16x8, w); }
                        }
                        __builtin_amdgcn_sched_barrier(0);
                        unsigned pw[16]; f32x2 ls = {0.f, 0.f};
                        {
                            const LAS unsigned char* vb_ = lds + VRING + ((j - 1) & 1) * VTILE + l31 * KROW + hi * 16;
                            bf16x8 vf[16];
#define ATT_VRD(i) vf[i] = *(const LAS bf16x8*)(vb_ + ((i) & 3) * 32 * KROW + ((i) >> 2) * 32)
                            ATT_VRD(0); ATT_VRD(1);
#pragma unroll
                            for (int i = 0; i < 16; ++i) {
                                if (i + 2 < 16) ATT_VRD(i + 2);
                                o[i & 3] = __builtin_amdgcn_mfma_f32_32x32x16_bf16(vf[i], pp[i >> 2], o[i & 3], 0, 0, 0);
                                s0[i] = __builtin_amdgcn_exp2f(s0[i]); s1[i] = __builtin_amdgcn_exp2f(s1[i]);
                                if (i & 1) { pw[i >> 1] = pk2(s0[i - 1], s0[i]); pw[8 + (i >> 1)] = pk2(s1[i - 1], s1[i]); ls += (f32x2){s0[i - 1], s0[i]}; ls += (f32x2){s1[i - 1], s1[i]}; }
                                __builtin_amdgcn_sched_barrier(0);
                            }
#undef ATT_VRD
                        }
                        l_run += ls.x + ls.y;
#pragma unroll
                        for (int ks = 0; ks < 4; ++ks) { const u32x4 w = {pw[4 * ks], pw[4 * ks + 1], pw[4 * ks + 2], pw[4 * ks + 3]}; pp[ks] = __builtin_bit_cast(bf16x8, w); }
                        ATT_STOREK(jn & 1); ATT_STOREV(j & 1);
                        __syncthreads();
                    }
                    ATT_PV(67 & 1);
#undef ATT_TOKBASE
#undef ATT_LOADK
#undef ATT_LOADV
#undef ATT_STOREK
#undef ATT_STOREV
#undef ATT_QK
#undef ATT_PV
#undef ATT_SOFT
                    { const float lt = xhalf_sum(l_run); const float inv = 1.f / lt;
#pragma unroll
                      for (int dt = 0; dt < 4; ++dt)
#pragma unroll
                          for (int r = 0; r < 16; ++r) o[dt][r] *= inv; }
                    __syncthreads();
                    LAS float* ex = (LAS float*)lds + wq * 4096;
                    if (comp == 1) {
#pragma unroll
                        for (int dt = 0; dt < 4; ++dt)
#pragma unroll
                            for (int r = 0; r < 16; ++r) ex[(dt * 16 + r) * 64 + lane] = o[dt][r];
                    }
                    __syncthreads();
                    LAS bf16_t* stg = (LAS bf16_t*)(lds + 81920) + wq * (32 * 136);
                    if (comp == 0) {
                        float ss = 0.f;
#pragma unroll
                        for (int dt = 0; dt < 4; ++dt)
#pragma unroll
                            for (int r = 0; r < 16; ++r) { const float d = o[dt][r] - lamv * ex[(dt * 16 + r) * 64 + lane]; o[dt][r] = d; ss += d * d; }
                        ss = xhalf_sum(ss);
                        const float rstd = rsqrtf(ss * (1.f / 128.f) + EPS) * (1.f - LAM_INIT);
#pragma unroll
                        for (int dt = 0; dt < 4; ++dt)
#pragma unroll
                            for (int r = 0; r < 16; ++r) { const int dv = 32 * dt + (r & 3) + 8 * (r >> 2) + 4 * hi; stg[l31 * 136 + dv] = (bf16_t)(pk2(o[dt][r] * rstd * p.subln[dv], 0.f) & 0xffffu); }
                    }
                    __syncthreads();
                    if (comp == 0) {
#pragma unroll
                        for (int it = 0; it < 8; ++it) { const int row = it * 4 + (lane >> 4), ch = lane & 15;
                            const u32x4 w = *(const LAS u32x4*)(stg + row * 136 + ch * 8);
                            *(u32x4*)(HN + (size_t)(qrow0 + wq * 32 + row) * D + head * 128 + ch * 8) = w; }
                    }
                }
                __syncthreads();
            }
            PH_END;
        } else {
            if (PH_ON) {
                pg8::Gemm g{(const bf16_t*)(ws + WS_CS), HN, 256, D, 256, 0, 256};
                pg8::Sched S; S.init(2, 136, 4);
                pg8::EpiChanDft E{(bf16_t*)(ws + WS_PQT), (bf16_t*)(ws + WS_PQC)};
                pg8::gemm_phase(lds, g, S, E, wave0);
            }
            PH_END;
            if (PH_ON) {
                { pg8::Gemm g{(const bf16_t*)(ws + WS_W1M), (const bf16_t*)(ws + WS_PQT), 128, 128, 128, 0, 0};
                  pg8::Sched S; S.init(1, 2048, 1); pg8::EpiFft1 E{(bf16_t*)(ws + WS_B2)}; pg8::gemm_phase(lds, g, S, E, wave0); }
                { pg8::Gemm g{(const bf16_t*)(ws + WS_CN256), (const bf16_t*)(ws + WS_PQC), 512, 512, 512, 0, (size_t)1024 * 512};
                  pg8::Sched S; S.init(1, 4, 8); pg8::EpiStore<0> E{HN + (size_t)TL * D, D, (size_t)256 * D}; pg8::gemm_phase(lds, g, S, E, wave0); }
            }
            PH_END;
            if (PH_ON) {
                pg8::Gemm g{(const bf16_t*)(ws + WS_W2M), (const bf16_t*)(ws + WS_B2), 128, 128, 128, 0, 0};
                pg8::Sched S; S.init(1, 2048, 1); pg8::EpiFft2 E{HN}; pg8::gemm_phase(lds, g, S, E, wave0);
            }
            PH_END;
        }
        if (kind != 0) {
            if (PH_ON) {
                { pg8::Gemm g{HN, kind == 1 ? WOT : FWT, D, D, D, 0, 0};
                  pg8::Sched S; S.init(128, 4, 1);
                  pg8::EpiResid E{xl, xc, p.out, XCTX, modl + 2 * D, kind == 2 ? p.fb : nullptr};
                  pg8::gemm_phase(lds, g, S, E, wave0); }
                if (!last) { pg8::Gemm g{HN, kind == 1 ? WOT : FWT, D, D, D / KSPLIT, (size_t)(D / KSPLIT), (size_t)(D / KSPLIT)};
                  pg8::Sched S; S.init(8, 4, KSPLIT, 128);
                  pg8::EpiPart E{PART};
                  pg8::gemm_phase(lds, g, S, E, wave0); }
            }
            PH_END;
        }
        if (PH_ON) { FRESH_IDS; for (int rep = 0; rep < NREP(3); ++rep) norm_rows_tok(p.out, XCTX, ng + D, modl, 3, HN, last ? TL : TA, gw, NGW, lane, false, fxF); }
        PH_END;
        if (PH_ON) {
            for (int rep = 0; rep < NREP(0); ++rep) {
            pg8::Gemm g{HN, W1T + (size_t)li * D * DFF, D, D, D, 0, 0};
            pg8::Sched S; S.init(last ? 128 : 136, 16, 1);
            pg8::EpiStore<1> E{HB, DFF, 0};
            pg8::gemm_phase(lds, g, S, E, wave0); }
        }
        PH_END;
        if (PH_ON) {
            if (!last) { pg8::Gemm g{HB, W2T + (size_t)li * D * DFF, DFF, DFF, DFF / KSPLIT, (size_t)(DFF / KSPLIT), (size_t)(DFF / KSPLIT)};
              pg8::Sched S; S.init(8, 4, KSPLIT, 128);
              pg8::EpiPart E{PART};
              pg8::gemm_phase(lds, g, S, E, wave0); }
            for (int rep = 0; rep < NREP(1); ++rep) {
            pg8::Gemm g{HB, W2T + (size_t)li * D * DFF, DFF, DFF, DFF, 0, 0};
            pg8::Sched S; S.init(128, 4, 1);
            pg8::EpiResid E{p.out, XCTX, p.out, XCTX, (rep + 1 < NREP(1)) ? (const float*)(ws + WS_ZERO) : modl + 5 * D, nullptr};
            pg8::gemm_phase(lds, g, S, E, wave0); }
        }
        PH_END;
    }
}

extern "C" void kernel_launch(void* const* d_in, const int* in_sizes, int n_in, void* d_out, int out_size, void* d_ws, size_t ws_size, hipStream_t stream) {
    static int grid = 0;
    if (grid == 0) {
        int dev = 0, cus = 0, per_cu = 0;
        hipGetDevice(&dev);
        hipDeviceGetAttribute(&cus, hipDeviceAttributeMultiprocessorCount, dev);
        hipFuncSetAttribute((const void*)mega_fwd, hipFuncAttributeMaxDynamicSharedMemorySize, LDS_BYTES);
        hipOccupancyMaxActiveBlocksPerMultiprocessor(&per_cu, (const void*)mega_fwd, 512, LDS_BYTES);
        if (per_cu < 1) per_cu = 1;
        grid = cus * per_cu;
        if (ws_size < WS_END) fprintf(stderr, "kernel_launch: workspace too small: %zu < %zu\n", ws_size, (size_t)WS_END);
    }
    (void)hipMemsetAsync((char*)d_ws + WS_CTL, 0, CTL_BYTES, stream);
    Params p{};
    const float** f = (const float**)&p;
    for (int i = 0; i < 26; ++i) f[i] = (const float*)d_in[i];
    p.out = (float*)d_out; p.ws = (unsigned char*)d_ws; p.ph_lo = 0; p.ph_hi = 1000;
    void* args[] = {&p};
    hipError_t e = hipLaunchCooperativeKernel((const void*)mega_fwd, dim3(grid), dim3(512), args, LDS_BYTES, stream);
    if (e != hipSuccess) fprintf(stderr, "cooperative launch failed: %s (grid %d)\n", hipGetErrorString(e), grid);
}
```

```cpp
#include <hip/hip_runtime.h>
#include <hip/hip_cooperative_groups.h>
#include <cstdio>
#include <cstdint>
namespace cg = cooperative_groups;

#define LAS __attribute__((address_space(3)))
typedef unsigned short bf16_t;
typedef short bf16x8 __attribute__((ext_vector_type(8)));
typedef float f32x2 __attribute__((ext_vector_type(2)));
typedef float f32x4 __attribute__((ext_vector_type(4)));
typedef float f32x16 __attribute__((ext_vector_type(16)));
typedef unsigned u32x2 __attribute__((ext_vector_type(2)));
typedef unsigned u32x4 __attribute__((ext_vector_type(4)));
typedef __bf16 bf16x2_t __attribute__((ext_vector_type(2)));

__device__ __forceinline__ unsigned pk2(float lo, float hi) { f32x2 v = {lo, hi}; bf16x2_t b = __builtin_convertvector(v, bf16x2_t); return __builtin_bit_cast(unsigned, b); }
__device__ __forceinline__ float bflo(unsigned w) { return __uint_as_float(w << 16); }
__device__ __forceinline__ float bfhi(unsigned w) { return __uint_as_float(w & 0xffff0000u); }
__device__ __forceinline__ float shx(float v, int lane, int m) { return __int_as_float(__builtin_amdgcn_ds_bpermute((lane ^ m) << 2, __float_as_int(v))); }
__device__ __forceinline__ float wave_sum(float v, int lane) {
#pragma unroll
    for (int o = 1; o < 64; o <<= 1) v += shx(v, lane, o);
    return v;
}
__device__ __forceinline__ float xhalf_max(float v) { auto rr = __builtin_amdgcn_permlane32_swap(__float_as_uint(v), __float_as_uint(v), false, false); return fmaxf(__uint_as_float(rr[0]), __uint_as_float(rr[1])); }
__device__ __forceinline__ float xhalf_sum(float v) { auto rr = __builtin_amdgcn_permlane32_swap(__float_as_uint(v), __float_as_uint(v), false, false); return __uint_as_float(rr[0]) + __uint_as_float(rr[1]); }
__device__ __forceinline__ int fresh_tid(int wave0) { int l; asm volatile("v_mbcnt_lo_u32_b32 %0, -1, 0\n\tv_mbcnt_hi_u32_b32 %0, -1, %0" : "=v"(l)); return wave0 * 64 + l; }
#define LAUNDER_V(x) asm volatile("" : "+v"(x))
__device__ __forceinline__ float max3f(float a, float b, float c) { float r; asm("v_max3_f32 %0, %1, %2, %3" : "=v"(r) : "v"(a), "v"(b), "v"(c)); return r; }
__device__ __forceinline__ float sigmoidf_(float x) { return 1.0f / (1.0f + __expf(-x)); }
__device__ __forceinline__ float gelu_tanh(float x) { const float u = 0.7978845608028654f * (x + 0.044715f * x * x * x); return x * sigmoidf_(2.0f * u); }

constexpr int D = 1024, TL = 32768, TC = 2048, TA = TL + TC, DFF = 4096, NMOD = 6;
constexpr int NCH = 1088;
constexpr int UGP = 768;
constexpr float EPS = 1e-6f;
constexpr float LAM_INIT = 0.35550906759f;
constexpr float QSCALE = 0.125f * 1.4426950408889634f;
#ifndef REP_MASK
#define REP_MASK 0
#endif
#define NREP(bit) ((REP_MASK >> (bit)) & 1 ? 2 : 1)
#ifndef ATT_THR
#define ATT_THR 16.0f
#endif

constexpr size_t MiB = 1u << 20;
constexpr size_t WS_W1T = 0, WS_W2T = 32 * MiB, WS_GLUT = 64 * MiB, WS_QKVT = 72 * MiB, WS_WOT = 78 * MiB, WS_FWT = 80 * MiB;
constexpr size_t WS_ZERO = 474 * MiB, WS_CTL = 475 * MiB, CTL_BYTES = 16384;
constexpr size_t WS_PART = 476 * MiB;
constexpr int KSPLIT = 4;
constexpr size_t WS_MOD = 82 * MiB, WS_KTAB = 83 * MiB, WS_XCTX = 91 * MiB, WS_HN = 99 * MiB, WS_H = 202 * MiB, WS_END = 474 * MiB;
constexpr size_t WS_SLOC = WS_H, WS_W1S = WS_H + 68 * MiB, WS_W3S = WS_H + 84 * MiB, WS_Z = WS_H + 132 * MiB;
constexpr size_t WS_QK = WS_H, WS_VT = WS_H + 136 * MiB;
constexpr size_t WS_PQT = WS_H, WS_PQC = WS_H + 128 * MiB, WS_B2 = WS_H + 136 * MiB, WS_CS = WS_H + 264 * MiB, WS_CN256 = WS_H + 265 * MiB, WS_W1M = WS_H + 266 * MiB, WS_W2M = WS_H + 267 * MiB;

constexpr int LDS_BYTES = 147456;

struct Params {
    const float *x, *c, *ctx, *c_ctx, *w_mod, *b_mod, *norm_g, *mlp_w1, *mlp_w2;
    const float *s5_lre, *s5_lim, *s5_ldt, *s5_bre, *s5_bim, *s5_cre, *s5_cim, *s5_d, *s5_wglu;
    const float *wqkv, *qn, *kn, *dlam, *subln, *wo, *fw, *fb;
    float* out; unsigned char* ws;
    int ph_lo, ph_hi;
};

namespace pg8 {
constexpr int BM = 256, BK = 64, HALF = 128, HTB = HALF * BK * 2, STAGE_BYTES = 8 * HTB, NXCD = 8, WGM = 8;
__host__ __device__ __forceinline__ int lds_byte(int r, int c) { const int st = (r >> 4) * 2 + (c >> 5), rr = r & 15, cc = c & 31, ob = rr * 64 + cc * 2; return st * 1024 + (ob ^ (((ob >> 9) & 1) << 5)); }
__host__ __device__ __forceinline__ void stage_rc(int b, int& R, int& C) { const int st = b / 1024, sb = b % 1024, swz = sb ^ (((sb >> 9) & 1) << 5); R = (st >> 1) * 16 + swz / 64; C = (st & 1) * 32 + (swz % 64) / 2; }
__host__ __device__ __forceinline__ int perm32(int rho) { const int n = rho >> 4, i = rho & 15; return 8 * (i >> 2) + 4 * n + (i & 3); }

struct Unit { int pm, pn, pb; };
struct Gemm { const bf16_t* A; const bf16_t* Bt; int lda, ldb, K; size_t batchA, batchB; };
struct Sched {
    int nM, nN, nwg, G, c;
    int pm0;
    __device__ __forceinline__ void init(int nM_, int nN_, int nB_, int pm0_ = 0, int coff = 0) { nM = nM_; nN = nN_; nwg = nM_ * nN_ * nB_; G = gridDim.x; c = (blockIdx.x + coff) % gridDim.x; pm0 = pm0_; }
    __device__ __forceinline__ bool next(int i, Unit& u) const {
        const long L = (long)i * G + c; if (L >= nwg) return false;
        int wgid = (int)L; { const int q = nwg / NXCD, r = nwg % NXCD, xcd = wgid % NXCD, off = wgid / NXCD; wgid = (xcd < r ? xcd * (q + 1) : r * (q + 1) + (xcd - r) * q) + off; }
        const int upb = nM * nN; u.pb = wgid / upb; const int w = wgid - u.pb * upb;
        const int nig = WGM * nN, gid = w / nig, fm = gid * WGM, gsz = (nM - fm) < WGM ? (nM - fm) : WGM;
        u.pm = pm0 + fm + ((w % nig) % gsz); u.pn = (w % nig) / gsz; return true;
    }
};

template <class Epi>
__device__ __forceinline__ void gemm_phase(LAS unsigned char* lds, const Gemm g, const Sched& S, const Epi& E, int wave0) {
    const int tid = fresh_tid(wave0), wid = __builtin_amdgcn_readfirstlane(tid >> 6), lane = tid & 63, wr = wid >> 2, wc = wid & 3, fr = lane & 15, fq = lane >> 4;
    const int nt = g.K / BK;
    unsigned voffA[2], voffB[2];
#pragma unroll
    for (int i = 0; i < 2; ++i) { int R, C; stage_rc(tid * 16 + i * 8192, R, C); const int Rb = Epi::PERM ? ((R & ~31) + perm32(R & 31)) : R;
        voffA[i] = (unsigned)(R * g.lda + C) * 2u; voffB[i] = (unsigned)(Rb * g.ldb + C) * 2u; }
    const size_t kstep = (size_t)(BK * 2);
    const size_t hstepA = (size_t)HALF * g.lda * 2, hstepB = (size_t)HALF * g.ldb * 2;
    const unsigned ldsw = (unsigned)wid * 1024u;
    const int aoff = lds_byte(wr * 64 + fr, fq * 8), boff = lds_byte(wc * 32 + fr, fq * 8);
#define PG8_APTR(u) ((const char*)(g.A + (size_t)(u).pb * g.batchA + (size_t)(u).pm * BM * g.lda))
#define PG8_BPTR(u) ((const char*)(g.Bt + (size_t)(u).pb * g.batchB + (size_t)(u).pn * BM * g.ldb))
#define PG8_SA(b, h) (((b) * 2 + (h)) * HTB)
#define PG8_SB(b, h) ((4 + (b) * 2 + (h)) * HTB)
#define PG8_STAGE(bufoff, gbase, voff) do { const char* gb_ = (const char*)(gbase); asm volatile("" : "+s"(gb_)); _Pragma("unroll") for (int _i = 0; _i < 2; ++_i) \
        __builtin_amdgcn_global_load_lds((const unsigned*)(gb_ + (voff)[_i]), (LAS unsigned*)(lds + (bufoff) + ldsw + _i * 8192), 16, 0, 0); } while (0)
#define PG8_LDA(dst, b, h) do { _Pragma("unroll") for (int m = 0; m < 4; ++m) _Pragma("unroll") for (int k = 0; k < 2; ++k) dst[m][k] = *(const LAS bf16x8*)(lds + PG8_SA(b, h) + aoff + m * 2048 + k * 1024); } while (0)
#define PG8_LDB(dst, b, h) do { _Pragma("unroll") for (int n = 0; n < 2; ++n) _Pragma("unroll") for (int k = 0; k < 2; ++k) dst[n][k] = *(const LAS bf16x8*)(lds + PG8_SB(b, h) + boff + n * 2048 + k * 1024); } while (0)
#define PG8_MMA(ai, bj, At, Bt) do { __builtin_amdgcn_s_setprio(1); _Pragma("unroll") for (int m = 0; m < 4; ++m) _Pragma("unroll") for (int n = 0; n < 2; ++n) _Pragma("unroll") for (int k = 0; k < 2; ++k) \
        acc[ai][bj][m][n] = __builtin_amdgcn_mfma_f32_16x16x32_bf16(Bt[n][k], At[m][k], acc[ai][bj][m][n], 0, 0, 0); __builtin_amdgcn_s_setprio(0); } while (0)
#define PG8_WAIT_V(n) asm volatile("s_waitcnt vmcnt(" #n ")" ::: "memory")
#define PG8_WAIT_L(n) asm volatile("s_waitcnt lgkmcnt(" #n ")" ::: "memory")
#define PG8_BAR __builtin_amdgcn_s_barrier()
#define PG8_SCHED __builtin_amdgcn_sched_barrier(0)
    Unit cur, nxt; int ui = 0;
    if (!S.next(0, cur)) return;
    f32x4 acc[2][2][4][2];
#pragma unroll
    for (int a = 0; a < 2; ++a)
#pragma unroll
        for (int b = 0; b < 2; ++b)
#pragma unroll
            for (int m = 0; m < 4; ++m)
#pragma unroll
                for (int n = 0; n < 2; ++n) acc[a][b][m][n] = (f32x4){0.f, 0.f, 0.f, 0.f};
    bf16x8 At[4][2], B0[2][2], B1[2][2];
    const char* cA = PG8_APTR(cur); const char* cB = PG8_BPTR(cur);
    PG8_STAGE(PG8_SB(0, 0), cB, voffB); PG8_STAGE(PG8_SB(0, 1), cB + hstepB, voffB); PG8_STAGE(PG8_SA(0, 0), cA, voffA); PG8_STAGE(PG8_SA(0, 1), cA + hstepA, voffA);
    if (wr == 1) PG8_BAR;
    PG8_WAIT_V(2); PG8_BAR;
    PG8_STAGE(PG8_SB(1, 0), cB + kstep, voffB); PG8_STAGE(PG8_SA(1, 0), cA + kstep, voffA); PG8_STAGE(PG8_SB(1, 1), cB + hstepB + kstep, voffB);
    PG8_WAIT_V(6); PG8_BAR;
    for (;;) {
        const bool has_next = S.next(ui + 1, nxt);
        const char* nA = has_next ? PG8_APTR(nxt) : cA; const char* nB = has_next ? PG8_BPTR(nxt) : cB;
        for (int t = 0; t < nt; t += 2) {
            const bool last = (t == nt - 2);
            const char* a1 = cA + (size_t)(t + 1) * kstep;
            const char* a2 = last ? nA : cA + (size_t)(t + 2) * kstep; const char* b2 = last ? nB : cB + (size_t)(t + 2) * kstep;
            const char* a3 = a2 + kstep; const char* b3 = b2 + kstep;
            PG8_LDB(B0, 0, 0); PG8_LDB(B1, 0, 1); PG8_SCHED; PG8_LDA(At, 0, 0); PG8_STAGE(PG8_SA(1, 1), a1 + hstepA, voffA);
            PG8_WAIT_V(8); PG8_WAIT_L(0); PG8_BAR; PG8_MMA(0, 0, At, B0); PG8_MMA(0, 1, At, B1); PG8_BAR; PG8_SCHED;
            PG8_LDA(At, 0, 1); PG8_STAGE(PG8_SB(0, 0), b2, voffB); PG8_STAGE(PG8_SB(0, 1), b2 + hstepB, voffB); PG8_STAGE(PG8_SA(0, 0), a2, voffA);
            PG8_WAIT_V(8); PG8_WAIT_L(0); PG8_BAR; PG8_MMA(1, 0, At, B0); PG8_MMA(1, 1, At, B1); PG8_BAR; PG8_SCHED;
            PG8_LDB(B0, 1, 0); PG8_LDB(B1, 1, 1); PG8_SCHED; PG8_LDA(At, 1, 0); PG8_STAGE(PG8_SA(0, 1), a2 + hstepA, voffA);
            PG8_WAIT_V(8); PG8_WAIT_L(0); PG8_BAR; PG8_MMA(0, 0, At, B0); PG8_MMA(0, 1, At, B1); PG8_BAR; PG8_SCHED;
            PG8_LDA(At, 1, 1); PG8_STAGE(PG8_SB(1, 0), b3, voffB); PG8_STAGE(PG8_SB(1, 1), b3 + hstepB, voffB); PG8_STAGE(PG8_SA(1, 0), a3, voffA);
            PG8_WAIT_V(8); PG8_WAIT_L(0); PG8_BAR; PG8_MMA(1, 0, At, B0); PG8_MMA(1, 1, At, B1); PG8_BAR; PG8_SCHED;
        }
        if (wr == 0) PG8_BAR;
        { int l2_; asm volatile("v_mbcnt_lo_u32_b32 %0, -1, 0\n\tv_mbcnt_hi_u32_b32 %0, -1, %0" : "=v"(l2_)); E(acc, cur, wr, wc, l2_ & 15, l2_ >> 4); }
        if (!has_next) break;
#pragma unroll
        for (int a = 0; a < 2; ++a)
#pragma unroll
            for (int b = 0; b < 2; ++b)
#pragma unroll
                for (int m = 0; m < 4; ++m)
#pragma unroll
                    for (int n = 0; n < 2; ++n) acc[a][b][m][n] = (f32x4){0.f, 0.f, 0.f, 0.f};
        cur = nxt; cA = nA; cB = nB; ++ui;
        if (wr == 1) PG8_BAR;
    }
    PG8_WAIT_V(0);
    PG8_BAR;
#undef PG8_APTR
#undef PG8_BPTR
#undef PG8_SA
#undef PG8_SB
#undef PG8_STAGE
#undef PG8_LDA
#undef PG8_LDB
#undef PG8_MMA
#undef PG8_WAIT_V
#undef PG8_WAIT_L
#undef PG8_BAR
#undef PG8_SCHED
}

typedef f32x4 Acc[2][2][4][2];

template <int ACT  > struct EpiStore {
    static constexpr bool PERM = true;
    bf16_t* O; size_t ldc, bstride;
    __device__ __forceinline__ void operator()(const Acc& acc, const Unit& u, int wr, int wc, int fr, int fq) const {
        LAUNDER_V(fr); LAUNDER_V(fq);
        const int row0 = u.pm * BM + wr * 64 + fr, col0 = u.pn * BM + wc * 32 + 8 * fq;
        bf16_t* base = O + (size_t)u.pb * bstride;
#pragma unroll
        for (int ai = 0; ai < 2; ++ai)
#pragma unroll
            for (int m = 0; m < 4; ++m) { bf16_t* rowp = base + (size_t)(row0 + ai * HALF + m * 16) * ldc + col0;
#pragma unroll
                for (int bj = 0; bj < 2; ++bj) { f32x4 v0 = acc[ai][bj][m][0], v1 = acc[ai][bj][m][1];
                    if (ACT == 1) {
#pragma unroll
                        for (int e = 0; e < 4; ++e) { float a = fmaxf(v0[e], 0.f), b = fmaxf(v1[e], 0.f); v0[e] = a * a; v1[e] = b * b; } }
                    u32x4 w; w.x = pk2(v0[0], v0[1]); w.y = pk2(v0[2], v0[3]); w.z = pk2(v1[0], v1[1]); w.w = pk2(v1[2], v1[3]);
                    *(u32x4*)(rowp + bj * HALF) = w; } }
    }
};

struct EpiResid {
    static constexpr bool PERM = false;
    const float* base_lat; const float* base_ctx; float* out_lat; float* out_ctx; const float* gate; const float* bias;
    __device__ __forceinline__ void operator()(const Acc& acc, const Unit& u, int wr, int wc, int fr, int fq) const {
        LAUNDER_V(fr); LAUNDER_V(fq);
        const float* bp; float* op; int rbase, mi;
        if (u.pm < 128) { bp = base_lat; op = out_lat; rbase = u.pm * BM; mi = u.pm >> 4; } else { bp = base_ctx; op = out_ctx; rbase = (u.pm - 128) * BM; mi = 8; }
        const int col0 = u.pn * BM + wc * 32 + 4 * fq;
        f32x4 gv[2][2], bv[2][2];
#pragma unroll
        for (int bj = 0; bj < 2; ++bj)
#pragma unroll
            for (int n = 0; n < 2; ++n) { gv[bj][n] = *(const f32x4*)(gate + mi * (NMOD * D) + col0 + bj * HALF + n * 16);
                bv[bj][n] = bias ? *(const f32x4*)(bias + col0 + bj * HALF + n * 16) : (f32x4){0.f, 0.f, 0.f, 0.f}; }
#pragma unroll
        for (int ai = 0; ai < 2; ++ai)
#pragma unroll
            for (int m = 0; m < 4; ++m) { const size_t off = (size_t)(rbase + ai * HALF + wr * 64 + m * 16 + fr) * D + col0;
#pragma unroll
                for (int bj = 0; bj < 2; ++bj)
#pragma unroll
                    for (int n = 0; n < 2; ++n) { const f32x4 xv = *(const f32x4*)(bp + off + bj * HALF + n * 16);
                        *(f32x4*)(op + off + bj * HALF + n * 16) = xv + gv[bj][n] * (acc[ai][bj][m][n] + bv[bj][n]); } }
    }
};

struct EpiQK {
    static constexpr bool PERM = false;
    bf16_t* QKo; const float* qn; const float* kn;
    __device__ __forceinline__ void operator()(const Acc& acc, const Unit& u, int wr, int wc, int fr, int fq) const {
        LAUNDER_V(fr); LAUNDER_V(fq);
        const int lane = fq * 16 + fr, hc = u.pn * 4 + wc; const bool isq = hc < 16;
        const float* nwp = (isq ? qn : kn) + 4 * fq;
        f32x4 nw[2][2];
#pragma unroll
        for (int bj = 0; bj < 2; ++bj)
#pragma unroll
            for (int n = 0; n < 2; ++n) nw[bj][n] = *(const f32x4*)(nwp + 32 * bj + 16 * n);
        float invf[4];
#pragma unroll
        for (int i = 0; i < 4; ++i) invf[i] = __builtin_amdgcn_exp2f(-(float)(4 * fq + i) * 0.8304820237218406f) * 0.15915494309189535f;
        const float qs = isq ? QSCALE : 1.f;
#pragma unroll
        for (int ai = 0; ai < 2; ++ai)
#pragma unroll
            for (int m = 0; m < 4; ++m) { const int row = u.pm * BM + ai * HALF + wr * 64 + m * 16 + fr;
                float ss = 0.f;
#pragma unroll
                for (int bj = 0; bj < 2; ++bj)
#pragma unroll
                    for (int n = 0; n < 2; ++n) { const f32x4 a = acc[ai][bj][m][n]; ss += (a[0] * a[0] + a[1] * a[1]) + (a[2] * a[2] + a[3] * a[3]); }
                ss += shx(ss, lane, 16); ss += shx(ss, lane, 32);
                const float rstd = rsqrtf(ss * (1.f / 64.f) + EPS) ;
                const int l = row & 4095; const float posr = (float)(l >> 6), posc = (float)(l & 63);
                bf16_t* op = QKo + (size_t)row * 2048 + hc * 64 + 4 * fq;
#pragma unroll
                for (int bj = 0; bj < 2; ++bj) { f32x4 x1 = acc[ai][bj][m][0] * rstd * nw[bj][0], x2 = acc[ai][bj][m][1] * rstd * nw[bj][1];
                    if (row < TL) { const float pos = bj ? posc : posr;
#pragma unroll
                        for (int i = 0; i < 4; ++i) { const float rev = pos * invf[i]; const float cs = __builtin_amdgcn_cosf(rev), sn = __builtin_amdgcn_sinf(rev);
                            const float a = x1[i], b = x2[i]; x1[i] = a * cs - b * sn; x2[i] = a * sn + b * cs; } }
                    x1 *= qs; x2 *= qs;
                    *(u32x2*)(op + 32 * bj) = (u32x2){pk2(x1[0], x1[1]), pk2(x1[2], x1[3])};
                    *(u32x2*)(op + 32 * bj + 16) = (u32x2){pk2(x2[0], x2[1]), pk2(x2[2], x2[3])}; } }
    }
};

struct EpiPart {
    static constexpr bool PERM = false;
    float* P;
    __device__ __forceinline__ void operator()(const Acc& acc, const Unit& u, int wr, int wc, int fr, int fq) const {
        LAUNDER_V(fr); LAUNDER_V(fq);
        const int col0 = u.pn * BM + wc * 32 + 4 * fq;
#pragma unroll
        for (int ai = 0; ai < 2; ++ai)
#pragma unroll
            for (int m = 0; m < 4; ++m) { float* rp = P + ((size_t)u.pb * TC + (u.pm - 128) * BM + ai * HALF + wr * 64 + m * 16 + fr) * D + col0;
#pragma unroll
                for (int bj = 0; bj < 2; ++bj)
#pragma unroll
                    for (int n = 0; n < 2; ++n) *(f32x4*)(rp + bj * HALF + n * 16) = acc[ai][bj][m][n]; }
    }
};

struct EpiGlu {
    static constexpr bool PERM = false;
    const float* base_lat; const float* base_ctx; float* out_lat; float* out_ctx; const float* gate;
    __device__ __forceinline__ void operator()(const Acc& acc, const Unit& u, int wr, int wc, int fr, int fq) const {
        LAUNDER_V(fr); LAUNDER_V(fq);
        const float* bp; float* op; int rbase, mi;
        if (u.pm < 128) { bp = base_lat; op = out_lat; rbase = u.pm * BM; mi = u.pm >> 4; } else { bp = base_ctx; op = out_ctx; rbase = (u.pm - 128) * BM; mi = 8; }
        const int col0 = u.pn * HALF + wc * 32 + 4 * fq;
        f32x4 gv[2];
#pragma unroll
        for (int n = 0; n < 2; ++n) gv[n] = *(const f32x4*)(gate + mi * (NMOD * D) + col0 + n * 16);
#pragma unroll
        for (int ai = 0; ai < 2; ++ai)
#pragma unroll
            for (int m = 0; m < 4; ++m) { const size_t off = (size_t)(rbase + ai * HALF + wr * 64 + m * 16 + fr) * D + col0;
#pragma unroll
                for (int n = 0; n < 2; ++n) { const f32x4 xv = *(const f32x4*)(bp + off + n * 16); const f32x4 v = acc[ai][0][m][n], gt = acc[ai][1][m][n]; f32x4 o;
#pragma unroll
                    for (int e = 0; e < 4; ++e) o[e] = xv[e] + gv[n][e] * v[e] * sigmoidf_(gt[e]);
                    *(f32x4*)(op + off + n * 16) = o; } }
    }
};

struct EpiSloc {
    static constexpr bool PERM = false;
    float* S;
    __device__ __forceinline__ void operator()(const Acc& acc, const Unit& u, int wr, int wc, int fr, int fq) const {
        LAUNDER_V(fr); LAUNDER_V(fq);
        const int col0 = wc * 32 + 4 * fq;
#pragma unroll
        for (int ai = 0; ai < 2; ++ai)
#pragma unroll
            for (int m = 0; m < 4; ++m) { const int ci = u.pm * BM + ai * HALF + wr * 64 + m * 16 + fr;
                if (ci < NCH) { float* rp = S + ((size_t)u.pb * NCH + ci) * 256 + col0;
#pragma unroll
                    for (int bj = 0; bj < 2; ++bj)
#pragma unroll
                        for (int n = 0; n < 2; ++n) *(f32x4*)(rp + bj * HALF + n * 16) = acc[ai][bj][m][n]; } }
    }
};

struct EpiZ {
    static constexpr bool PERM = false;
    bf16_t* Z;
    __device__ __forceinline__ void operator()(const Acc& acc, const Unit& u, int wr, int wc, int fr, int fq) const {
        LAUNDER_V(fr); LAUNDER_V(fq);
#pragma unroll
        for (int ai = 0; ai < 2; ++ai)
#pragma unroll
            for (int m = 0; m < 4; ++m) { const int ci = u.pm * BM + ai * HALF + wr * 64 + m * 16 + fr;
                if (ci < NCH) { const int b = ci / 136, cc = ci - b * 136; const int tok0 = cc < 8 ? TL + b * 256 + cc * 32 : b * 4096 + (cc - 8) * 32;
#pragma unroll
                    for (int bj = 0; bj < 2; ++bj)
#pragma unroll
                        for (int n = 0; n < 2; ++n) { const int t = 16 * u.pn + 8 * bj + 2 * wc + n; const f32x4 v = acc[ai][bj][m][n];
                            u32x2 w; w.x = pk2(gelu_tanh(v[0]), gelu_tanh(v[1])); w.y = pk2(gelu_tanh(v[2]), gelu_tanh(v[3]));
                            *(u32x2*)(Z + (size_t)(tok0 + t) * D + u.pb * 16 + 4 * fq) = w; } } }
    }
};

struct EpiChanDft {
    static constexpr bool PERM = true;
    bf16_t* PQ1; bf16_t* PQC;
    __device__ __forceinline__ void operator()(const Acc& acc, const Unit& u, int wr, int wc, int fr, int fq) const {
        LAUNDER_V(fr); LAUNDER_V(fq);
        if (u.pn < 128) {
            const int b = u.pn >> 4;
#pragma unroll
            for (int ai = 0; ai < 2; ++ai)
#pragma unroll
                for (int m = 0; m < 4; ++m) { const int kc = ai * HALF + wr * 64 + m * 16 + fr;
                    bf16_t* rowp = PQ1 + (size_t)(b * 1024 + u.pb * 256 + kc) * 8192 + u.pm * 64;
#pragma unroll
                    for (int bj = 0; bj < 2; ++bj) { const int tp = (u.pn & 15) * 256 + bj * HALF + wc * 32 + 8 * fq;
                        const f32x4 v0 = acc[ai][bj][m][0], v1 = acc[ai][bj][m][1];
                        u32x4 w; w.x = pk2(v0[0], v0[1]); w.y = pk2(v0[2], v0[3]); w.z = pk2(v1[0], v1[1]); w.w = pk2(v1[2], v1[3]);
                        *(u32x4*)(rowp + (tp >> 6) * 128 + (tp & 63)) = w; } }
        } else {
            const int b = u.pn - 128;
            bf16_t* base = PQC + (size_t)(b * 1024 + u.pb * 256) * 512 + (size_t)u.pm * 256 + wc * 32 + 8 * fq;
#pragma unroll
            for (int ai = 0; ai < 2; ++ai)
#pragma unroll
                for (int m = 0; m < 4; ++m) { bf16_t* rowp = base + (size_t)(ai * HALF + wr * 64 + m * 16 + fr) * 512;
#pragma unroll
                    for (int bj = 0; bj < 2; ++bj) { const f32x4 v0 = acc[ai][bj][m][0], v1 = acc[ai][bj][m][1];
                        u32x4 w; w.x = pk2(v0[0], v0[1]); w.y = pk2(v0[2], v0[3]); w.z = pk2(v1[0], v1[1]); w.w = pk2(v1[2], v1[3]);
                        *(u32x4*)(rowp + bj * HALF) = w; } }
        }
    }
};

struct EpiFft1 {
    static constexpr bool PERM = true;
    bf16_t* B2;
    __device__ __forceinline__ void operator()(const Acc& acc, const Unit& u, int wr, int wc, int fr, int fq) const {
        LAUNDER_V(fr); LAUNDER_V(fq);
        if (wr != 0) return;
#pragma unroll
        for (int m = 0; m < 4; ++m) { const int m2 = 16 * m + fr;
#pragma unroll
            for (int bj = 0; bj < 2; ++bj) { const int n0 = u.pn * BM + bj * HALF + wc * 32 + 8 * fq; const int k2 = n0 & 63, c = (n0 >> 6) & 1023, b = n0 >> 16;
                float br[8], bi[8];
#pragma unroll
                for (int e = 0; e < 8; ++e) { const float ar = acc[0][bj][m][e >> 2][e & 3], ai_ = acc[1][bj][m][e >> 2][e & 3];
                    const float rev = (float)(m2 * (k2 + e)) * (1.f / 4096.f); const float cs = __builtin_amdgcn_cosf(rev), sn = __builtin_amdgcn_sinf(rev);
                    br[e] = (ar * cs + ai_ * sn) * (1.f / 64.f); bi[e] = (ai_ * cs - ar * sn) * (1.f / 64.f); }
                bf16_t* op = B2 + ((size_t)(b * 64 + m2) * 1024 + c) * 128 + k2;
                *(u32x4*)(op) = (u32x4){pk2(br[0], br[1]), pk2(br[2], br[3]), pk2(br[4], br[5]), pk2(br[6], br[7])};
                *(u32x4*)(op + 64) = (u32x4){pk2(bi[0], bi[1]), pk2(bi[2], bi[3]), pk2(bi[4], bi[5]), pk2(bi[6], bi[7])}; } }
    }
};

struct EpiFft2 {
    static constexpr bool PERM = true;
    bf16_t* F;
    __device__ __forceinline__ void operator()(const Acc& acc, const Unit& u, int wr, int wc, int fr, int fq) const {
        LAUNDER_V(fr); LAUNDER_V(fq);
        if (wr != 0) return;
#pragma unroll
        for (int m = 0; m < 4; ++m) { const int m1 = 16 * m + fr;
#pragma unroll
            for (int bj = 0; bj < 2; ++bj) { const int n0 = u.pn * BM + bj * HALF + wc * 32 + 8 * fq; const int c = n0 & 1023, m2 = (n0 >> 10) & 63, b = n0 >> 16;
                const f32x4 v0 = acc[0][bj][m][0], v1 = acc[0][bj][m][1];
                *(u32x4*)(F + (size_t)(b * 4096 + 64 * m1 + m2) * D + c) = (u32x4){pk2(v0[0], v0[1]), pk2(v0[2], v0[3]), pk2(v1[0], v1[1]), pk2(v1[2], v1[3])}; } }
    }
};
}

__device__ __forceinline__ void transpose_item(const float* W, int K, int N, bf16_t* WT, int glu, LAS float* scr, int item, int lane) {
    const int nblk = N / 32, kb = item / nblk, nb = item % nblk, k0 = 64 * kb, n0 = 32 * nb;
#pragma unroll 8
    for (int i = 0; i < 32; ++i) { const int kk = 2 * i + (lane >> 5); scr[kk * 33 + (lane & 31)] = W[(size_t)(k0 + kk) * N + n0 + (lane & 31)]; }
    asm volatile("s_waitcnt lgkmcnt(0)" ::: "memory");
    const int n0p = glu == 1 ? (((n0 & 1023) >> 7) * 256 + (n0 >> 10) * 128 + (n0 & 127))
                  : (glu == 2 && n0 < 2048) ? ((n0 & ~255) | (((n0 >> 5) & 1) << 7) | (((n0 >> 6) & 3) << 5)) : n0;
    const int c = lane & 7;
#pragma unroll
    for (int j = 0; j < 4; ++j) { const int n = (lane >> 3) + 8 * j; const LAS float* s = scr + (8 * c) * 33 + n;
        u32x4 o; o.x = pk2(s[0 * 33], s[1 * 33]); o.y = pk2(s[2 * 33], s[3 * 33]); o.z = pk2(s[4 * 33], s[5 * 33]); o.w = pk2(s[6 * 33], s[7 * 33]);
        *(u32x4*)(WT + (size_t)(n0p + n) * K + k0 + 8 * c) = o; }
    asm volatile("s_waitcnt lgkmcnt(0)" ::: "memory");
}


struct TJob { const float* W; bf16_t* WT; int K, N, mode, nitems; };
__device__ __forceinline__ void run_tjobs(const TJob& a, const TJob& b, const TJob& c, LAS float* scr, int gw, int ngw, int lane) {
    const int n = a.nitems + b.nitems + c.nitems;
    for (int it = gw; it < n; it += ngw) {
        int r = it;
        if (r < a.nitems) { transpose_item(a.W, a.K, a.N, a.WT, a.mode, scr, r, lane); continue; } r -= a.nitems;
        if (r < b.nitems) { transpose_item(b.W, b.K, b.N, b.WT, b.mode, scr, r, lane); continue; } r -= b.nitems;
        transpose_item(c.W, c.K, c.N, c.WT, c.mode, scr, r, lane);
    }
}
__device__ __forceinline__ const float* xrow_ptr(const float* xl, const float* xc, int row) { return row < TL ? xl + (size_t)row * D : xc + (size_t)(row - TL) * D; }

struct CtxFix { const float* part; const float* pgate; const float* pbias; float* xw; };
__device__ __forceinline__ void norm_rows_tok(const float* xl, const float* xc, const float* g, const float* modl  , int sidx, bf16_t* out, int nrows, int gw, int ngw, int lane, bool perm64, const CtxFix fx) {
    for (int row = gw; row < nrows; row += ngw) {
        const f32x4* xr = (const f32x4*)xrow_ptr(xl, xc, row) + lane;
        f32x4 v[4]; float ss = 0.f;
#pragma unroll
        for (int j = 0; j < 4; ++j) v[j] = xr[64 * j];
        if (fx.part && row >= TL) {
#pragma unroll
            for (int j = 0; j < 4; ++j) { const int c = 4 * lane + 256 * j; f32x4 s = fx.pbias ? *(const f32x4*)(fx.pbias + c) : (f32x4){0.f, 0.f, 0.f, 0.f};
#pragma unroll
                for (int k = 0; k < KSPLIT; ++k) s += *(const f32x4*)(fx.part + ((size_t)k * TC + (row - TL)) * D + c);
                v[j] += *(const f32x4*)(fx.pgate + c) * s;
                *(f32x4*)(fx.xw + (size_t)(row - TL) * D + c) = v[j]; } }
#pragma unroll
        for (int j = 0; j < 4; ++j) ss += (v[j].x * v[j].x + v[j].y * v[j].y) + (v[j].z * v[j].z + v[j].w * v[j].w);
        const float rstd = rsqrtf(wave_sum(ss, lane) * (1.f / D) + EPS);
        const int mi = row < TL ? row >> 12 : 8;
        const float* sh = modl + mi * (NMOD * D) + sidx * D; const float* sc = sh + D;
        const int orow = (perm64 && row < TL) ? ((row & ~4095) | ((row & 63) << 6) | ((row & 4095) >> 6)) : row;
        unsigned long long* o8 = (unsigned long long*)(out + (size_t)orow * D) + lane;
#pragma unroll
        for (int j = 0; j < 4; ++j) { const int c = 4 * lane + 256 * j; const f32x4 gg = *(const f32x4*)(g + c), s1 = *(const f32x4*)(sc + c), s0 = *(const f32x4*)(sh + c);
            f32x4 y;
#pragma unroll
            for (int e = 0; e < 4; ++e) y[e] = v[j][e] * rstd * gg[e] * (1.f + s1[e]) + s0[e];
            o8[64 * j] = (unsigned long long)pk2(y[0], y[1]) | ((unsigned long long)pk2(y[2], y[3]) << 32); }
    }
}
__device__ __forceinline__ void norm_rows_s5(const float* xl, const float* xc, const float* g, const float* modl, bf16_t* ug, int gw, int ngw, int lane, const CtxFix fx) {
    for (int row = gw; row < TA; row += ngw) {
        const f32x4* xr = (const f32x4*)xrow_ptr(xl, xc, row) + 4 * lane;
        f32x4 v[4]; float ss = 0.f;
#pragma unroll
        for (int j = 0; j < 4; ++j) v[j] = xr[j];
        if (fx.part && row >= TL) {
#pragma unroll
            for (int j = 0; j < 4; ++j) { const int c = 16 * lane + 4 * j; f32x4 s = fx.pbias ? *(const f32x4*)(fx.pbias + c) : (f32x4){0.f, 0.f, 0.f, 0.f};
#pragma unroll
                for (int k = 0; k < KSPLIT; ++k) s += *(const f32x4*)(fx.part + ((size_t)k * TC + (row - TL)) * D + c);
                v[j] += *(const f32x4*)(fx.pgate + c) * s;
                *(f32x4*)(fx.xw + (size_t)(row - TL) * D + c) = v[j]; } }
#pragma unroll
        for (int j = 0; j < 4; ++j) ss += (v[j].x * v[j].x + v[j].y * v[j].y) + (v[j].z * v[j].z + v[j].w * v[j].w);
        const float rstd = rsqrtf(wave_sum(ss, lane) * (1.f / D) + EPS);
        int mi, b, pos; if (row < TL) { b = row >> 12; pos = 256 + (row & 4095); mi = b; } else { b = (row - TL) >> 8; pos = (row - TL) & 255; mi = 8; }
        const float* sh = modl + mi * (NMOD * D); const float* sc = sh + D;
        const int chunk = b * 136 + (pos >> 5), s = pos & 31;
        unsigned w[8];
#pragma unroll
        for (int j = 0; j < 4; ++j) { const int c = 16 * lane + 4 * j; const f32x4 gg = *(const f32x4*)(g + c), s1 = *(const f32x4*)(sc + c), s0 = *(const f32x4*)(sh + c);
            f32x4 y;
#pragma unroll
            for (int e = 0; e < 4; ++e) y[e] = v[j][e] * rstd * gg[e] * (1.f + s1[e]) + s0[e];
            w[2 * j] = pk2(y[0], y[1]); w[2 * j + 1] = pk2(y[2], y[3]); }
        u32x4* op = (u32x4*)(ug + ((size_t)lane * NCH + chunk) * UGP + s * 16);
        op[0] = (u32x4){w[0], w[1], w[2], w[3]}; op[1] = (u32x4){w[4], w[5], w[6], w[7]};
    }
}

__device__ __forceinline__ void cpow(float lr_dt, float li_dt, float k, float& re, float& im) {
    const float mag = __expf(k * lr_dt); const float rev = k * li_dt * 0.15915494309189535f;
    re = mag * __builtin_amdgcn_cosf(rev); im = mag * __builtin_amdgcn_sinf(rev);
}
__device__ __forceinline__ void s5_kcoef(float lr, float li, float dt, float& kr, float& ki) {
    const float th = li * dt; const float rv = th * 0.15915494309189535f;
    const float c = __builtin_amdgcn_cosf(rv), s = __builtin_amdgcn_sinf(rv), sh = __builtin_amdgcn_sinf(0.5f * rv);
    const float em1 = expm1f(lr * dt);
    const float nre = em1 * c - 2.f * sh * sh, nim = (em1 + 1.f) * s;
    const float den = lr * lr + li * li;
    kr = (nre * lr + nim * li) / den; ki = (nim * lr - nre * li) / den;
}


#define XB_TMO      128
#define XB_XCNT(j)  (256  + 64 * (j))
#define XB_XSUB(j)  (1280 + 64 * (j))
#define XB_XGEN(j)  (2304 + 64 * (j))
#define XB_TOP      3328
#define XB_TOPGEN   3392
#define XCD_BAR_WORDS 3456
#define XB_SPIN_CAP (1u << 18)
__device__ __forceinline__ unsigned xb_ld(unsigned* p)              { return __hip_atomic_load(p, __ATOMIC_RELAXED, __HIP_MEMORY_SCOPE_AGENT); }
__device__ __forceinline__ unsigned xb_add(unsigned* p, unsigned v) { return __hip_atomic_fetch_add(p, v, __ATOMIC_RELAXED, __HIP_MEMORY_SCOPE_AGENT); }
__device__ __forceinline__ unsigned xb_xcc_id() { return (unsigned)__builtin_amdgcn_s_getreg((3 << 11) | 20) & 0xFu; }
#define XB_SPIN(cond, bar) do { unsigned _sp = 0; while (cond) { __builtin_amdgcn_s_sleep(1); \
    if ((++_sp & 255u) == 0u) { if (xb_ld(&(bar)[XB_TMO])) break; if (_sp > XB_SPIN_CAP) { atomicAdd(&(bar)[XB_TMO], 1u); break; } } } } while (0)
struct XcdBarrier { unsigned* bar; unsigned x; volatile LAS unsigned* st; };
__device__ __forceinline__ XcdBarrier xcd_barrier_post(unsigned* bar, volatile LAS unsigned* st) {
    XcdBarrier b; b.bar = bar; b.x = xb_xcc_id(); b.st = st;
    if (threadIdx.x == 0) (void)xb_add(&bar[XB_XCNT(b.x)], 1u);
    return b;
}
__device__ __forceinline__ void xcd_barrier_complete(unsigned* bar, unsigned x, unsigned& nloc, unsigned& nx) {
    const unsigned G = gridDim.x * gridDim.y * gridDim.z;
    unsigned sum, cnt, mine, sp = 0u;
    for (;;) {
        sum = 0u; cnt = 0u; mine = 0u;
#pragma unroll
        for (unsigned j = 0; j < 16; ++j) { const unsigned c = xb_ld(&bar[XB_XCNT(j)]); sum += c; cnt += (c > 0u) ? 1u : 0u; mine = (j == x) ? c : mine; }
        if (sum == G) break;
        __builtin_amdgcn_s_sleep(1);
        if ((++sp & 255u) == 0u) { if (xb_ld(&bar[XB_TMO])) break; if (sp > XB_SPIN_CAP) { atomicAdd(&bar[XB_TMO], 1u); break; } }
    }
    nloc = mine > 0u ? mine : 1u; nx = cnt > 0u ? cnt : 1u;
}
__device__ __forceinline__ void xcd_barrier(const XcdBarrier& b) {
    asm volatile("s_waitcnt vmcnt(0)" ::: "memory");
    __syncthreads();
    if (threadIdx.x == 0) {
        unsigned* bar = b.bar;
        __builtin_amdgcn_s_waitcnt(0);
        unsigned nloc = b.st[0], nx = b.st[1];
        if (nloc == 0u) { xcd_barrier_complete(bar, b.x, nloc, nx); b.st[0] = nloc; b.st[1] = nx; }
        const unsigned old = xb_add(&bar[XB_XSUB(b.x)], 1u);
        const unsigned gen = old / nloc;
        if (old + 1u == (gen + 1u) * nloc) {
            __builtin_amdgcn_fence(__ATOMIC_RELEASE, "agent");
            asm volatile("s_waitcnt vmcnt(0)" ::: "memory");
            const unsigned og = xb_add(&bar[XB_TOP], 1u);
            const unsigned tg = og / nx;
            if (og + 1u == (tg + 1u) * nx) xb_add(&bar[XB_TOPGEN], 1u);
            else XB_SPIN(xb_ld(&bar[XB_TOPGEN]) == tg, bar);
            __builtin_amdgcn_fence(__ATOMIC_ACQUIRE, "agent");
            xb_add(&bar[XB_XGEN(b.x)], 1u);
            asm volatile("s_waitcnt vmcnt(0)" ::: "memory");
        } else {
            XB_SPIN(xb_ld(&bar[XB_XGEN(b.x)]) == gen, bar);
            __builtin_amdgcn_fence(__ATOMIC_ACQUIRE, "agent");
            asm volatile("s_waitcnt vmcnt(0)" ::: "memory");
        }
    }
    __syncthreads();
}

__global__ void __launch_bounds__(512) mega_fwd(Params p) {
    extern __shared__ __attribute__((aligned(16))) unsigned char lds_raw[];
    LAS unsigned char* lds = (LAS unsigned char*)lds_raw;
    cg::grid_group grid = cg::this_grid();
    const int G = gridDim.x, bid = blockIdx.x, NGW = G * 8;
    const int wave0 = __builtin_amdgcn_readfirstlane(threadIdx.x >> 6);
#define FRESH_IDS const int tid = fresh_tid(wave0), lane = tid & 63, wave = __builtin_amdgcn_readfirstlane(tid >> 6), gw = bid * 8 + wave; (void)lane; (void)gw
    unsigned char* ws = p.ws;
    bf16_t* W1T = (bf16_t*)(ws + WS_W1T); bf16_t* W2T = (bf16_t*)(ws + WS_W2T); bf16_t* GLUT = (bf16_t*)(ws + WS_GLUT);
    bf16_t* QKVT = (bf16_t*)(ws + WS_QKVT); bf16_t* WOT = (bf16_t*)(ws + WS_WOT); bf16_t* FWT = (bf16_t*)(ws + WS_FWT);
    float* MOD = (float*)(ws + WS_MOD); float* KTAB = (float*)(ws + WS_KTAB); float* XCTX = (float*)(ws + WS_XCTX);
    bf16_t* HN = (bf16_t*)(ws + WS_HN); bf16_t* HB = (bf16_t*)(ws + WS_H);
    int ph = 0;
#define PH_ON (ph >= p.ph_lo && ph < p.ph_hi)
    volatile LAS unsigned* bst = (volatile LAS unsigned*)(lds + LDS_BYTES - 64);
    if (threadIdx.x < 2) bst[threadIdx.x] = 0u;
    __syncthreads();
    const XcdBarrier xbar = xcd_barrier_post((unsigned*)(ws + WS_CTL), bst);
#define PH_END do { if (ph >= p.ph_lo && ph + 1 < p.ph_hi) { for (int r_ = 0; r_ < NREP(8); ++r_) { if (ph == 0) grid.sync(); else xcd_barrier(xbar); } } ++ph; } while (0)

    if (PH_ON) {
        FRESH_IDS;
        {
            LAS float* scr = (LAS float*)(lds + wave * 16384);
            const TJob ja{p.mlp_w1, W1T, D, DFF, 0, 16 * 128}, jb{p.mlp_w2, W2T, DFF, D, 0, 64 * 32}, jc{p.s5_wglu, GLUT, D, 2 * D, 1, 16 * 64};
            run_tjobs(ja, jb, jc, scr, gw, NGW, lane);
        }
        if (REP_MASK) { for (int e = bid * 512 + tid; e < 9 * NMOD * D; e += G * 512) ((float*)(ws + WS_ZERO))[e] = 0.f; }
        __syncthreads();
        {
            LAS float* sc = (LAS float*)lds;
            LAS float* red = (LAS float*)(lds + 9 * 4096);
            for (int e = tid; e < 9 * D; e += 512) { const float v = e < 8 * D ? p.c[e] : p.c_ctx[e - 8 * D]; sc[e] = v * sigmoidf_(v); }
            __syncthreads();
            const int col = tid & 63, kp = tid >> 6;
            for (int item = bid; item < 4 * 96; item += G) {
                const int i = item / 96, nb = item % 96;
                float a[9];
#pragma unroll
                for (int r = 0; r < 9; ++r) a[r] = 0.f;
                const float* wp = p.w_mod + ((size_t)i * D + kp * 128) * (NMOD * D) + nb * 64 + col;
#pragma unroll 8
                for (int k = 0; k < 128; ++k) { const float w = wp[(size_t)k * (NMOD * D)];
#pragma unroll
                    for (int r = 0; r < 9; ++r) a[r] += sc[r * D + kp * 128 + k] * w; }
#pragma unroll
                for (int r = 0; r < 9; ++r) red[(kp * 64 + col) * 9 + r] = a[r];
                __syncthreads();
                for (int e = tid; e < 576; e += 512) { const int r = e >> 6, cc = e & 63; float s = p.b_mod[i * (NMOD * D) + nb * 64 + cc];
#pragma unroll
                    for (int q = 0; q < 8; ++q) s += red[(q * 64 + cc) * 9 + r];
                    MOD[((size_t)i * 9 + r) * (NMOD * D) + nb * 64 + cc] = s; }
                __syncthreads();
            }
        }
        {
            LAS float* Bb = (LAS float*)lds;
            LAS float* Cc = (LAS float*)(lds + 8192);
            LAS float* ap = (LAS float*)(lds + 16384);
            for (int item = bid; item < 256; item += G) {
                const int j = item >> 7, g = (item >> 1) & 63, dir = item & 1;
                const int pg = (j * 2 + dir) * 64 + g;
                const float dt = __expf(p.s5_ldt[pg]);
                __syncthreads();
                for (int e = tid; e < 1024; e += 512) { const int pp = e >> 4, h = e & 15; float kr, ki; s5_kcoef(p.s5_lre[pg * 64 + pp], p.s5_lim[pg * 64 + pp], dt, kr, ki);
                    const float br = p.s5_bre[((size_t)pg * 64 + pp) * 16 + h], bi = p.s5_bim[((size_t)pg * 64 + pp) * 16 + h];
                    Bb[e * 2] = kr * br - ki * bi; Bb[e * 2 + 1] = kr * bi + ki * br;
                    const int h2 = e >> 6, p2 = e & 63; Cc[e * 2] = p.s5_cre[((size_t)pg * 16 + h2) * 64 + p2]; Cc[e * 2 + 1] = p.s5_cim[((size_t)pg * 16 + h2) * 64 + p2]; }
                for (int e = tid; e < 2048; e += 512) { const int tau = e >> 6, pp = e & 63; float re, im; cpow(p.s5_lre[pg * 64 + pp] * dt, p.s5_lim[pg * 64 + pp] * dt, (float)tau, re, im); ap[e * 2] = re; ap[e * 2 + 1] = im; }
                __syncthreads();
                const int hh = tid & 255, h = hh >> 4, hp = hh & 15, th = tid >> 8;
                float a[16];
#pragma unroll
                for (int q = 0; q < 16; ++q) a[q] = 0.f;
                for (int pp = 0; pp < 64; ++pp) { const float cr = Cc[(h * 64 + pp) * 2], ci = Cc[(h * 64 + pp) * 2 + 1], br = Bb[(pp * 16 + hp) * 2], bi = Bb[(pp * 16 + hp) * 2 + 1];
                    const float cbr = cr * br - ci * bi, cbi = cr * bi + ci * br;
#pragma unroll
                    for (int q = 0; q < 16; ++q) { const float ar = ap[((th * 16 + q) * 64 + pp) * 2], ai = ap[((th * 16 + q) * 64 + pp) * 2 + 1]; a[q] += cbr * ar - cbi * ai; } }
#pragma unroll
                for (int q = 0; q < 16; ++q) KTAB[((((size_t)j * 64 + g) * 2 + dir) * 32 + th * 16 + q) * 256 + hh] = a[q];
            }
            __syncthreads();
        }
    }
    PH_END;

    for (int li = 0; li < 4; ++li) {
        const int kind = li % 3, jj = li / 3; const bool last = (li == 3);
        const float* xl = li == 0 ? p.x : p.out; const float* xc = li == 0 ? p.ctx : XCTX;
        const float* modl = MOD + (size_t)li * 9 * (NMOD * D);
        const float* ng = p.norm_g + (size_t)li * 2 * D;
        float* PART = (float*)(ws + WS_PART);
        const CtxFix fxA{li > 0 ? PART : nullptr, MOD + ((size_t)(li - 1) * 9 + 8) * (NMOD * D) + 5 * D, nullptr, XCTX};
        const CtxFix fxF{(kind != 0 && !last) ? PART : nullptr, modl + 8 * (NMOD * D) + 2 * D, kind == 2 ? p.fb : nullptr, XCTX};

        if (PH_ON) {
            FRESH_IDS;
            if (kind == 0) {
                for (int rep = 0; rep < NREP(3); ++rep) norm_rows_s5(xl, xc, ng, modl, HN, gw, NGW, lane, fxA);
                bf16_t* W1S = (bf16_t*)(ws + WS_W1S); bf16_t* W3S = (bf16_t*)(ws + WS_W3S);
                LAS float* apf = (LAS float*)lds;
                LAS float* apb = (LAS float*)(lds + 16896);
                LAS float* Cf = (LAS float*)(lds + 33792);
                LAS float* Cb = (LAS float*)(lds + 41984);
                LAS float* Bbf = (LAS float*)(lds + 50176);
                LAS float* Bbb = (LAS float*)(lds + 58368);
                for (int item = bid; item < 256; item += G) {
                    const int g = item >> 2, tq = item & 3;
                    __syncthreads();
                    for (int e = tid; e < 2 * 33 * 64; e += 512) { const int dir = e / (33 * 64), r = e % (33 * 64), k = r >> 6, pp = r & 63; const int pg = (jj * 2 + dir) * 64 + g;
                        const float dt = __expf(p.s5_ldt[pg]); float re, im; cpow(p.s5_lre[pg * 64 + pp] * dt, p.s5_lim[pg * 64 + pp] * dt, (float)k, re, im);
                        LAS float* d = dir ? apb : apf; d[r * 2] = re; d[r * 2 + 1] = im; }
                    for (int e = tid; e < 2048; e += 512) { const int dir = e >> 10, r = e & 1023; const int pg = (jj * 2 + dir) * 64 + g;
                        { const int h2 = r >> 6, p2 = r & 63; LAS float* d = dir ? Cb : Cf; d[r * 2] = p.s5_cre[((size_t)pg * 16 + h2) * 64 + p2]; d[r * 2 + 1] = p.s5_cim[((size_t)pg * 16 + h2) * 64 + p2]; }
                        { const int pp = r >> 4, h = r & 15; const float dt = __expf(p.s5_ldt[pg]); float kr, ki; s5_kcoef(p.s5_lre[pg * 64 + pp], p.s5_lim[pg * 64 + pp], dt, kr, ki);
                          const float br = p.s5_bre[((size_t)pg * 64 + pp) * 16 + h], bi = p.s5_bim[((size_t)pg * 64 + pp) * 16 + h];
                          LAS float* d = dir ? Bbb : Bbf; d[r * 2] = kr * br - ki * bi; d[r * 2 + 1] = kr * bi + ki * br; } }
                    __syncthreads();
                    for (int e = tid; e < 4096; e += 512) { const int ee = tq * 4096 + e; const int hh = ee & 1, s = (ee >> 1) & 31, pp = (ee >> 6) & 63, ri = (ee >> 12) & 1, dir = ee >> 13;
                        const int ex = dir ? s : 31 - s; const LAS float* apd = dir ? apb : apf; const LAS float* bd = dir ? Bbb : Bbf;
                        const float ar = apd[(ex * 64 + pp) * 2], ai = apd[(ex * 64 + pp) * 2 + 1];
                        float v[8];
#pragma unroll
                        for (int i = 0; i < 8; ++i) { const float br = bd[(pp * 16 + hh * 8 + i) * 2], bi = bd[(pp * 16 + hh * 8 + i) * 2 + 1]; v[i] = ri ? ar * bi + ai * br : ar * br - ai * bi; }
                        *(u32x4*)(W1S + ((size_t)(g * 256 + dir * 128 + ri * 64 + pp)) * 512 + s * 16 + hh * 8) = (u32x4){pk2(v[0], v[1]), pk2(v[2], v[3]), pk2(v[4], v[5]), pk2(v[6], v[7])}; }
                    const float* ktf = KTAB + (((size_t)jj * 64 + g) * 2 + 0) * 32 * 256; const float* ktb = ktf + 32 * 256;
                    for (int e = tid; e < 128 * 96; e += 512) { const int kc = e % 96, rowi = e / 96, t = tq * 8 + (rowi >> 4), h = rowi & 15;
                        float v[8];
                        if (kc < 64) { const int s = kc >> 1, h0 = (kc & 1) * 8;
#pragma unroll
                            for (int i = 0; i < 8; ++i) v[i] = 0.f;
                            if (s <= t) { const f32x4* kp = (const f32x4*)(ktf + (t - s) * 256 + h * 16 + h0); const f32x4 a = kp[0], b = kp[1];
#pragma unroll
                                for (int i = 0; i < 4; ++i) { v[i] += a[i]; v[4 + i] += b[i]; } }
                            if (s >= t) { const f32x4* kp = (const f32x4*)(ktb + (s - t) * 256 + h * 16 + h0); const f32x4 a = kp[0], b = kp[1];
#pragma unroll
                                for (int i = 0; i < 4; ++i) { v[i] += a[i]; v[4 + i] += b[i]; } }
                            if (s == t) { const float dd = p.s5_d[jj * D + g * 16 + h];
#pragma unroll
                                for (int i = 0; i < 8; ++i) if (h0 + i == h) v[i] += dd; }
                        } else { const int q = kc - 64, dir = q >> 4, ri = (q >> 3) & 1, p0 = (q & 7) * 8; const int ex = dir ? 32 - t : t + 1;
                            const LAS float* apd = dir ? apb : apf; const LAS float* cd = dir ? Cb : Cf;
#pragma unroll
                            for (int i = 0; i < 8; ++i) { const int pp = p0 + i; const float ar = apd[(ex * 64 + pp) * 2], ai = apd[(ex * 64 + pp) * 2 + 1], cr = cd[(h * 64 + pp) * 2], ci = cd[(h * 64 + pp) * 2 + 1];
                                v[i] = ri ? -(cr * ai + ci * ar) : cr * ar - ci * ai; } }
                        *(u32x4*)(W3S + ((size_t)(g * 512 + t * 16 + h)) * UGP + kc * 8) = (u32x4){pk2(v[0], v[1]), pk2(v[2], v[3]), pk2(v[4], v[5]), pk2(v[6], v[7])}; }
                }
                __syncthreads();
            } else {
                for (int rep = 0; rep < NREP(3); ++rep) norm_rows_tok(xl, xc, ng, modl, 0, HN, TA, gw, NGW, lane, kind == 2, fxA);
                if (kind == 2) {
                    bf16_t* CS = (bf16_t*)(ws + WS_CS); bf16_t* CN2 = (bf16_t*)(ws + WS_CN256); bf16_t* W1M = (bf16_t*)(ws + WS_W1M); bf16_t* W2M = (bf16_t*)(ws + WS_W2M);
                    const int gt = bid * 512 + tid, NT = G * 512;
                    for (int e = gt; e < 2 * 256 * 16; e += NT) { const int which = e >> 12, r = (e >> 4) & 255, kc = e & 15, k0 = (kc & 7) * 8, hs = kc >> 3; float v[8];
#pragma unroll
                        for (int i = 0; i < 8; ++i) { const int mm = r & 63; const float rev = (float)((mm * (k0 + i)) & 63) * (1.f / 64.f); const float cs = __builtin_amdgcn_cosf(rev), sn = __builtin_amdgcn_sinf(rev);
                            float val = 0.f;
                            if (which == 0) { if (r < 64) val = hs ? -sn : cs; else if (r >= 128 && r < 192) val = hs ? -cs : -sn; }
                            else { if (r < 64) val = hs ? sn : cs; }
                            v[i] = val; }
                        *(u32x4*)((which ? W2M : W1M) + (size_t)r * 128 + kc * 8) = (u32x4){pk2(v[0], v[1]), pk2(v[2], v[3]), pk2(v[4], v[5]), pk2(v[6], v[7])}; }
                    for (int e = gt; e < 512 * 32; e += NT) { const int m = e >> 5, kc = m & 255, isS = m >> 8, k0 = (e & 31) * 8; float v[8];
#pragma unroll
                        for (int i = 0; i < 8; ++i) { const float rev = (float)((kc * (k0 + i)) & 255) * (1.f / 256.f); v[i] = (isS ? __builtin_amdgcn_sinf(rev) : __builtin_amdgcn_cosf(rev)) * (1.f / 16.f); }
                        *(u32x4*)(CS + (size_t)m * 256 + k0) = (u32x4){pk2(v[0], v[1]), pk2(v[2], v[3]), pk2(v[4], v[5]), pk2(v[6], v[7])}; }
                    for (int e = gt; e < 256 * 64; e += NT) { const int m = e >> 6, kc = e & 63, k0 = (kc & 31) * 8, isS = kc >> 5; float v[8];
#pragma unroll
                        for (int i = 0; i < 8; ++i) { const float rev = (float)((m * (k0 + i)) & 255) * (1.f / 256.f); v[i] = (isS ? -__builtin_amdgcn_sinf(rev) : __builtin_amdgcn_cosf(rev)) * (1.f / 16.f); }
                        *(u32x4*)(CN2 + (size_t)m * 512 + kc * 8) = (u32x4){pk2(v[0], v[1]), pk2(v[2], v[3]), pk2(v[4], v[5]), pk2(v[6], v[7])}; }
                }
            }
        }
        PH_END;

        if (kind == 0) {
            if (PH_ON) {
                pg8::Gemm g{HN, (const bf16_t*)(ws + WS_W1S), UGP, 512, 512, (size_t)NCH * UGP, (size_t)256 * 512};
                pg8::Sched S; S.init(5, 1, 64);
                pg8::EpiSloc E{(float*)(ws + WS_SLOC)};
                pg8::gemm_phase(lds, g, S, E, wave0);
            }
            PH_END;
            if (PH_ON) {
                FRESH_IDS;
                const float* SL = (const float*)(ws + WS_SLOC);
                for (int id = bid * 512 + tid; id < 8 * 64 * 2 * 64; id += G * 512) {
                    const int pp = id & 63, dir = (id >> 6) & 1, g = (id >> 7) & 63, b = id >> 13;
                    const int pg = (jj * 2 + dir) * 64 + g; const float dt = __expf(p.s5_ldt[pg]);
                    float ar, ai; cpow(p.s5_lre[pg * 64 + pp] * dt, p.s5_lim[pg * 64 + pp] * dt, 32.f, ar, ai);
                    float sr = 0.f, si = 0.f;
                    const size_t rb = (size_t)g * NCH + b * 136;
                    for (int k0 = 0; k0 < 136; k0 += 8) {
                        float lr[8], lim[8];
#pragma unroll
                        for (int q = 0; q < 8; ++q) { const int k = k0 + q; const int cc = dir == 0 ? k : (k < 8 ? 7 - k : 143 - k);
                            lr[q] = SL[(rb + cc) * 256 + dir * 128 + pp]; lim[q] = SL[(rb + cc) * 256 + dir * 128 + 64 + pp]; }
#pragma unroll
                        for (int q = 0; q < 8; ++q) { const int k = k0 + q; const int cc = dir == 0 ? k : (k < 8 ? 7 - k : 143 - k);
                            bf16_t* o = HN + (rb + cc) * UGP + 512 + dir * 128 + pp;
                            o[0] = (bf16_t)(pk2(sr, 0.f) & 0xffffu); o[64] = (bf16_t)(pk2(si, 0.f) & 0xffffu);
                            const float nr = ar * sr - ai * si + lr[q], ni = ar * si + ai * sr + lim[q]; sr = nr; si = ni; }
                    }
                }
            }
            PH_END;
            if (PH_ON) {
                pg8::Gemm g{HN, (const bf16_t*)(ws + WS_W3S), UGP, UGP, UGP, (size_t)NCH * UGP, (size_t)512 * UGP};
                pg8::Sched S; S.init(5, 2, 64);
                pg8::EpiZ E{(bf16_t*)(ws + WS_Z)};
                pg8::gemm_phase(lds, g, S, E, wave0);
            }
            PH_END;
            if (PH_ON) {
                pg8::Gemm g{(const bf16_t*)(ws + WS_Z), GLUT + (size_t)jj * D * 2 * D, D, D, D, 0, 0};
                pg8::Sched S; S.init(last ? 128 : 136, 8, 1);
                pg8::EpiGlu E{xl, xc, p.out, XCTX, modl + 2 * D};
                pg8::gemm_phase(lds, g, S, E, wave0);
            }
            PH_END;
        } else if (kind == 1) {
            bf16_t* QK = (bf16_t*)(ws + WS_QK); bf16_t* VT = (bf16_t*)(ws + WS_VT);
            if (PH_ON) {
                { pg8::Gemm g{HN, QKVT, D, D, D, 0, 0}; pg8::Sched S; S.init(136, 8, 1); pg8::EpiQK E{QK, p.qn, p.kn}; pg8::gemm_phase(lds, g, S, E, wave0); }
                { pg8::Gemm g{QKVT + (size_t)2048 * D, HN, D, D, D, 0, 0}; pg8::Sched S; S.init(4, 136, 1, 0, 128); pg8::EpiStore<0> E{VT, (size_t)TA, 0}; pg8::gemm_phase(lds, g, S, E, wave0); }
            }
            PH_END;
            if (PH_ON) {
                FRESH_IDS;
                const int l31 = lane & 31, hi = lane >> 5, comp = wave >> 2, wq = wave & 3;
                float lamv; { const float a = wave_sum(p.dlam[lane] * p.dlam[64 + lane], lane), b = wave_sum(p.dlam[128 + lane] * p.dlam[192 + lane], lane); lamv = __expf(a) - __expf(b) + LAM_INIT; }
                const int vcu = (G % 8 == 0) ? (bid % 8) * (G / 8) + bid / 8 : bid;
                constexpr int KROW = 144, KTILE = 64 * KROW, VTILE = 128 * KROW, VRING = 4 * KTILE;
                const int kr = tid >> 3, kch = tid & 7;
                const int kst = kr * KROW + kch * 16, vst = kr * KROW + ((kch >> 1) * 32 + (kch & 1) * 8);
                for (int rep = 0; rep < NREP(2); ++rep)
                for (int u = vcu; u < 2176; u += G) {
                    int b, head, qrow0, j0;
                    if (u < 2048) { b = u >> 8; head = (u >> 5) & 7; qrow0 = b * 4096 + (u & 31) * 128; j0 = 0; }
                    else { const int v = u - 2048; b = v >> 4; head = (v >> 1) & 7; qrow0 = TL + b * 256 + (v & 1) * 128; j0 = 64; }
                    bf16x8 qf[4];
                    { const bf16_t* qp = QK + (size_t)(qrow0 + wq * 32 + l31) * 2048 + head * 128 + comp * 64 + hi * 8;
#pragma unroll
                      for (int ds = 0; ds < 4; ++ds) qf[ds] = *(const bf16x8*)(qp + ds * 16); }
                    const bf16_t* kbase = QK + (size_t)kr * 2048 + 1024 + head * 128 + kch * 8;
                    const bf16_t* vbase = VT + (size_t)(head * 128 + kr) * TA + kch * 8;
                    u32x4 pk0, pk1, pv0, pv1;
#define ATT_TOKBASE(j) ((j) < 64 ? b * 4096 + 64 * (j) : TL + b * 256 + 64 * ((j) - 64))
#define ATT_LOADK(j) do { const bf16_t* kp_ = kbase + (size_t)ATT_TOKBASE(j) * 2048; pk0 = *(const u32x4*)kp_; pk1 = *(const u32x4*)(kp_ + 64); } while (0)
#define ATT_LOADV(j) do { const bf16_t* vp_ = vbase + ATT_TOKBASE(j); pv0 = *(const u32x4*)vp_; pv1 = *(const u32x4*)(vp_ + (size_t)64 * TA); } while (0)
#define ATT_STOREK(sl) do { LAS unsigned char* bb_ = lds + (sl) * (2 * KTILE) + kst; *(LAS u32x4*)(bb_) = pk0; *(LAS u32x4*)(bb_ + KTILE) = pk1; } while (0)
#define ATT_STOREV(sl) do { LAS unsigned char* vb_ = lds + VRING + (sl) * VTILE + vst; \
                        *(LAS u32x2*)(vb_) = (u32x2){pv0.x, pv0.y}; *(LAS u32x2*)(vb_ + 16) = (u32x2){pv0.z, pv0.w}; \
                        *(LAS u32x2*)(vb_ + 64 * KROW) = (u32x2){pv1.x, pv1.y}; *(LAS u32x2*)(vb_ + 64 * KROW + 16) = (u32x2){pv1.z, pv1.w}; } while (0)
#define ATT_QK(S0, S1, sl, CI) do { const LAS unsigned char* kb_ = lds + (sl) * (2 * KTILE) + comp * KTILE + l31 * KROW + hi * 16; bf16x8 kf_[8]; \
                        _Pragma("unroll") for (int ds = 0; ds < 4; ++ds) { kf_[2 * ds] = *(const LAS bf16x8*)(kb_ + ds * 32); kf_[2 * ds + 1] = *(const LAS bf16x8*)(kb_ + 32 * KROW + ds * 32); } \
                        __builtin_amdgcn_sched_barrier(0); \
                        _Pragma("unroll") for (int ds = 0; ds < 4; ++ds) { \
                            S0 = __builtin_amdgcn_mfma_f32_32x32x16_bf16(kf_[2 * ds], qf[ds], ds == 0 ? CI : S0, 0, 0, 0); S1 = __builtin_amdgcn_mfma_f32_32x32x16_bf16(kf_[2 * ds + 1], qf[ds], ds == 0 ? CI : S1, 0, 0, 0); } } while (0)
#define ATT_PV(sl) do { const LAS unsigned char* vb_ = lds + VRING + (sl) * VTILE + l31 * KROW + hi * 16; \
                        _Pragma("unroll") for (int ks = 0; ks < 4; ++ks) _Pragma("unroll") for (int dt = 0; dt < 4; ++dt) { const bf16x8 a_ = *(const LAS bf16x8*)(vb_ + dt * 32 * KROW + ks * 32); \
                            o[dt] = __builtin_amdgcn_mfma_f32_32x32x16_bf16(a_, pp[ks], o[dt], 0, 0, 0); } } while (0)
#define ATT_SOFT(S0, S1, PD) do { f32x2 ls_ = {0.f, 0.f}; \
                        _Pragma("unroll") for (int r = 0; r < 16; ++r) { S0[r] = __builtin_amdgcn_exp2f(S0[r]); S1[r] = __builtin_amdgcn_exp2f(S1[r]); } \
                        _Pragma("unroll") for (int r = 0; r < 16; r += 2) { ls_ += (f32x2){S0[r], S0[r + 1]}; ls_ += (f32x2){S1[r], S1[r + 1]}; } \
                        l_run += ls_.x + ls_.y; \
                        { u32x4 w_; \
                          w_ = (u32x4){pk2(S0[0], S0[1]), pk2(S0[2], S0[3]), pk2(S0[4], S0[5]), pk2(S0[6], S0[7])}; PD[0] = __builtin_bit_cast(bf16x8, w_); \
                          w_ = (u32x4){pk2(S0[8], S0[9]), pk2(S0[10], S0[11]), pk2(S0[12], S0[13]), pk2(S0[14], S0[15])}; PD[1] = __builtin_bit_cast(bf16x8, w_); \
                          w_ = (u32x4){pk2(S1[0], S1[1]), pk2(S1[2], S1[3]), pk2(S1[4], S1[5]), pk2(S1[6], S1[7])}; PD[2] = __builtin_bit_cast(bf16x8, w_); \
                          w_ = (u32x4){pk2(S1[8], S1[9]), pk2(S1[10], S1[11]), pk2(S1[12], S1[13]), pk2(S1[14], S1[15])}; PD[3] = __builtin_bit_cast(bf16x8, w_); } } while (0)
                    f32x16 o[4];
#pragma unroll
                    for (int dt = 0; dt < 4; ++dt)
#pragma unroll
                        for (int r = 0; r < 16; ++r) o[dt][r] = 0.f;
                    float m_ref, l_run = 0.f;
                    f32x16 negm, zero16;
#pragma unroll
                    for (int r = 0; r < 16; ++r) zero16[r] = 0.f;
                    bf16x8 pp[4];
                    __syncthreads();
                    ATT_LOADK(j0); ATT_STOREK(j0 & 1);
                    __syncthreads();
                    {
                        ATT_LOADK(j0 + 1); ATT_LOADV(j0);
                        f32x16 s0, s1;
                        ATT_QK(s0, s1, j0 & 1, zero16);
                        float mx = fmaxf(s0[0], s1[0]);
#pragma unroll
                        for (int r = 1; r < 16; ++r) mx = fmaxf(mx, fmaxf(s0[r], s1[r]));
                        m_ref = xhalf_max(mx);
#pragma unroll
                        for (int r = 0; r < 16; ++r) { s0[r] -= m_ref; s1[r] -= m_ref; negm[r] = -m_ref; }
                        ATT_SOFT(s0, s1, pp);
                        ATT_STOREK((j0 + 1) & 1); ATT_STOREV(j0 & 1);
                        __syncthreads();
                    }
                    for (int j = j0 + 1; j < 68; ++j) {
                        const int jn = j + 1 < 68 ? j + 1 : 67;
                        ATT_LOADK(jn); ATT_LOADV(j);
                        f32x16 s0, s1;
                        ATT_QK(s0, s1, j & 1, negm);
                        float mx = max3f(s0[0], s1[0], s0[1]), mx2 = max3f(s1[1], s0[2], s1[2]);
#pragma unroll
                        for (int r = 3; r < 15; r += 2) { mx = max3f(mx, s0[r], s1[r]); mx2 = max3f(mx2, s0[r + 1], s1[r + 1]); }
                        mx = max3f(mx, s0[15], s1[15]); mx = fmaxf(mx, mx2);
                        mx = xhalf_max(mx);
                        if (__builtin_expect(__any(mx > ATT_THR), 0)) {
                            const float dl = ceilf(fmaxf(mx, 0.f)), f = __builtin_amdgcn_exp2f(-dl);
                            m_ref += dl; l_run *= f;
#pragma unroll
                            for (int r = 0; r < 16; ++r) { s0[r] -= dl; s1[r] -= dl; negm[r] = -m_ref; }
#pragma unroll
                            for (int dt = 0; dt < 4; ++dt)
#pragma unroll
                                for (int r = 0; r < 16; ++r) o[dt][r] *= f;
#pragma unroll
                            for (int ks = 0; ks < 4; ++ks) { u32x4 w = __builtin_bit_cast(u32x4, pp[ks]);
                                w.x = pk2(bflo(w.x) * f, bfhi(w.x) * f); w.y = pk2(bflo(w.y) * f, bfhi(w.y) * f); w.z = pk2(bflo(w.z) * f, bfhi(w.z) * f); w.w = pk2(bflo(w.w) * f, bfhi(w.w) * f);
                                pp[ks] = __builtin_bit_cast(bf16x8, w); }
                        }
                        __builtin_amdgcn_sched_barrier(0);
                        unsigned pw[16]; f32x2 ls = {0.f, 0.f};
                        {
                            const LAS unsigned char* vb_ = lds + VRING + ((j - 1) & 1) * VTILE + l31 * KROW + hi * 16;
                            bf16x8 vf[16];
#define ATT_VRD(i) vf[i] = *(const LAS bf16x8*)(vb_ + ((i) & 3) * 32 * KROW + ((i) >> 2) * 32)
                            ATT_VRD(0); ATT_VRD(1);
#pragma unroll
                            for (int i = 0; i < 16; ++i) {
                                if (i + 2 < 16) ATT_VRD(i + 2);
                                o[i & 3] = __builtin_amdgcn_mfma_f32_32x32x16_bf16(vf[i], pp[i >> 2], o[i & 3], 0, 0, 0);
                                s0[i] = __builtin_amdgcn_exp2f(s0[i]); s1[i] = __builtin_amdgcn_exp2f(s1[i]);
                                if (i & 1) { pw[i >> 1] = pk2(s0[i - 1], s0[i]); pw[8 + (i >> 1)] = pk2(s1[i - 1], s1[i]); ls += (f32x2){s0[i - 1], s0[i]}; ls += (f32x2){s1[i - 1], s1[i]}; }
                                __builtin_amdgcn_sched_barrier(0);
                            }
#undef ATT_VRD
                        }
                        l_run += ls.x + ls.y;
#pragma unroll
                        for (int ks = 0; ks < 4; ++ks) { const u32x4 w = {pw[4 * ks], pw[4 * ks + 1], pw[4 * ks + 2], pw[4 * ks + 3]}; pp[ks] = __builtin_bit_cast(bf16x8, w); }
                        ATT_STOREK(jn & 1); ATT_STOREV(j & 1);
                        __syncthreads();
                    }
                    ATT_PV(67 & 1);
#undef ATT_TOKBASE
#undef ATT_LOADK
#undef ATT_LOADV
#undef ATT_STOREK
#undef ATT_STOREV
#undef ATT_QK
#undef ATT_PV
#undef ATT_SOFT
                    { const float lt = xhalf_sum(l_run); const float inv = 1.f / lt;
#pragma unroll
                      for (int dt = 0; dt < 4; ++dt)
#pragma unroll
                          for (int r = 0; r < 16; ++r) o[dt][r] *= inv; }
                    __syncthreads();
                    LAS float* ex = (LAS float*)lds + wq * 4096;
                    if (comp == 1) {
#pragma unroll
                        for (int dt = 0; dt < 4; ++dt)
#pragma unroll
                            for (int r = 0; r < 16; ++r) ex[(dt * 16 + r) * 64 + lane] = o[dt][r];
                    }
                    __syncthreads();
                    LAS bf16_t* stg = (LAS bf16_t*)(lds + 81920) + wq * (32 * 136);
                    if (comp == 0) {
                        float ss = 0.f;
#pragma unroll
                        for (int dt = 0; dt < 4; ++dt)
#pragma unroll
                            for (int r = 0; r < 16; ++r) { const float d = o[dt][r] - lamv * ex[(dt * 16 + r) * 64 + lane]; o[dt][r] = d; ss += d * d; }
                        ss = xhalf_sum(ss);
                        const float rstd = rsqrtf(ss * (1.f / 128.f) + EPS) * (1.f - LAM_INIT);
#pragma unroll
                        for (int dt = 0; dt < 4; ++dt)
#pragma unroll
                            for (int r = 0; r < 16; ++r) { const int dv = 32 * dt + (r & 3) + 8 * (r >> 2) + 4 * hi; stg[l31 * 136 + dv] = (bf16_t)(pk2(o[dt][r] * rstd * p.subln[dv], 0.f) & 0xffffu); }
                    }
                    __syncthreads();
                    if (comp == 0) {
#pragma unroll
                        for (int it = 0; it < 8; ++it) { const int row = it * 4 + (lane >> 4), ch = lane & 15;
                            const u32x4 w = *(const LAS u32x4*)(stg + row * 136 + ch * 8);
                            *(u32x4*)(HN + (size_t)(qrow0 + wq * 32 + row) * D + head * 128 + ch * 8) = w; }
                    }
                }
                __syncthreads();
            }
            PH_END;
        } else {
            if (PH_ON) {
                pg8::Gemm g{(const bf16_t*)(ws + WS_CS), HN, 256, D, 256, 0, 256};
                pg8::Sched S; S.init(2, 136, 4);
                pg8::EpiChanDft E{(bf16_t*)(ws + WS_PQT), (bf16_t*)(ws + WS_PQC)};
                pg8::gemm_phase(lds, g, S, E, wave0);
            }
            PH_END;
            if (PH_ON) {
                { pg8::Gemm g{(const bf16_t*)(ws + WS_W1M), (const bf16_t*)(ws + WS_PQT), 128, 128, 128, 0, 0};
                  pg8::Sched S; S.init(1, 2048, 1); pg8::EpiFft1 E{(bf16_t*)(ws + WS_B2)}; pg8::gemm_phase(lds, g, S, E, wave0); }
                { pg8::Gemm g{(const bf16_t*)(ws + WS_CN256), (const bf16_t*)(ws + WS_PQC), 512, 512, 512, 0, (size_t)1024 * 512};
                  pg8::Sched S; S.init(1, 4, 8); pg8::EpiStore<0> E{HN + (size_t)TL * D, D, (size_t)256 * D}; pg8::gemm_phase(lds, g, S, E, wave0); }
            }
            PH_END;
            if (PH_ON) {
                pg8::Gemm g{(const bf16_t*)(ws + WS_W2M), (const bf16_t*)(ws + WS_B2), 128, 128, 128, 0, 0};
                pg8::Sched S; S.init(1, 2048, 1); pg8::EpiFft2 E{HN}; pg8::gemm_phase(lds, g, S, E, wave0);
            }
            PH_END;
        }
        if (kind != 0) {
            if (PH_ON) {
                { pg8::Gemm g{HN, kind == 1 ? WOT : FWT, D, D, D, 0, 0};
                  pg8::Sched S; S.init(128, 4, 1);
                  pg8::EpiResid E{xl, xc, p.out, XCTX, modl + 2 * D, kind == 2 ? p.fb : nullptr};
                  pg8::gemm_phase(lds, g, S, E, wave0); }
                if (!last) { pg8::Gemm g{HN, kind == 1 ? WOT : FWT, D, D, D / KSPLIT, (size_t)(D / KSPLIT), (size_t)(D / KSPLIT)};
                  pg8::Sched S; S.init(8, 4, KSPLIT, 128);
                  pg8::EpiPart E{PART};
                  pg8::gemm_phase(lds, g, S, E, wave0); }
            }
            PH_END;
        }
        if (PH_ON) { FRESH_IDS; for (int rep = 0; rep < NREP(3); ++rep) norm_rows_tok(p.out, XCTX, ng + D, modl, 3, HN, last ? TL : TA, gw, NGW, lane, false, fxF); }
        PH_END;
        if (PH_ON) {
            for (int rep = 0; rep < NREP(0); ++rep) {
            pg8::Gemm g{HN, W1T + (size_t)li * D * DFF, D, D, D, 0, 0};
            pg8::Sched S; S.init(last ? 128 : 136, 16, 1);
            pg8::EpiStore<1> E{HB, DFF, 0};
            pg8::gemm_phase(lds, g, S, E, wave0); }
            if (!last) {
                const int first = (136 * 16) % G;
                if (bid >= first) { FRESH_IDS;
                    const int gw2 = (bid - first) * 8 + wave, ngw2 = (G - first) * 8;
                    LAS float* scr = (LAS float*)(lds + wave * 16384);
                    const int ln = li + 1;
                    const TJob jw1{p.mlp_w1 + (size_t)ln * D * DFF, W1T + (size_t)ln * D * DFF, D, DFF, 0, 16 * 128};
                    TJob jx{p.wqkv, QKVT, D, 3 * D, 2, 16 * 96}, jy{p.wo, WOT, D, D, 0, 16 * 32};
                    if (ln == 2) { jx = TJob{p.fw, FWT, D, D, 0, 16 * 32}; jy.nitems = 0; }
                    if (ln == 3) { jx = TJob{p.s5_wglu + (size_t)D * 2 * D, GLUT + (size_t)D * 2 * D, D, 2 * D, 1, 16 * 64}; jy.nitems = 0; }
                    run_tjobs(jx, jy, jw1, scr, gw2, ngw2, lane);
                }
            }
        }
        PH_END;
        if (PH_ON) {
            if (!last) { pg8::Gemm g{HB, W2T + (size_t)li * D * DFF, DFF, DFF, DFF / KSPLIT, (size_t)(DFF / KSPLIT), (size_t)(DFF / KSPLIT)};
              pg8::Sched S; S.init(8, 4, KSPLIT, 128);
              pg8::EpiPart E{PART};
              pg8::gemm_phase(lds, g, S, E, wave0);
              const int first = (8 * 4 * KSPLIT) % G;
              if (bid >= first) { FRESH_IDS;
                  const int gw2 = (bid - first) * 8 + wave, ngw2 = (G - first) * 8;
                  LAS float* scr = (LAS float*)(lds + wave * 16384);
                  const int ln = li + 1;
                  const TJob jw2{p.mlp_w2 + (size_t)ln * D * DFF, W2T + (size_t)ln * D * DFF, DFF, D, 0, 64 * 32}; TJob jz = jw2; jz.nitems = 0;
                  run_tjobs(jw2, jz, jz, scr, gw2, ngw2, lane);
                  __syncthreads(); } }
            for (int rep = 0; rep < NREP(1); ++rep) {
            pg8::Gemm g{HB, W2T + (size_t)li * D * DFF, DFF, DFF, DFF, 0, 0};
            pg8::Sched S; S.init(128, 4, 1);
            pg8::EpiResid E{p.out, XCTX, p.out, XCTX, (rep + 1 < NREP(1)) ? (const float*)(ws + WS_ZERO) : modl + 5 * D, nullptr};
            pg8::gemm_phase(lds, g, S, E, wave0); }
        }
        PH_END;
    }
}

extern "C" void kernel_launch(void* const* d_in, const int* in_sizes, int n_in, void* d_out, int out_size, void* d_ws, size_t ws_size, hipStream_t stream) {
    static int grid = 0;
    if (grid == 0) {
        int dev = 0, cus = 0, per_cu = 0;
        hipGetDevice(&dev);
        hipDeviceGetAttribute(&cus, hipDeviceAttributeMultiprocessorCount, dev);
        hipFuncSetAttribute((const void*)mega_fwd, hipFuncAttributeMaxDynamicSharedMemorySize, LDS_BYTES);
        hipOccupancyMaxActiveBlocksPerMultiprocessor(&per_cu, (const void*)mega_fwd, 512, LDS_BYTES);
        if (per_cu < 1) per_cu = 1;
        grid = cus * per_cu;
        if (ws_size < WS_END) fprintf(stderr, "kernel_launch: workspace too small: %zu < %zu\n", ws_size, (size_t)WS_END);
    }
    (void)hipMemsetAsync((char*)d_ws + WS_CTL, 0, CTL_BYTES, stream);
    Params p{};
    const float** f = (const float**)&p;
    for (int i = 0; i < 26; ++i) f[i] = (const float*)d_in[i];
    p.out = (float*)d_out; p.ws = (unsigned char*)d_ws; p.ph_lo = 0; p.ph_hi = 1000;
    void* args[] = {&p};
    hipError_t e = hipLaunchCooperativeKernel((const void*)mega_fwd, dim3(grid), dim3(512), args, LDS_BYTES, stream);
    if (e != hipSuccess) fprintf(stderr, "cooperative launch failed: %s (grid %d)\n", hipGetErrorString(e), grid);
}
```

```cpp
#include <hip/hip_runtime.h>
#include <hip/hip_cooperative_groups.h>
#include <cstdio>
#include <cstdint>
namespace cg = cooperative_groups;

#define LAS __attribute__((address_space(3)))
typedef unsigned short bf16_t;
typedef short bf16x8 __attribute__((ext_vector_type(8)));
typedef float f32x2 __attribute__((ext_vector_type(2)));
typedef float f32x4 __attribute__((ext_vector_type(4)));
typedef float f32x16 __attribute__((ext_vector_type(16)));
typedef unsigned u32x2 __attribute__((ext_vector_type(2)));
typedef unsigned u32x4 __attribute__((ext_vector_type(4)));
typedef __bf16 bf16x2_t __attribute__((ext_vector_type(2)));

__device__ __forceinline__ unsigned pk2(float lo, float hi) { f32x2 v = {lo, hi}; bf16x2_t b = __builtin_convertvector(v, bf16x2_t); return __builtin_bit_cast(unsigned, b); }
__device__ __forceinline__ float bflo(unsigned w) { return __uint_as_float(w << 16); }
__device__ __forceinline__ float bfhi(unsigned w) { return __uint_as_float(w & 0xffff0000u); }
__device__ __forceinline__ float shx(float v, int lane, int m) { return __int_as_float(__builtin_amdgcn_ds_bpermute((lane ^ m) << 2, __float_as_int(v))); }
__device__ __forceinline__ float wave_sum(float v, int lane) {
#pragma unroll
    for (int o = 1; o < 64; o <<= 1) v += shx(v, lane, o);
    return v;
}
__device__ __forceinline__ float xhalf_max(float v) { auto rr = __builtin_amdgcn_permlane32_swap(__float_as_uint(v), __float_as_uint(v), false, false); return fmaxf(__uint_as_float(rr[0]), __uint_as_float(rr[1])); }
__device__ __forceinline__ float xhalf_sum(float v) { auto rr = __builtin_amdgcn_permlane32_swap(__float_as_uint(v), __float_as_uint(v), false, false); return __uint_as_float(rr[0]) + __uint_as_float(rr[1]); }
__device__ __forceinline__ int fresh_tid(int wave0) { int l; asm volatile("v_mbcnt_lo_u32_b32 %0, -1, 0\n\tv_mbcnt_hi_u32_b32 %0, -1, %0" : "=v"(l)); return wave0 * 64 + l; }
#define LAUNDER_V(x) asm volatile("" : "+v"(x))
__device__ __forceinline__ float max3f(float a, float b, float c) { float r; asm("v_max3_f32 %0, %1, %2, %3" : "=v"(r) : "v"(a), "v"(b), "v"(c)); return r; }
__device__ __forceinline__ float sigmoidf_(float x) { return 1.0f / (1.0f + __expf(-x)); }
__device__ __forceinline__ float gelu_tanh(float x) { const float u = 0.7978845608028654f * (x + 0.044715f * x * x * x); return x * sigmoidf_(2.0f * u); }

constexpr int D = 1024, TL = 32768, TC = 2048, TA = TL + TC, DFF = 4096, NMOD = 6;
constexpr int NCH = 1088;
constexpr int UGP = 768;
constexpr float EPS = 1e-6f;
constexpr float LAM_INIT = 0.35550906759f;
constexpr float QSCALE = 0.125f * 1.4426950408889634f;
#ifndef REP_MASK
#define REP_MASK 0
#endif
#define NREP(bit) ((REP_MASK >> (bit)) & 1 ? 2 : 1)
#ifndef ATT_THR
#define ATT_THR 16.0f
#endif

constexpr size_t MiB = 1u << 20;
constexpr size_t WS_W1T = 0, WS_W2T = 32 * MiB, WS_GLUT = 64 * MiB, WS_QKVT = 72 * MiB, WS_WOT = 78 * MiB, WS_FWT = 80 * MiB;
constexpr size_t WS_ZERO = 474 * MiB, WS_CTL = 475 * MiB, CTL_BYTES = 16384;
constexpr size_t WS_PART = 476 * MiB;
constexpr int KSPLIT = 4;
constexpr size_t WS_MOD = 82 * MiB, WS_KTAB = 83 * MiB, WS_XCTX = 91 * MiB, WS_HN = 99 * MiB, WS_H = 202 * MiB, WS_END = 474 * MiB;
constexpr size_t WS_SLOC = WS_H, WS_W1S = WS_H + 68 * MiB, WS_W3S = WS_H + 84 * MiB, WS_Z = WS_H + 132 * MiB;
constexpr size_t WS_QK = WS_H, WS_VT = WS_H + 136 * MiB;
constexpr size_t WS_PQT = WS_H, WS_PQC = WS_H + 128 * MiB, WS_B2 = WS_H + 136 * MiB, WS_CS = WS_H + 264 * MiB, WS_CN256 = WS_H + 265 * MiB, WS_W1M = WS_H + 266 * MiB, WS_W2M = WS_H + 267 * MiB;

constexpr int LDS_BYTES = 147456;

struct Params {
    const float *x, *c, *ctx, *c_ctx, *w_mod, *b_mod, *norm_g, *mlp_w1, *mlp_w2;
    const float *s5_lre, *s5_lim, *s5_ldt, *s5_bre, *s5_bim, *s5_cre, *s5_cim, *s5_d, *s5_wglu;
    const float *wqkv, *qn, *kn, *dlam, *subln, *wo, *fw, *fb;
    float* out; unsigned char* ws;
    int ph_lo, ph_hi;
};

namespace pg8 {
constexpr int BM = 256, BK = 64, HALF = 128, HTB = HALF * BK * 2, STAGE_BYTES = 8 * HTB, NXCD = 8, WGM = 8;
__host__ __device__ __forceinline__ int lds_byte(int r, int c) { const int st = (r >> 4) * 2 + (c >> 5), rr = r & 15, cc = c & 31, ob = rr * 64 + cc * 2; return st * 1024 + (ob ^ (((ob >> 9) & 1) << 5)); }
__host__ __device__ __forceinline__ void stage_rc(int b, int& R, int& C) { const int st = b / 1024, sb = b % 1024, swz = sb ^ (((sb >> 9) & 1) << 5); R = (st >> 1) * 16 + swz / 64; C = (st & 1) * 32 + (swz % 64) / 2; }
__host__ __device__ __forceinline__ int perm32(int rho) { const int n = rho >> 4, i = rho & 15; return 8 * (i >> 2) + 4 * n + (i & 3); }

struct Unit { int pm, pn, pb; };
struct Gemm { const bf16_t* A; const bf16_t* Bt; int lda, ldb, K; size_t batchA, batchB; };
struct Sched {
    int nM, nN, nwg, G, c;
    int pm0;
    __device__ __forceinline__ void init(int nM_, int nN_, int nB_, int pm0_ = 0, int coff = 0) { nM = nM_; nN = nN_; nwg = nM_ * nN_ * nB_; G = gridDim.x; c = (blockIdx.x + coff) % gridDim.x; pm0 = pm0_; }
    __device__ __forceinline__ bool next(int i, Unit& u) const {
        const long L = (long)i * G + c; if (L >= nwg) return false;
        int wgid = (int)L; { const int q = nwg / NXCD, r = nwg % NXCD, xcd = wgid % NXCD, off = wgid / NXCD; wgid = (xcd < r ? xcd * (q + 1) : r * (q + 1) + (xcd - r) * q) + off; }
        const int upb = nM * nN; u.pb = wgid / upb; const int w = wgid - u.pb * upb;
        const int nig = WGM * nN, gid = w / nig, fm = gid * WGM, gsz = (nM - fm) < WGM ? (nM - fm) : WGM;
        u.pm = pm0 + fm + ((w % nig) % gsz); u.pn = (w % nig) / gsz; return true;
    }
};

template <class Epi>
__device__ __forceinline__ void gemm_phase(LAS unsigned char* lds, const Gemm g, const Sched& S, const Epi& E, int wave0) {
    const int tid = fresh_tid(wave0), wid = __builtin_amdgcn_readfirstlane(tid >> 6), lane = tid & 63, wr = wid >> 2, wc = wid & 3, fr = lane & 15, fq = lane >> 4;
    const int nt = g.K / BK;
    unsigned voffA[2], voffB[2];
#pragma unroll
    for (int i = 0; i < 2; ++i) { int R, C; stage_rc(tid * 16 + i * 8192, R, C); const int Rb = Epi::PERM ? ((R & ~31) + perm32(R & 31)) : R;
        voffA[i] = (unsigned)(R * g.lda + C) * 2u; voffB[i] = (unsigned)(Rb * g.ldb + C) * 2u; }
    const size_t kstep = (size_t)(BK * 2);
    const size_t hstepA = (size_t)HALF * g.lda * 2, hstepB = (size_t)HALF * g.ldb * 2;
    const unsigned ldsw = (unsigned)wid * 1024u;
    const int aoff = lds_byte(wr * 64 + fr, fq * 8), boff = lds_byte(wc * 32 + fr, fq * 8);
#define PG8_APTR(u) ((const char*)(g.A + (size_t)(u).pb * g.batchA + (size_t)(u).pm * BM * g.lda))
#define PG8_BPTR(u) ((const char*)(g.Bt + (size_t)(u).pb * g.batchB + (size_t)(u).pn * BM * g.ldb))
#define PG8_SA(b, h) (((b) * 2 + (h)) * HTB)
#define PG8_SB(b, h) ((4 + (b) * 2 + (h)) * HTB)
#define PG8_STAGE(bufoff, gbase, voff) do { const char* gb_ = (const char*)(gbase); asm volatile("" : "+s"(gb_)); _Pragma("unroll") for (int _i = 0; _i < 2; ++_i) \
        __builtin_amdgcn_global_load_lds((const unsigned*)(gb_ + (voff)[_i]), (LAS unsigned*)(lds + (bufoff) + ldsw + _i * 8192), 16, 0, 0); } while (0)
#define PG8_LDA(dst, b, h) do { _Pragma("unroll") for (int m = 0; m < 4; ++m) _Pragma("unroll") for (int k = 0; k < 2; ++k) dst[m][k] = *(const LAS bf16x8*)(lds + PG8_SA(b, h) + aoff + m * 2048 + k * 1024); } while (0)
#define PG8_LDB(dst, b, h) do { _Pragma("unroll") for (int n = 0; n < 2; ++n) _Pragma("unroll") for (int k = 0; k < 2; ++k) dst[n][k] = *(const LAS bf16x8*)(lds + PG8_SB(b, h) + boff + n * 2048 + k * 1024); } while (0)
#define PG8_MMA(ai, bj, At, Bt) do { __builtin_amdgcn_s_setprio(1); _Pragma("unroll") for (int m = 0; m < 4; ++m) _Pragma("unroll") for (int n = 0; n < 2; ++n) _Pragma("unroll") for (int k = 0; k < 2; ++k) \
        acc[ai][bj][m][n] = __builtin_amdgcn_mfma_f32_16x16x32_bf16(Bt[n][k], At[m][k], acc[ai][bj][m][n], 0, 0, 0); __builtin_amdgcn_s_setprio(0); } while (0)
#define PG8_WAIT_V(n) asm volatile("s_waitcnt vmcnt(" #n ")" ::: "memory")
#define PG8_WAIT_L(n) asm volatile("s_waitcnt lgkmcnt(" #n ")" ::: "memory")
#define PG8_BAR __builtin_amdgcn_s_barrier()
#define PG8_SCHED __builtin_amdgcn_sched_barrier(0)
    Unit cur, nxt; int ui = 0;
    if (!S.next(0, cur)) return;
    f32x4 acc[2][2][4][2];
#pragma unroll
    for (int a = 0; a < 2; ++a)
#pragma unroll
        for (int b = 0; b < 2; ++b)
#pragma unroll
            for (int m = 0; m < 4; ++m)
#pragma unroll
                for (int n = 0; n < 2; ++n) acc[a][b][m][n] = (f32x4){0.f, 0.f, 0.f, 0.f};
    bf16x8 At[4][2], B0[2][2], B1[2][2];
    const char* cA = PG8_APTR(cur); const char* cB = PG8_BPTR(cur);
    PG8_STAGE(PG8_SB(0, 0), cB, voffB); PG8_STAGE(PG8_SB(0, 1), cB + hstepB, voffB); PG8_STAGE(PG8_SA(0, 0), cA, voffA); PG8_STAGE(PG8_SA(0, 1), cA + hstepA, voffA);
    if (wr == 1) PG8_BAR;
    PG8_WAIT_V(2); PG8_BAR;
    PG8_STAGE(PG8_SB(1, 0), cB + kstep, voffB); PG8_STAGE(PG8_SA(1, 0), cA + kstep, voffA); PG8_STAGE(PG8_SB(1, 1), cB + hstepB + kstep, voffB);
    PG8_WAIT_V(6); PG8_BAR;
    for (;;) {
        const bool has_next = S.next(ui + 1, nxt);
        const char* nA = has_next ? PG8_APTR(nxt) : cA; const char* nB = has_next ? PG8_BPTR(nxt) : cB;
        for (int t = 0; t < nt; t += 2) {
            const bool last = (t == nt - 2);
            const char* a1 = cA + (size_t)(t + 1) * kstep;
            const char* a2 = last ? nA : cA + (size_t)(t + 2) * kstep; const char* b2 = last ? nB : cB + (size_t)(t + 2) * kstep;
            const char* a3 = a2 + kstep; const char* b3 = b2 + kstep;
            PG8_LDB(B0, 0, 0); PG8_LDB(B1, 0, 1); PG8_SCHED; PG8_LDA(At, 0, 0); PG8_STAGE(PG8_SA(1, 1), a1 + hstepA, voffA);
            PG8_WAIT_V(8); PG8_WAIT_L(0); PG8_BAR; PG8_MMA(0, 0, At, B0); PG8_MMA(0, 1, At, B1); PG8_BAR; PG8_SCHED;
            PG8_LDA(At, 0, 1); PG8_STAGE(PG8_SB(0, 0), b2, voffB); PG8_STAGE(PG8_SB(0, 1), b2 + hstepB, voffB); PG8_STAGE(PG8_SA(0, 0), a2, voffA);
            PG8_WAIT_V(8); PG8_WAIT_L(0); PG8_BAR; PG8_MMA(1, 0, At, B0); PG8_MMA(1, 1, At, B1); PG8_BAR; PG8_SCHED;
            PG8_LDB(B0, 1, 0); PG8_LDB(B1, 1, 1); PG8_SCHED; PG8_LDA(At, 1, 0); PG8_STAGE(PG8_SA(0, 1), a2 + hstepA, voffA);
            PG8_WAIT_V(8); PG8_WAIT_L(0); PG8_BAR; PG8_MMA(0, 0, At, B0); PG8_MMA(0, 1, At, B1); PG8_BAR; PG8_SCHED;
            PG8_LDA(At, 1, 1); PG8_STAGE(PG8_SB(1, 0), b3, voffB); PG8_STAGE(PG8_SB(1, 1), b3 + hstepB, voffB); PG8_STAGE(PG8_SA(1, 0), a3, voffA);
            PG8_WAIT_V(8); PG8_WAIT_L(0); PG8_BAR; PG8_MMA(1, 0, At, B0); PG8_MMA(1, 1, At, B1); PG8_BAR; PG8_SCHED;
        }
        if (wr == 0) PG8_BAR;
        { int l2_; asm volatile("v_mbcnt_lo_u32_b32 %0, -1, 0\n\tv_mbcnt_hi_u32_b32 %0, -1, %0" : "=v"(l2_)); E(acc, cur, wr, wc, l2_ & 15, l2_ >> 4); }
        if (!has_next) break;
#pragma unroll
        for (int a = 0; a < 2; ++a)
#pragma unroll
            for (int b = 0; b < 2; ++b)
#pragma unroll
                for (int m = 0; m < 4; ++m)
#pragma unroll
                    for (int n = 0; n < 2; ++n) acc[a][b][m][n] = (f32x4){0.f, 0.f, 0.f, 0.f};
        cur = nxt; cA = nA; cB = nB; ++ui;
        if (wr == 1) PG8_BAR;
    }
    PG8_WAIT_V(0);
    PG8_BAR;
#undef PG8_APTR
#undef PG8_BPTR
#undef PG8_SA
#undef PG8_SB
#undef PG8_STAGE
#undef PG8_LDA
#undef PG8_LDB
#undef PG8_MMA
#undef PG8_WAIT_V
#undef PG8_WAIT_L
#undef PG8_BAR
#undef PG8_SCHED
}

typedef f32x4 Acc[2][2][4][2];

template <int ACT  > struct EpiStore {
    static constexpr bool PERM = true;
    bf16_t* O; size_t ldc, bstride;
    __device__ __forceinline__ void operator()(const Acc& acc, const Unit& u, int wr, int wc, int fr, int fq) const {
        LAUNDER_V(fr); LAUNDER_V(fq);
        const int row0 = u.pm * BM + wr * 64 + fr, col0 = u.pn * BM + wc * 32 + 8 * fq;
        bf16_t* base = O + (size_t)u.pb * bstride;
#pragma unroll
        for (int ai = 0; ai < 2; ++ai)
#pragma unroll
            for (int m = 0; m < 4; ++m) { bf16_t* rowp = base + (size_t)(row0 + ai * HALF + m * 16) * ldc + col0;
#pragma unroll
                for (int bj = 0; bj < 2; ++bj) { f32x4 v0 = acc[ai][bj][m][0], v1 = acc[ai][bj][m][1];
                    if (ACT == 1) {
#pragma unroll
                        for (int e = 0; e < 4; ++e) { float a = fmaxf(v0[e], 0.f), b = fmaxf(v1[e], 0.f); v0[e] = a * a; v1[e] = b * b; } }
                    u32x4 w; w.x = pk2(v0[0], v0[1]); w.y = pk2(v0[2], v0[3]); w.z = pk2(v1[0], v1[1]); w.w = pk2(v1[2], v1[3]);
                    *(u32x4*)(rowp + bj * HALF) = w; } }
    }
};

struct EpiResid {
    static constexpr bool PERM = false;
    const float* base_lat; const float* base_ctx; float* out_lat; float* out_ctx; const float* gate; const float* bias;
    __device__ __forceinline__ void operator()(const Acc& acc, const Unit& u, int wr, int wc, int fr, int fq) const {
        LAUNDER_V(fr); LAUNDER_V(fq);
        const float* bp; float* op; int rbase, mi;
        if (u.pm < 128) { bp = base_lat; op = out_lat; rbase = u.pm * BM; mi = u.pm >> 4; } else { bp = base_ctx; op = out_ctx; rbase = (u.pm - 128) * BM; mi = 8; }
        const int col0 = u.pn * BM + wc * 32 + 4 * fq;
        f32x4 gv[2][2], bv[2][2];
#pragma unroll
        for (int bj = 0; bj < 2; ++bj)
#pragma unroll
            for (int n = 0; n < 2; ++n) { gv[bj][n] = *(const f32x4*)(gate + mi * (NMOD * D) + col0 + bj * HALF + n * 16);
                bv[bj][n] = bias ? *(const f32x4*)(bias + col0 + bj * HALF + n * 16) : (f32x4){0.f, 0.f, 0.f, 0.f}; }
#pragma unroll
        for (int ai = 0; ai < 2; ++ai)
#pragma unroll
            for (int m = 0; m < 4; ++m) { const size_t off = (size_t)(rbase + ai * HALF + wr * 64 + m * 16 + fr) * D + col0;
#pragma unroll
                for (int bj = 0; bj < 2; ++bj)
#pragma unroll
                    for (int n = 0; n < 2; ++n) { const f32x4 xv = *(const f32x4*)(bp + off + bj * HALF + n * 16);
                        *(f32x4*)(op + off + bj * HALF + n * 16) = xv + gv[bj][n] * (acc[ai][bj][m][n] + bv[bj][n]); } }
    }
};

struct EpiQK {
    static constexpr bool PERM = false;
    bf16_t* QKo; const float* qn; const float* kn;
    __device__ __forceinline__ void operator()(const Acc& acc, const Unit& u, int wr, int wc, int fr, int fq) const {
        LAUNDER_V(fr); LAUNDER_V(fq);
        const int lane = fq * 16 + fr, hc = u.pn * 4 + wc; const bool isq = hc < 16;
        const float* nwp = (isq ? qn : kn) + 4 * fq;
        f32x4 nw[2][2];
#pragma unroll
        for (int bj = 0; bj < 2; ++bj)
#pragma unroll
            for (int n = 0; n < 2; ++n) nw[bj][n] = *(const f32x4*)(nwp + 32 * bj + 16 * n);
        float invf[4];
#pragma unroll
        for (int i = 0; i < 4; ++i) invf[i] = __builtin_amdgcn_exp2f(-(float)(4 * fq + i) * 0.8304820237218406f) * 0.15915494309189535f;
        const float qs = isq ? QSCALE : 1.f;
#pragma unroll
        for (int ai = 0; ai < 2; ++ai)
#pragma unroll
            for (int m = 0; m < 4; ++m) { const int row = u.pm * BM + ai * HALF + wr * 64 + m * 16 + fr;
                float ss = 0.f;
#pragma unroll
                for (int bj = 0; bj < 2; ++bj)
#pragma unroll
                    for (int n = 0; n < 2; ++n) { const f32x4 a = acc[ai][bj][m][n]; ss += (a[0] * a[0] + a[1] * a[1]) + (a[2] * a[2] + a[3] * a[3]); }
                ss += shx(ss, lane, 16); ss += shx(ss, lane, 32);
                const float rstd = rsqrtf(ss * (1.f / 64.f) + EPS) ;
                const int l = row & 4095; const float posr = (float)(l >> 6), posc = (float)(l & 63);
                bf16_t* op = QKo + (size_t)row * 2048 + hc * 64 + 4 * fq;
#pragma unroll
                for (int bj = 0; bj < 2; ++bj) { f32x4 x1 = acc[ai][bj][m][0] * rstd * nw[bj][0], x2 = acc[ai][bj][m][1] * rstd * nw[bj][1];
                    if (row < TL) { const float pos = bj ? posc : posr;
#pragma unroll
                        for (int i = 0; i < 4; ++i) { const float rev = pos * invf[i]; const float cs = __builtin_amdgcn_cosf(rev), sn = __builtin_amdgcn_sinf(rev);
                            const float a = x1[i], b = x2[i]; x1[i] = a * cs - b * sn; x2[i] = a * sn + b * cs; } }
                    x1 *= qs; x2 *= qs;
                    *(u32x2*)(op + 32 * bj) = (u32x2){pk2(x1[0], x1[1]), pk2(x1[2], x1[3])};
                    *(u32x2*)(op + 32 * bj + 16) = (u32x2){pk2(x2[0], x2[1]), pk2(x2[2], x2[3])}; } }
    }
};

struct EpiPart {
    static constexpr bool PERM = false;
    float* P;
    __device__ __forceinline__ void operator()(const Acc& acc, const Unit& u, int wr, int wc, int fr, int fq) const {
        LAUNDER_V(fr); LAUNDER_V(fq);
        const int col0 = u.pn * BM + wc * 32 + 4 * fq;
#pragma unroll
        for (int ai = 0; ai < 2; ++ai)
#pragma unroll
            for (int m = 0; m < 4; ++m) { float* rp = P + ((size_t)u.pb * TC + (u.pm - 128) * BM + ai * HALF + wr * 64 + m * 16 + fr) * D + col0;
#pragma unroll
                for (int bj = 0; bj < 2; ++bj)
#pragma unroll
                    for (int n = 0; n < 2; ++n) *(f32x4*)(rp + bj * HALF + n * 16) = acc[ai][bj][m][n]; }
    }
};

struct EpiGlu {
    static constexpr bool PERM = false;
    const float* base_lat; const float* base_ctx; float* out_lat; float* out_ctx; const float* gate;
    __device__ __forceinline__ void operator()(const Acc& acc, const Unit& u, int wr, int wc, int fr, int fq) const {
        LAUNDER_V(fr); LAUNDER_V(fq);
        const float* bp; float* op; int rbase, mi;
        if (u.pm < 128) { bp = base_lat; op = out_lat; rbase = u.pm * BM; mi = u.pm >> 4; } else { bp = base_ctx; op = out_ctx; rbase = (u.pm - 128) * BM; mi = 8; }
        const int col0 = u.pn * HALF + wc * 32 + 4 * fq;
        f32x4 gv[2];
#pragma unroll
        for (int n = 0; n < 2; ++n) gv[n] = *(const f32x4*)(gate + mi * (NMOD * D) + col0 + n * 16);
#pragma unroll
        for (int ai = 0; ai < 2; ++ai)
#pragma unroll
            for (int m = 0; m < 4; ++m) { const size_t off = (size_t)(rbase + ai * HALF + wr * 64 + m * 16 + fr) * D + col0;
#pragma unroll
                for (int n = 0; n < 2; ++n) { const f32x4 xv = *(const f32x4*)(bp + off + n * 16); const f32x4 v = acc[ai][0][m][n], gt = acc[ai][1][m][n]; f32x4 o;
#pragma unroll
                    for (int e = 0; e < 4; ++e) o[e] = xv[e] + gv[n][e] * v[e] * sigmoidf_(gt[e]);
                    *(f32x4*)(op + off + n * 16) = o; } }
    }
};

struct EpiSloc {
    static constexpr bool PERM = false;
    float* S;
    __device__ __forceinline__ void operator()(const Acc& acc, const Unit& u, int wr, int wc, int fr, int fq) const {
        LAUNDER_V(fr); LAUNDER_V(fq);
        const int col0 = wc * 32 + 4 * fq;
#pragma unroll
        for (int ai = 0; ai < 2; ++ai)
#pragma unroll
            for (int m = 0; m < 4; ++m) { const int ci = u.pm * BM + ai * HALF + wr * 64 + m * 16 + fr;
                if (ci < NCH) { float* rp = S + ((size_t)u.pb * NCH + ci) * 256 + col0;
#pragma unroll
                    for (int bj = 0; bj < 2; ++bj)
#pragma unroll
                        for (int n = 0; n < 2; ++n) *(f32x4*)(rp + bj * HALF + n * 16) = acc[ai][bj][m][n]; } }
    }
};

struct EpiZ {
    static constexpr bool PERM = false;
    bf16_t* Z;
    __device__ __forceinline__ void operator()(const Acc& acc, const Unit& u, int wr, int wc, int fr, int fq) const {
        LAUNDER_V(fr); LAUNDER_V(fq);
#pragma unroll
        for (int ai = 0; ai < 2; ++ai)
#pragma unroll
            for (int m = 0; m < 4; ++m) { const int ci = u.pm * BM + ai * HALF + wr * 64 + m * 16 + fr;
                if (ci < NCH) { const int b = ci / 136, cc = ci - b * 136; const int tok0 = cc < 8 ? TL + b * 256 + cc * 32 : b * 4096 + (cc - 8) * 32;
#pragma unroll
                    for (int bj = 0; bj < 2; ++bj)
#pragma unroll
                        for (int n = 0; n < 2; ++n) { const int t = 16 * u.pn + 8 * bj + 2 * wc + n; const f32x4 v = acc[ai][bj][m][n];
                            u32x2 w; w.x = pk2(gelu_tanh(v[0]), gelu_tanh(v[1])); w.y = pk2(gelu_tanh(v[2]), gelu_tanh(v[3]));
                            *(u32x2*)(Z + (size_t)(tok0 + t) * D + u.pb * 16 + 4 * fq) = w; } } }
    }
};

struct EpiChanDft {
    static constexpr bool PERM = true;
    bf16_t* PQ1; bf16_t* PQC;
    __device__ __forceinline__ void operator()(const Acc& acc, const Unit& u, int wr, int wc, int fr, int fq) const {
        LAUNDER_V(fr); LAUNDER_V(fq);
        if (u.pn < 128) {
            const int b = u.pn >> 4;
#pragma unroll
            for (int ai = 0; ai < 2; ++ai)
#pragma unroll
                for (int m = 0; m < 4; ++m) { const int kc = ai * HALF + wr * 64 + m * 16 + fr;
                    bf16_t* rowp = PQ1 + (size_t)(b * 1024 + u.pb * 256 + kc) * 8192 + u.pm * 64;
#pragma unroll
                    for (int bj = 0; bj < 2; ++bj) { const int tp = (u.pn & 15) * 256 + bj * HALF + wc * 32 + 8 * fq;
                        const f32x4 v0 = acc[ai][bj][m][0], v1 = acc[ai][bj][m][1];
                        u32x4 w; w.x = pk2(v0[0], v0[1]); w.y = pk2(v0[2], v0[3]); w.z = pk2(v1[0], v1[1]); w.w = pk2(v1[2], v1[3]);
                        *(u32x4*)(rowp + (tp >> 6) * 128 + (tp & 63)) = w; } }
        } else {
            const int b = u.pn - 128;
            bf16_t* base = PQC + (size_t)(b * 1024 + u.pb * 256) * 512 + (size_t)u.pm * 256 + wc * 32 + 8 * fq;
#pragma unroll
            for (int ai = 0; ai < 2; ++ai)
#pragma unroll
                for (int m = 0; m < 4; ++m) { bf16_t* rowp = base + (size_t)(ai * HALF + wr * 64 + m * 16 + fr) * 512;
#pragma unroll
                    for (int bj = 0; bj < 2; ++bj) { const f32x4 v0 = acc[ai][bj][m][0], v1 = acc[ai][bj][m][1];
                        u32x4 w; w.x = pk2(v0[0], v0[1]); w.y = pk2(v0[2], v0[3]); w.z = pk2(v1[0], v1[1]); w.w = pk2(v1[2], v1[3]);
                        *(u32x4*)(rowp + bj * HALF) = w; } }
        }
    }
};

struct EpiFft1 {
    static constexpr bool PERM = true;
    bf16_t* B2;
    __device__ __forceinline__ void operator()(const Acc& acc, const Unit& u, int wr, int wc, int fr, int fq) const {
        LAUNDER_V(fr); LAUNDER_V(fq);
        if (wr != 0) return;
#pragma unroll
        for (int m = 0; m < 4; ++m) { const int m2 = 16 * m + fr;
#pragma unroll
            for (int bj = 0; bj < 2; ++bj) { const int n0 = u.pn * BM + bj * HALF + wc * 32 + 8 * fq; const int k2 = n0 & 63, c = (n0 >> 6) & 1023, b = n0 >> 16;
                float br[8], bi[8];
#pragma unroll
                for (int e = 0; e < 8; ++e) { const float ar = acc[0][bj][m][e >> 2][e & 3], ai_ = acc[1][bj][m][e >> 2][e & 3];
                    const float rev = (float)(m2 * (k2 + e)) * (1.f / 4096.f); const float cs = __builtin_amdgcn_cosf(rev), sn = __builtin_amdgcn_sinf(rev);
                    br[e] = (ar * cs + ai_ * sn) * (1.f / 64.f); bi[e] = (ai_ * cs - ar * sn) * (1.f / 64.f); }
                bf16_t* op = B2 + ((size_t)(b * 64 + m2) * 1024 + c) * 128 + k2;
                *(u32x4*)(op) = (u32x4){pk2(br[0], br[1]), pk2(br[2], br[3]), pk2(br[4], br[5]), pk2(br[6], br[7])};
                *(u32x4*)(op + 64) = (u32x4){pk2(bi[0], bi[1]), pk2(bi[2], bi[3]), pk2(bi[4], bi[5]), pk2(bi[6], bi[7])}; } }
    }
};

struct EpiFft2 {
    static constexpr bool PERM = true;
    bf16_t* F;
    __device__ __forceinline__ void operator()(const Acc& acc, const Unit& u, int wr, int wc, int fr, int fq) const {
        LAUNDER_V(fr); LAUNDER_V(fq);
        if (wr != 0) return;
#pragma unroll
        for (int m = 0; m < 4; ++m) { const int m1 = 16 * m + fr;
#pragma unroll
            for (int bj = 0; bj < 2; ++bj) { const int n0 = u.pn * BM + bj * HALF + wc * 32 + 8 * fq; const int c = n0 & 1023, m2 = (n0 >> 10) & 63, b = n0 >> 16;
                const f32x4 v0 = acc[0][bj][m][0], v1 = acc[0][bj][m][1];
                *(u32x4*)(F + (size_t)(b * 4096 + 64 * m1 + m2) * D + c) = (u32x4){pk2(v0[0], v0[1]), pk2(v0[2], v0[3]), pk2(v1[0], v1[1]), pk2(v1[2], v1[3])}; } }
    }
};
}

__device__ __forceinline__ void transpose_item(const float* W, int K, int N, bf16_t* WT, int glu, LAS float* scr, int item, int lane) {
    const int nblk = N / 32, kb = item / nblk, nb = item % nblk, k0 = 64 * kb, n0 = 32 * nb;
#pragma unroll 8
    for (int i = 0; i < 32; ++i) { const int kk = 2 * i + (lane >> 5); scr[kk * 33 + (lane & 31)] = W[(size_t)(k0 + kk) * N + n0 + (lane & 31)]; }
    asm volatile("s_waitcnt lgkmcnt(0)" ::: "memory");
    const int n0p = glu == 1 ? (((n0 & 1023) >> 7) * 256 + (n0 >> 10) * 128 + (n0 & 127))
                  : (glu == 2 && n0 < 2048) ? ((n0 & ~255) | (((n0 >> 5) & 1) << 7) | (((n0 >> 6) & 3) << 5)) : n0;
    const int c = lane & 7;
#pragma unroll
    for (int j = 0; j < 4; ++j) { const int n = (lane >> 3) + 8 * j; const LAS float* s = scr + (8 * c) * 33 + n;
        u32x4 o; o.x = pk2(s[0 * 33], s[1 * 33]); o.y = pk2(s[2 * 33], s[3 * 33]); o.z = pk2(s[4 * 33], s[5 * 33]); o.w = pk2(s[6 * 33], s[7 * 33]);
        *(u32x4*)(WT + (size_t)(n0p + n) * K + k0 + 8 * c) = o; }
    asm volatile("s_waitcnt lgkmcnt(0)" ::: "memory");
}

__device__ __forceinline__ const float* xrow_ptr(const float* xl, const float* xc, int row) { return row < TL ? xl + (size_t)row * D : xc + (size_t)(row - TL) * D; }

struct CtxFix { const float* part; const float* pgate; const float* pbias; float* xw; };
__device__ __forceinline__ void norm_rows_tok(const float* xl, const float* xc, const float* g, const float* modl  , int sidx, bf16_t* out, int nrows, int gw, int ngw, int lane, bool perm64, const CtxFix fx) {
    for (int row = gw; row < nrows; row += ngw) {
        const f32x4* xr = (const f32x4*)xrow_ptr(xl, xc, row) + lane;
        f32x4 v[4]; float ss = 0.f;
#pragma unroll
        for (int j = 0; j < 4; ++j) v[j] = xr[64 * j];
        if (fx.part && row >= TL) {
#pragma unroll
            for (int j = 0; j < 4; ++j) { const int c = 4 * lane + 256 * j; f32x4 s = fx.pbias ? *(const f32x4*)(fx.pbias + c) : (f32x4){0.f, 0.f, 0.f, 0.f};
#pragma unroll
                for (int k = 0; k < KSPLIT; ++k) s += *(const f32x4*)(fx.part + ((size_t)k * TC + (row - TL)) * D + c);
                v[j] += *(const f32x4*)(fx.pgate + c) * s;
                *(f32x4*)(fx.xw + (size_t)(row - TL) * D + c) = v[j]; } }
#pragma unroll
        for (int j = 0; j < 4; ++j) ss += (v[j].x * v[j].x + v[j].y * v[j].y) + (v[j].z * v[j].z + v[j].w * v[j].w);
        const float rstd = rsqrtf(wave_sum(ss, lane) * (1.f / D) + EPS);
        const int mi = row < TL ? row >> 12 : 8;
        const float* sh = modl + mi * (NMOD * D) + sidx * D; const float* sc = sh + D;
        const int orow = (perm64 && row < TL) ? ((row & ~4095) | ((row & 63) << 6) | ((row & 4095) >> 6)) : row;
        unsigned long long* o8 = (unsigned long long*)(out + (size_t)orow * D) + lane;
#pragma unroll
        for (int j = 0; j < 4; ++j) { const int c = 4 * lane + 256 * j; const f32x4 gg = *(const f32x4*)(g + c), s1 = *(const f32x4*)(sc + c), s0 = *(const f32x4*)(sh + c);
            f32x4 y;
#pragma unroll
            for (int e = 0; e < 4; ++e) y[e] = v[j][e] * rstd * gg[e] * (1.f + s1[e]) + s0[e];
            o8[64 * j] = (unsigned long long)pk2(y[0], y[1]) | ((unsigned long long)pk2(y[2], y[3]) << 32); }
    }
}
__device__ __forceinline__ void norm_rows_s5(const float* xl, const float* xc, const float* g, const float* modl, bf16_t* ug, int gw, int ngw, int lane, const CtxFix fx) {
    for (int row = gw; row < TA; row += ngw) {
        const f32x4* xr = (const f32x4*)xrow_ptr(xl, xc, row) + 4 * lane;
        f32x4 v[4]; float ss = 0.f;
#pragma unroll
        for (int j = 0; j < 4; ++j) v[j] = xr[j];
        if (fx.part && row >= TL) {
#pragma unroll
            for (int j = 0; j < 4; ++j) { const int c = 16 * lane + 4 * j; f32x4 s = fx.pbias ? *(const f32x4*)(fx.pbias + c) : (f32x4){0.f, 0.f, 0.f, 0.f};
#pragma unroll
                for (int k = 0; k < KSPLIT; ++k) s += *(const f32x4*)(fx.part + ((size_t)k * TC + (row - TL)) * D + c);
                v[j] += *(const f32x4*)(fx.pgate + c) * s;
                *(f32x4*)(fx.xw + (size_t)(row - TL) * D + c) = v[j]; } }
#pragma unroll
        for (int j = 0; j < 4; ++j) ss += (v[j].x * v[j].x + v[j].y * v[j].y) + (v[j].z * v[j].z + v[j].w * v[j].w);
        const float rstd = rsqrtf(wave_sum(ss, lane) * (1.f / D) + EPS);
        int mi, b, pos; if (row < TL) { b = row >> 12; pos = 256 + (row & 4095); mi = b; } else { b = (row - TL) >> 8; pos = (row - TL) & 255; mi = 8; }
        const float* sh = modl + mi * (NMOD * D); const float* sc = sh + D;
        const int chunk = b * 136 + (pos >> 5), s = pos & 31;
        unsigned w[8];
#pragma unroll
        for (int j = 0; j < 4; ++j) { const int c = 16 * lane + 4 * j; const f32x4 gg = *(const f32x4*)(g + c), s1 = *(const f32x4*)(sc + c), s0 = *(const f32x4*)(sh + c);
            f32x4 y;
#pragma unroll
            for (int e = 0; e < 4; ++e) y[e] = v[j][e] * rstd * gg[e] * (1.f + s1[e]) + s0[e];
            w[2 * j] = pk2(y[0], y[1]); w[2 * j + 1] = pk2(y[2], y[3]); }
        u32x4* op = (u32x4*)(ug + ((size_t)lane * NCH + chunk) * UGP + s * 16);
        op[0] = (u32x4){w[0], w[1], w[2], w[3]}; op[1] = (u32x4){w[4], w[5], w[6], w[7]};
    }
}

__device__ __forceinline__ void cpow(float lr_dt, float li_dt, float k, float& re, float& im) {
    const float mag = __expf(k * lr_dt); const float rev = k * li_dt * 0.15915494309189535f;
    re = mag * __builtin_amdgcn_cosf(rev); im = mag * __builtin_amdgcn_sinf(rev);
}
__device__ __forceinline__ void s5_kcoef(float lr, float li, float dt, float& kr, float& ki) {
    const float th = li * dt; const float rv = th * 0.15915494309189535f;
    const float c = __builtin_amdgcn_cosf(rv), s = __builtin_amdgcn_sinf(rv), sh = __builtin_amdgcn_sinf(0.5f * rv);
    const float em1 = expm1f(lr * dt);
    const float nre = em1 * c - 2.f * sh * sh, nim = (em1 + 1.f) * s;
    const float den = lr * lr + li * li;
    kr = (nre * lr + nim * li) / den; ki = (nim * lr - nre * li) / den;
}


#define XB_TMO      128
#define XB_XCNT(j)  (256  + 64 * (j))
#define XB_XSUB(j)  (1280 + 64 * (j))
#define XB_XGEN(j)  (2304 + 64 * (j))
#define XB_TOP      3328
#define XB_TOPGEN   3392
#define XCD_BAR_WORDS 3456
#define XB_SPIN_CAP (1u << 18)
__device__ __forceinline__ unsigned xb_ld(unsigned* p)              { return __hip_atomic_load(p, __ATOMIC_RELAXED, __HIP_MEMORY_SCOPE_AGENT); }
__device__ __forceinline__ unsigned xb_add(unsigned* p, unsigned v) { return __hip_atomic_fetch_add(p, v, __ATOMIC_RELAXED, __HIP_MEMORY_SCOPE_AGENT); }
__device__ __forceinline__ unsigned xb_xcc_id() { return (unsigned)__builtin_amdgcn_s_getreg((3 << 11) | 20) & 0xFu; }
#define XB_SPIN(cond, bar) do { unsigned _sp = 0; while (cond) { __builtin_amdgcn_s_sleep(1); \
    if ((++_sp & 255u) == 0u) { if (xb_ld(&(bar)[XB_TMO])) break; if (_sp > XB_SPIN_CAP) { atomicAdd(&(bar)[XB_TMO], 1u); break; } } } } while (0)
struct XcdBarrier { unsigned* bar; unsigned x; volatile LAS unsigned* st; };
__device__ __forceinline__ XcdBarrier xcd_barrier_post(unsigned* bar, volatile LAS unsigned* st) {
    XcdBarrier b; b.bar = bar; b.x = xb_xcc_id(); b.st = st;
    if (threadIdx.x == 0) (void)xb_add(&bar[XB_XCNT(b.x)], 1u);
    return b;
}
__device__ __forceinline__ void xcd_barrier_complete(unsigned* bar, unsigned x, unsigned& nloc, unsigned& nx) {
    const unsigned G = gridDim.x * gridDim.y * gridDim.z;
    unsigned sum, cnt, mine, sp = 0u;
    for (;;) {
        sum = 0u; cnt = 0u; mine = 0u;
#pragma unroll
        for (unsigned j = 0; j < 16; ++j) { const unsigned c = xb_ld(&bar[XB_XCNT(j)]); sum += c; cnt += (c > 0u) ? 1u : 0u; mine = (j == x) ? c : mine; }
        if (sum == G) break;
        __builtin_amdgcn_s_sleep(1);
        if ((++sp & 255u) == 0u) { if (xb_ld(&bar[XB_TMO])) break; if (sp > XB_SPIN_CAP) { atomicAdd(&bar[XB_TMO], 1u); break; } }
    }
    nloc = mine > 0u ? mine : 1u; nx = cnt > 0u ? cnt : 1u;
}
__device__ __forceinline__ void xcd_barrier(const XcdBarrier& b) {
    asm volatile("s_waitcnt vmcnt(0)" ::: "memory");
    __syncthreads();
    if (threadIdx.x == 0) {
        unsigned* bar = b.bar;
        __builtin_amdgcn_s_waitcnt(0);
        unsigned nloc = b.st[0], nx = b.st[1];
        if (nloc == 0u) { xcd_barrier_complete(bar, b.x, nloc, nx); b.st[0] = nloc; b.st[1] = nx; }
        const unsigned old = xb_add(&bar[XB_XSUB(b.x)], 1u);
        const unsigned gen = old / nloc;
        if (old + 1u == (gen + 1u) * nloc) {
            __builtin_amdgcn_fence(__ATOMIC_RELEASE, "agent");
            asm volatile("s_waitcnt vmcnt(0)" ::: "memory");
            const unsigned og = xb_add(&bar[XB_TOP], 1u);
            const unsigned tg = og / nx;
            if (og + 1u == (tg + 1u) * nx) xb_add(&bar[XB_TOPGEN], 1u);
            else XB_SPIN(xb_ld(&bar[XB_TOPGEN]) == tg, bar);
            __builtin_amdgcn_fence(__ATOMIC_ACQUIRE, "agent");
            xb_add(&bar[XB_XGEN(b.x)], 1u);
            asm volatile("s_waitcnt vmcnt(0)" ::: "memory");
        } else {
            XB_SPIN(xb_ld(&bar[XB_XGEN(b.x)]) == gen, bar);
            __builtin_amdgcn_fence(__ATOMIC_ACQUIRE, "agent");
            asm volatile("s_waitcnt vmcnt(0)" ::: "memory");
        }
    }
    __syncthreads();
}

__global__ void __launch_bounds__(512) mega_fwd(Params p) {
    extern __shared__ __attribute__((aligned(16))) unsigned char lds_raw[];
    LAS unsigned char* lds = (LAS unsigned char*)lds_raw;
    cg::grid_group grid = cg::this_grid();
    const int G = gridDim.x, bid = blockIdx.x, NGW = G * 8;
    const int wave0 = __builtin_amdgcn_readfirstlane(threadIdx.x >> 6);
#define FRESH_IDS const int tid = fresh_tid(wave0), lane = tid & 63, wave = __builtin_amdgcn_readfirstlane(tid >> 6), gw = bid * 8 + wave; (void)lane; (void)gw
    unsigned char* ws = p.ws;
    bf16_t* W1T = (bf16_t*)(ws + WS_W1T); bf16_t* W2T = (bf16_t*)(ws + WS_W2T); bf16_t* GLUT = (bf16_t*)(ws + WS_GLUT);
    bf16_t* QKVT = (bf16_t*)(ws + WS_QKVT); bf16_t* WOT = (bf16_t*)(ws + WS_WOT); bf16_t* FWT = (bf16_t*)(ws + WS_FWT);
    float* MOD = (float*)(ws + WS_MOD); float* KTAB = (float*)(ws + WS_KTAB); float* XCTX = (float*)(ws + WS_XCTX);
    bf16_t* HN = (bf16_t*)(ws + WS_HN); bf16_t* HB = (bf16_t*)(ws + WS_H);
    int ph = 0;
#define PH_ON (ph >= p.ph_lo && ph < p.ph_hi)
    volatile LAS unsigned* bst = (volatile LAS unsigned*)(lds + LDS_BYTES - 64);
    if (threadIdx.x < 2) bst[threadIdx.x] = 0u;
    __syncthreads();
    const XcdBarrier xbar = xcd_barrier_post((unsigned*)(ws + WS_CTL), bst);
#define PH_END do { if (ph >= p.ph_lo && ph + 1 < p.ph_hi) { for (int r_ = 0; r_ < NREP(8); ++r_) { if (p.ph_hi < 0) grid.sync();     xcd_barrier(xbar); } } ++ph; } while (0)

    if (PH_ON) {
        FRESH_IDS;
        {
            LAS float* scr = (LAS float*)(lds + wave * 16384);
            constexpr int I_W1 = 16 * 128, I_W2 = 64 * 32, I_GLU = 16 * 64, I_QKV = 16 * 96, I_SQ = 16 * 32;
            constexpr int NIT = 4 * (I_W1 + I_W2) + 2 * I_GLU + I_QKV + 2 * I_SQ;
            for (int it = gw; it < NIT; it += NGW) {
                int r = it;
                if (r < 4 * I_W1) { const int l = r / I_W1; transpose_item(p.mlp_w1 + (size_t)l * D * DFF, D, DFF, W1T + (size_t)l * D * DFF, 0, scr, r % I_W1, lane); continue; } r -= 4 * I_W1;
                if (r < 4 * I_W2) { const int l = r / I_W2; transpose_item(p.mlp_w2 + (size_t)l * D * DFF, DFF, D, W2T + (size_t)l * D * DFF, 0, scr, r % I_W2, lane); continue; } r -= 4 * I_W2;
                if (r < 2 * I_GLU) { const int l = r / I_GLU; transpose_item(p.s5_wglu + (size_t)l * D * 2 * D, D, 2 * D, GLUT + (size_t)l * D * 2 * D, 1, scr, r % I_GLU, lane); continue; } r -= 2 * I_GLU;
                if (r < I_QKV) { transpose_item(p.wqkv, D, 3 * D, QKVT, 2, scr, r, lane); continue; } r -= I_QKV;
                if (r < I_SQ) { transpose_item(p.wo, D, D, WOT, 0, scr, r, lane); continue; } r -= I_SQ;
                transpose_item(p.fw, D, D, FWT, 0, scr, r, lane);
            }
        }
        if (REP_MASK) { for (int e = bid * 512 + tid; e < 9 * NMOD * D; e += G * 512) ((float*)(ws + WS_ZERO))[e] = 0.f; }
        __syncthreads();
        {
            LAS float* sc = (LAS float*)lds;
            LAS float* red = (LAS float*)(lds + 9 * 4096);
            for (int e = tid; e < 9 * D; e += 512) { const float v = e < 8 * D ? p.c[e] : p.c_ctx[e - 8 * D]; sc[e] = v * sigmoidf_(v); }
            __syncthreads();
            const int col = tid & 63, kp = tid >> 6;
            for (int item = bid; item < 4 * 96; item += G) {
                const int i = item / 96, nb = item % 96;
                float a[9];
#pragma unroll
                for (int r = 0; r < 9; ++r) a[r] = 0.f;
                const float* wp = p.w_mod + ((size_t)i * D + kp * 128) * (NMOD * D) + nb * 64 + col;
#pragma unroll 8
                for (int k = 0; k < 128; ++k) { const float w = wp[(size_t)k * (NMOD * D)];
#pragma unroll
                    for (int r = 0; r < 9; ++r) a[r] += sc[r * D + kp * 128 + k] * w; }
#pragma unroll
                for (int r = 0; r < 9; ++r) red[(kp * 64 + col) * 9 + r] = a[r];
                __syncthreads();
                for (int e = tid; e < 576; e += 512) { const int r = e >> 6, cc = e & 63; float s = p.b_mod[i * (NMOD * D) + nb * 64 + cc];
#pragma unroll
                    for (int q = 0; q < 8; ++q) s += red[(q * 64 + cc) * 9 + r];
                    MOD[((size_t)i * 9 + r) * (NMOD * D) + nb * 64 + cc] = s; }
                __syncthreads();
            }
        }
        {
            LAS float* Bb = (LAS float*)lds;
            LAS float* Cc = (LAS float*)(lds + 8192);
            LAS float* ap = (LAS float*)(lds + 16384);
            for (int item = bid; item < 256; item += G) {
                const int j = item >> 7, g = (item >> 1) & 63, dir = item & 1;
                const int pg = (j * 2 + dir) * 64 + g;
                const float dt = __expf(p.s5_ldt[pg]);
                __syncthreads();
                for (int e = tid; e < 1024; e += 512) { const int pp = e >> 4, h = e & 15; float kr, ki; s5_kcoef(p.s5_lre[pg * 64 + pp], p.s5_lim[pg * 64 + pp], dt, kr, ki);
                    const float br = p.s5_bre[((size_t)pg * 64 + pp) * 16 + h], bi = p.s5_bim[((size_t)pg * 64 + pp) * 16 + h];
                    Bb[e * 2] = kr * br - ki * bi; Bb[e * 2 + 1] = kr * bi + ki * br;
                    const int h2 = e >> 6, p2 = e & 63; Cc[e * 2] = p.s5_cre[((size_t)pg * 16 + h2) * 64 + p2]; Cc[e * 2 + 1] = p.s5_cim[((size_t)pg * 16 + h2) * 64 + p2]; }
                for (int e = tid; e < 2048; e += 512) { const int tau = e >> 6, pp = e & 63; float re, im; cpow(p.s5_lre[pg * 64 + pp] * dt, p.s5_lim[pg * 64 + pp] * dt, (float)tau, re, im); ap[e * 2] = re; ap[e * 2 + 1] = im; }
                __syncthreads();
                const int hh = tid & 255, h = hh >> 4, hp = hh & 15, th = tid >> 8;
                float a[16];
#pragma unroll
                for (int q = 0; q < 16; ++q) a[q] = 0.f;
                for (int pp = 0; pp < 64; ++pp) { const float cr = Cc[(h * 64 + pp) * 2], ci = Cc[(h * 64 + pp) * 2 + 1], br = Bb[(pp * 16 + hp) * 2], bi = Bb[(pp * 16 + hp) * 2 + 1];
                    const float cbr = cr * br - ci * bi, cbi = cr * bi + ci * br;
#pragma unroll
                    for (int q = 0; q < 16; ++q) { const float ar = ap[((th * 16 + q) * 64 + pp) * 2], ai = ap[((th * 16 + q) * 64 + pp) * 2 + 1]; a[q] += cbr * ar - cbi * ai; } }
#pragma unroll
                for (int q = 0; q < 16; ++q) KTAB[((((size_t)j * 64 + g) * 2 + dir) * 32 + th * 16 + q) * 256 + hh] = a[q];
            }
            __syncthreads();
        }
    }
    PH_END;

    for (int li = 0; li < 4; ++li) {
        const int kind = li % 3, jj = li / 3; const bool last = (li == 3);
        const float* xl = li == 0 ? p.x : p.out; const float* xc = li == 0 ? p.ctx : XCTX;
        const float* modl = MOD + (size_t)li * 9 * (NMOD * D);
        const float* ng = p.norm_g + (size_t)li * 2 * D;
        float* PART = (float*)(ws + WS_PART);
        const CtxFix fxA{li > 0 ? PART : nullptr, MOD + ((size_t)(li - 1) * 9 + 8) * (NMOD * D) + 5 * D, nullptr, XCTX};
        const CtxFix fxF{(kind != 0 && !last) ? PART : nullptr, modl + 8 * (NMOD * D) + 2 * D, kind == 2 ? p.fb : nullptr, XCTX};

        if (PH_ON) {
            FRESH_IDS;
            if (kind == 0) {
                for (int rep = 0; rep < NREP(3); ++rep) norm_rows_s5(xl, xc, ng, modl, HN, gw, NGW, lane, fxA);
                bf16_t* W1S = (bf16_t*)(ws + WS_W1S); bf16_t* W3S = (bf16_t*)(ws + WS_W3S);
                LAS float* apf = (LAS float*)lds;
                LAS float* apb = (LAS float*)(lds + 16896);
                LAS float* Cf = (LAS float*)(lds + 33792);
                LAS float* Cb = (LAS float*)(lds + 41984);
                LAS float* Bbf = (LAS float*)(lds + 50176);
                LAS float* Bbb = (LAS float*)(lds + 58368);
                for (int item = bid; item < 256; item += G) {
                    const int g = item >> 2, tq = item & 3;
                    __syncthreads();
                    for (int e = tid; e < 2 * 33 * 64; e += 512) { const int dir = e / (33 * 64), r = e % (33 * 64), k = r >> 6, pp = r & 63; const int pg = (jj * 2 + dir) * 64 + g;
                        const float dt = __expf(p.s5_ldt[pg]); float re, im; cpow(p.s5_lre[pg * 64 + pp] * dt, p.s5_lim[pg * 64 + pp] * dt, (float)k, re, im);
                        LAS float* d = dir ? apb : apf; d[r * 2] = re; d[r * 2 + 1] = im; }
                    for (int e = tid; e < 2048; e += 512) { const int dir = e >> 10, r = e & 1023; const int pg = (jj * 2 + dir) * 64 + g;
                        { const int h2 = r >> 6, p2 = r & 63; LAS float* d = dir ? Cb : Cf; d[r * 2] = p.s5_cre[((size_t)pg * 16 + h2) * 64 + p2]; d[r * 2 + 1] = p.s5_cim[((size_t)pg * 16 + h2) * 64 + p2]; }
                        { const int pp = r >> 4, h = r & 15; const float dt = __expf(p.s5_ldt[pg]); float kr, ki; s5_kcoef(p.s5_lre[pg * 64 + pp], p.s5_lim[pg * 64 + pp], dt, kr, ki);
                          const float br = p.s5_bre[((size_t)pg * 64 + pp) * 16 + h], bi = p.s5_bim[((size_t)pg * 64 + pp) * 16 + h];
                          LAS float* d = dir ? Bbb : Bbf; d[r * 2] = kr * br - ki * bi; d[r * 2 + 1] = kr * bi + ki * br; } }
                    __syncthreads();
                    for (int e = tid; e < 4096; e += 512) { const int ee = tq * 4096 + e; const int hh = ee & 1, s = (ee >> 1) & 31, pp = (ee >> 6) & 63, ri = (ee >> 12) & 1, dir = ee >> 13;
                        const int ex = dir ? s : 31 - s; const LAS float* apd = dir ? apb : apf; const LAS float* bd = dir ? Bbb : Bbf;
                        const float ar = apd[(ex * 64 + pp) * 2], ai = apd[(ex * 64 + pp) * 2 + 1];
                        float v[8];
#pragma unroll
                        for (int i = 0; i < 8; ++i) { const float br = bd[(pp * 16 + hh * 8 + i) * 2], bi = bd[(pp * 16 + hh * 8 + i) * 2 + 1]; v[i] = ri ? ar * bi + ai * br : ar * br - ai * bi; }
                        *(u32x4*)(W1S + ((size_t)(g * 256 + dir * 128 + ri * 64 + pp)) * 512 + s * 16 + hh * 8) = (u32x4){pk2(v[0], v[1]), pk2(v[2], v[3]), pk2(v[4], v[5]), pk2(v[6], v[7])}; }
                    const float* ktf = KTAB + (((size_t)jj * 64 + g) * 2 + 0) * 32 * 256; const float* ktb = ktf + 32 * 256;
                    for (int e = tid; e < 128 * 96; e += 512) { const int kc = e % 96, rowi = e / 96, t = tq * 8 + (rowi >> 4), h = rowi & 15;
                        float v[8];
                        if (kc < 64) { const int s = kc >> 1, h0 = (kc & 1) * 8;
#pragma unroll
                            for (int i = 0; i < 8; ++i) v[i] = 0.f;
                            if (s <= t) { const f32x4* kp = (const f32x4*)(ktf + (t - s) * 256 + h * 16 + h0); const f32x4 a = kp[0], b = kp[1];
#pragma unroll
                                for (int i = 0; i < 4; ++i) { v[i] += a[i]; v[4 + i] += b[i]; } }
                            if (s >= t) { const f32x4* kp = (const f32x4*)(ktb + (s - t) * 256 + h * 16 + h0); const f32x4 a = kp[0], b = kp[1];
#pragma unroll
                                for (int i = 0; i < 4; ++i) { v[i] += a[i]; v[4 + i] += b[i]; } }
                            if (s == t) { const float dd = p.s5_d[jj * D + g * 16 + h];
#pragma unroll
                                for (int i = 0; i < 8; ++i) if (h0 + i == h) v[i] += dd; }
                        } else { const int q = kc - 64, dir = q >> 4, ri = (q >> 3) & 1, p0 = (q & 7) * 8; const int ex = dir ? 32 - t : t + 1;
                            const LAS float* apd = dir ? apb : apf; const LAS float* cd = dir ? Cb : Cf;
#pragma unroll
                            for (int i = 0; i < 8; ++i) { const int pp = p0 + i; const float ar = apd[(ex * 64 + pp) * 2], ai = apd[(ex * 64 + pp) * 2 + 1], cr = cd[(h * 64 + pp) * 2], ci = cd[(h * 64 + pp) * 2 + 1];
                                v[i] = ri ? -(cr * ai + ci * ar) : cr * ar - ci * ai; } }
                        *(u32x4*)(W3S + ((size_t)(g * 512 + t * 16 + h)) * UGP + kc * 8) = (u32x4){pk2(v[0], v[1]), pk2(v[2], v[3]), pk2(v[4], v[5]), pk2(v[6], v[7])}; }
                }
                __syncthreads();
            } else {
                for (int rep = 0; rep < NREP(3); ++rep) norm_rows_tok(xl, xc, ng, modl, 0, HN, TA, gw, NGW, lane, kind == 2, fxA);
                if (kind == 2) {
                    bf16_t* CS = (bf16_t*)(ws + WS_CS); bf16_t* CN2 = (bf16_t*)(ws + WS_CN256); bf16_t* W1M = (bf16_t*)(ws + WS_W1M); bf16_t* W2M = (bf16_t*)(ws + WS_W2M);
                    const int gt = bid * 512 + tid, NT = G * 512;
                    for (int e = gt; e < 2 * 256 * 16; e += NT) { const int which = e >> 12, r = (e >> 4) & 255, kc = e & 15, k0 = (kc & 7) * 8, hs = kc >> 3; float v[8];
#pragma unroll
                        for (int i = 0; i < 8; ++i) { const int mm = r & 63; const float rev = (float)((mm * (k0 + i)) & 63) * (1.f / 64.f); const float cs = __builtin_amdgcn_cosf(rev), sn = __builtin_amdgcn_sinf(rev);
                            float val = 0.f;
                            if (which == 0) { if (r < 64) val = hs ? -sn : cs; else if (r >= 128 && r < 192) val = hs ? -cs : -sn; }
                            else { if (r < 64) val = hs ? sn : cs; }
                            v[i] = val; }
                        *(u32x4*)((which ? W2M : W1M) + (size_t)r * 128 + kc * 8) = (u32x4){pk2(v[0], v[1]), pk2(v[2], v[3]), pk2(v[4], v[5]), pk2(v[6], v[7])}; }
                    for (int e = gt; e < 512 * 32; e += NT) { const int m = e >> 5, kc = m & 255, isS = m >> 8, k0 = (e & 31) * 8; float v[8];
#pragma unroll
                        for (int i = 0; i < 8; ++i) { const float rev = (float)((kc * (k0 + i)) & 255) * (1.f / 256.f); v[i] = (isS ? __builtin_amdgcn_sinf(rev) : __builtin_amdgcn_cosf(rev)) * (1.f / 16.f); }
                        *(u32x4*)(CS + (size_t)m * 256 + k0) = (u32x4){pk2(v[0], v[1]), pk2(v[2], v[3]), pk2(v[4], v[5]), pk2(v[6], v[7])}; }
                    for (int e = gt; e < 256 * 64; e += NT) { const int m = e >> 6, kc = e & 63, k0 = (kc & 31) * 8, isS = kc >> 5; float v[8];
#pragma unroll
                        for (int i = 0; i < 8; ++i) { const float rev = (float)((m * (k0 + i)) & 255) * (1.f / 256.f); v[i] = (isS ? -__builtin_amdgcn_sinf(rev) : __builtin_amdgcn_cosf(rev)) * (1.f / 16.f); }
                        *(u32x4*)(CN2 + (size_t)m * 512 + kc * 8) = (u32x4){pk2(v[0], v[1]), pk2(v[2], v[3]), pk2(v[4], v[5]), pk2(v[6], v[7])}; }
                }
            }
        }
        PH_END;

        if (kind == 0) {
            if (PH_ON) {
                pg8::Gemm g{HN, (const bf16_t*)(ws + WS_W1S), UGP, 512, 512, (size_t)NCH * UGP, (size_t)256 * 512};
                pg8::Sched S; S.init(5, 1, 64);
                pg8::EpiSloc E{(float*)(ws + WS_SLOC)};
                pg8::gemm_phase(lds, g, S, E, wave0);
            }
            PH_END;
            if (PH_ON) {
                FRESH_IDS;
                const float* SL = (const float*)(ws + WS_SLOC);
                for (int id = bid * 512 + tid; id < 8 * 64 * 2 * 64; id += G * 512) {
                    const int pp = id & 63, dir = (id >> 6) & 1, g = (id >> 7) & 63, b = id >> 13;
                    const int pg = (jj * 2 + dir) * 64 + g; const float dt = __expf(p.s5_ldt[pg]);
                    float ar, ai; cpow(p.s5_lre[pg * 64 + pp] * dt, p.s5_lim[pg * 64 + pp] * dt, 32.f, ar, ai);
                    float sr = 0.f, si = 0.f;
                    const size_t rb = (size_t)g * NCH + b * 136;
                    for (int k0 = 0; k0 < 136; k0 += 8) {
                        float lr[8], lim[8];
#pragma unroll
                        for (int q = 0; q < 8; ++q) { const int k = k0 + q; const int cc = dir == 0 ? k : (k < 8 ? 7 - k : 143 - k);
                            lr[q] = SL[(rb + cc) * 256 + dir * 128 + pp]; lim[q] = SL[(rb + cc) * 256 + dir * 128 + 64 + pp]; }
#pragma unroll
                        for (int q = 0; q < 8; ++q) { const int k = k0 + q; const int cc = dir == 0 ? k : (k < 8 ? 7 - k : 143 - k);
                            bf16_t* o = HN + (rb + cc) * UGP + 512 + dir * 128 + pp;
                            o[0] = (bf16_t)(pk2(sr, 0.f) & 0xffffu); o[64] = (bf16_t)(pk2(si, 0.f) & 0xffffu);
                            const float nr = ar * sr - ai * si + lr[q], ni = ar * si + ai * sr + lim[q]; sr = nr; si = ni; }
                    }
                }
            }
            PH_END;
            if (PH_ON) {
                pg8::Gemm g{HN, (const bf16_t*)(ws + WS_W3S), UGP, UGP, UGP, (size_t)NCH * UGP, (size_t)512 * UGP};
                pg8::Sched S; S.init(5, 2, 64);
                pg8::EpiZ E{(bf16_t*)(ws + WS_Z)};
                pg8::gemm_phase(lds, g, S, E, wave0);
            }
            PH_END;
            if (PH_ON) {
                pg8::Gemm g{(const bf16_t*)(ws + WS_Z), GLUT + (size_t)jj * D * 2 * D, D, D, D, 0, 0};
                pg8::Sched S; S.init(last ? 128 : 136, 8, 1);
                pg8::EpiGlu E{xl, xc, p.out, XCTX, modl + 2 * D};
                pg8::gemm_phase(lds, g, S, E, wave0);
            }
            PH_END;
        } else if (kind == 1) {
            bf16_t* QK = (bf16_t*)(ws + WS_QK); bf16_t* VT = (bf16_t*)(ws + WS_VT);
            if (PH_ON) {
                { pg8::Gemm g{HN, QKVT, D, D, D, 0, 0}; pg8::Sched S; S.init(136, 8, 1); pg8::EpiQK E{QK, p.qn, p.kn}; pg8::gemm_phase(lds, g, S, E, wave0); }
                { pg8::Gemm g{QKVT + (size_t)2048 * D, HN, D, D, D, 0, 0}; pg8::Sched S; S.init(4, 136, 1, 0, 128); pg8::EpiStore<0> E{VT, (size_t)TA, 0}; pg8::gemm_phase(lds, g, S, E, wave0); }
            }
            PH_END;
            if (PH_ON) {
                FRESH_IDS;
                const int l31 = lane & 31, hi = lane >> 5, comp = wave >> 2, wq = wave & 3;
                float lamv; { const float a = wave_sum(p.dlam[lane] * p.dlam[64 + lane], lane), b = wave_sum(p.dlam[128 + lane] * p.dlam[192 + lane], lane); lamv = __expf(a) - __expf(b) + LAM_INIT; }
                const int vcu = (G % 8 == 0) ? (bid % 8) * (G / 8) + bid / 8 : bid;
                constexpr int KROW = 144, KTILE = 64 * KROW, VTILE = 128 * KROW, VRING = 4 * KTILE;
                const int kr = tid >> 3, kch = tid & 7;
                const int kst = kr * KROW + kch * 16, vst = kr * KROW + ((kch >> 1) * 32 + (kch & 1) * 8);
                for (int rep = 0; rep < NREP(2); ++rep)
                for (int u = vcu; u < 2176; u += G) {
                    int b, head, qrow0, j0;
                    if (u < 2048) { b = u >> 8; head = (u >> 5) & 7; qrow0 = b * 4096 + (u & 31) * 128; j0 = 0; }
                    else { const int v = u - 2048; b = v >> 4; head = (v >> 1) & 7; qrow0 = TL + b * 256 + (v & 1) * 128; j0 = 64; }
                    bf16x8 qf[4];
                    { const bf16_t* qp = QK + (size_t)(qrow0 + wq * 32 + l31) * 2048 + head * 128 + comp * 64 + hi * 8;
#pragma unroll
                      for (int ds = 0; ds < 4; ++ds) qf[ds] = *(const bf16x8*)(qp + ds * 16); }
                    const bf16_t* kbase = QK + (size_t)kr * 2048 + 1024 + head * 128 + kch * 8;
                    const bf16_t* vbase = VT + (size_t)(head * 128 + kr) * TA + kch * 8;
                    u32x4 pk0, pk1, pv0, pv1;
#define ATT_TOKBASE(j) ((j) < 64 ? b * 4096 + 64 * (j) : TL + b * 256 + 64 * ((j) - 64))
#define ATT_LOADK(j) do { const bf16_t* kp_ = kbase + (size_t)ATT_TOKBASE(j) * 2048; pk0 = *(const u32x4*)kp_; pk1 = *(const u32x4*)(kp_ + 64); } while (0)
#define ATT_LOADV(j) do { const bf16_t* vp_ = vbase + ATT_TOKBASE(j); pv0 = *(const u32x4*)vp_; pv1 = *(const u32x4*)(vp_ + (size_t)64 * TA); } while (0)
#define ATT_STOREK(sl) do { LAS unsigned char* bb_ = lds + (sl) * (2 * KTILE) + kst; *(LAS u32x4*)(bb_) = pk0; *(LAS u32x4*)(bb_ + KTILE) = pk1; } while (0)
#define ATT_STOREV(sl) do { LAS unsigned char* vb_ = lds + VRING + (sl) * VTILE + vst; \
                        *(LAS u32x2*)(vb_) = (u32x2){pv0.x, pv0.y}; *(LAS u32x2*)(vb_ + 16) = (u32x2){pv0.z, pv0.w}; \
                        *(LAS u32x2*)(vb_ + 64 * KROW) = (u32x2){pv1.x, pv1.y}; *(LAS u32x2*)(vb_ + 64 * KROW + 16) = (u32x2){pv1.z, pv1.w}; } while (0)
#define ATT_QK(S0, S1, sl, CI) do { const LAS unsigned char* kb_ = lds + (sl) * (2 * KTILE) + comp * KTILE + l31 * KROW + hi * 16; bf16x8 kf_[8]; \
                        _Pragma("unroll") for (int ds = 0; ds < 4; ++ds) { kf_[2 * ds] = *(const LAS bf16x8*)(kb_ + ds * 32); kf_[2 * ds + 1] = *(const LAS bf16x8*)(kb_ + 32 * KROW + ds * 32); } \
                        __builtin_amdgcn_sched_barrier(0); \
                        _Pragma("unroll") for (int ds = 0; ds < 4; ++ds) { \
                            S0 = __builtin_amdgcn_mfma_f32_32x32x16_bf16(kf_[2 * ds], qf[ds], ds == 0 ? CI : S0, 0, 0, 0); S1 = __builtin_amdgcn_mfma_f32_32x32x16_bf16(kf_[2 * ds + 1], qf[ds], ds == 0 ? CI : S1, 0, 0, 0); } } while (0)
#define ATT_PV(sl) do { const LAS unsigned char* vb_ = lds + VRING + (sl) * VTILE + l31 * KROW + hi * 16; \
                        _Pragma("unroll") for (int ks = 0; ks < 4; ++ks) _Pragma("unroll") for (int dt = 0; dt < 4; ++dt) { const bf16x8 a_ = *(const LAS bf16x8*)(vb_ + dt * 32 * KROW + ks * 32); \
                            o[dt] = __builtin_amdgcn_mfma_f32_32x32x16_bf16(a_, pp[ks], o[dt], 0, 0, 0); } } while (0)
#define ATT_SOFT(S0, S1, PD) do { f32x2 ls_ = {0.f, 0.f}; \
                        _Pragma("unroll") for (int r = 0; r < 16; ++r) { S0[r] = __builtin_amdgcn_exp2f(S0[r]); S1[r] = __builtin_amdgcn_exp2f(S1[r]); } \
                        _Pragma("unroll") for (int r = 0; r < 16; r += 2) { ls_ += (f32x2){S0[r], S0[r + 1]}; ls_ += (f32x2){S1[r], S1[r + 1]}; } \
                        l_run += ls_.x + ls_.y; \
                        { u32x4 w_; \
                          w_ = (u32x4){pk2(S0[0], S0[1]), pk2(S0[2], S0[3]), pk2(S0[4], S0[5]), pk2(S0[6], S0[7])}; PD[0] = __builtin_bit_cast(bf16x8, w_); \
                          w_ = (u32x4){pk2(S0[8], S0[9]), pk2(S0[10], S0[11]), pk2(S0[12], S0[13]), pk2(S0[14], S0[15])}; PD[1] = __builtin_bit_cast(bf16x8, w_); \
                          w_ = (u32x4){pk2(S1[0], S1[1]), pk2(S1[2], S1[3]), pk2(S1[4], S1[5]), pk2(S1[6], S1[7])}; PD[2] = __builtin_bit_cast(bf16x8, w_); \
                          w_ = (u32x4){pk2(S1[8], S1[9]), pk2(S1[10], S1[11]), pk2(S1[12], S1[13]), pk2(S1[14], S1[15])}; PD[3] = __builtin_bit_cast(bf16x8, w_); } } while (0)
                    f32x16 o[4];
#pragma unroll
                    for (int dt = 0; dt < 4; ++dt)
#pragma unroll
                        for (int r = 0; r < 16; ++r) o[dt][r] = 0.f;
                    float m_ref, l_run = 0.f;
                    f32x16 negm, zero16;
#pragma unroll
                    for (int r = 0; r < 16; ++r) zero16[r] = 0.f;
                    bf16x8 pp[4];
                    __syncthreads();
                    ATT_LOADK(j0); ATT_STOREK(j0 & 1);
                    __syncthreads();
                    {
                        ATT_LOADK(j0 + 1); ATT_LOADV(j0);
                        f32x16 s0, s1;
                        ATT_QK(s0, s1, j0 & 1, zero16);
                        float mx = fmaxf(s0[0], s1[0]);
#pragma unroll
                        for (int r = 1; r < 16; ++r) mx = fmaxf(mx, fmaxf(s0[r], s1[r]));
                        m_ref = xhalf_max(mx);
#pragma unroll
                        for (int r = 0; r < 16; ++r) { s0[r] -= m_ref; s1[r] -= m_ref; negm[r] = -m_ref; }
                        ATT_SOFT(s0, s1, pp);
                        ATT_STOREK((j0 + 1) & 1); ATT_STOREV(j0 & 1);
                        __syncthreads();
                    }
                    for (int j = j0 + 1; j < 68; ++j) {
                        const int jn = j + 1 < 68 ? j + 1 : 67;
                        ATT_LOADK(jn); ATT_LOADV(j);
                        f32x16 s0, s1;
                        ATT_QK(s0, s1, j & 1, negm);
                        float mx = max3f(s0[0], s1[0], s0[1]), mx2 = max3f(s1[1], s0[2], s1[2]);
#pragma unroll
                        for (int r = 3; r < 15; r += 2) { mx = max3f(mx, s0[r], s1[r]); mx2 = max3f(mx2, s0[r + 1], s1[r + 1]); }
                        mx = max3f(mx, s0[15], s1[15]); mx = fmaxf(mx, mx2);
                        mx = xhalf_max(mx);
                        if (__builtin_expect(__any(mx > ATT_THR), 0)) {
                            const float dl = ceilf(fmaxf(mx, 0.f)), f = __builtin_amdgcn_exp2f(-dl);
                            m_ref += dl; l_run *= f;
#pragma unroll
                            for (int r = 0; r < 16; ++r) { s0[r] -= dl; s1[r] -= dl; negm[r] = -m_ref; }
#pragma unroll
                            for (int dt = 0; dt < 4; ++dt)
#pragma unroll
                                for (int r = 0; r < 16; ++r) o[dt][r] *= f;
#pragma unroll
                            for (int ks = 0; ks < 4; ++ks) { u32x4 w = __builtin_bit_cast(u32x4, pp[ks]);
                                w.x = pk2(bflo(w.x) * f, bfhi(w.x) * f); w.y = pk2(bflo(w.y) * f, bfhi(w.y) * f); w.z = pk2(bflo(w.z) * f, bfhi(w.z) * f); w.w = pk2(bflo(w.w) * f, bfhi(w.w) * f);
                                pp[ks] = __builtin_bit_cast(bf16x8, w); }
                        }
                        __builtin_amdgcn_sched_barrier(0);
                        unsigned pw[16]; f32x2 ls = {0.f, 0.f};
                        {
                            const LAS unsigned char* vb_ = lds + VRING + ((j - 1) & 1) * VTILE + l31 * KROW + hi * 16;
                            bf16x8 vf[16];
#define ATT_VRD(i) vf[i] = *(const LAS bf16x8*)(vb_ + ((i) & 3) * 32 * KROW + ((i) >> 2) * 32)
                            ATT_VRD(0); ATT_VRD(1);
#pragma unroll
                            for (int i = 0; i < 16; ++i) {
                                if (i + 2 < 16) ATT_VRD(i + 2);
                                o[i & 3] = __builtin_amdgcn_mfma_f32_32x32x16_bf16(vf[i], pp[i >> 2], o[i & 3], 0, 0, 0);
                                s0[i] = __builtin_amdgcn_exp2f(s0[i]); s1[i] = __builtin_amdgcn_exp2f(s1[i]);
                                if (i & 1) { pw[i >> 1] = pk2(s0[i - 1], s0[i]); pw[8 + (i >> 1)] = pk2(s1[i - 1], s1[i]); ls += (f32x2){s0[i - 1], s0[i]}; ls += (f32x2){s1[i - 1], s1[i]}; }
                                __builtin_amdgcn_sched_barrier(0);
                            }
#undef ATT_VRD
                        }
                        l_run += ls.x + ls.y;
#pragma unroll
                        for (int ks = 0; ks < 4; ++ks) { const u32x4 w = {pw[4 * ks], pw[4 * ks + 1], pw[4 * ks + 2], pw[4 * ks + 3]}; pp[ks] = __builtin_bit_cast(bf16x8, w); }
                        ATT_STOREK(jn & 1); ATT_STOREV(j & 1);
                        __syncthreads();
                    }
                    ATT_PV(67 & 1);
#undef ATT_TOKBASE
#undef ATT_LOADK
#undef ATT_LOADV
#undef ATT_STOREK
#undef ATT_STOREV
#undef ATT_QK
#undef ATT_PV
#undef ATT_SOFT
                    { const float lt = xhalf_sum(l_run); const float inv = 1.f / lt;
#pragma unroll
                      for (int dt = 0; dt < 4; ++dt)
#pragma unroll
                          for (int r = 0; r < 16; ++r) o[dt][r] *= inv; }
                    __syncthreads();
                    LAS float* ex = (LAS float*)lds + wq * 4096;
                    if (comp == 1) {
#pragma unroll
                        for (int dt = 0; dt < 4; ++dt)
#pragma unroll
                            for (int r = 0; r < 16; ++r) ex[(dt * 16 + r) * 64 + lane] = o[dt][r];
                    }
                    __syncthreads();
                    LAS bf16_t* stg = (LAS bf16_t*)(lds + 81920) + wq * (32 * 136);
                    if (comp == 0) {
                        float ss = 0.f;
#pragma unroll
                        for (int dt = 0; dt < 4; ++dt)
#pragma unroll
                            for (int r = 0; r < 16; ++r) { const float d = o[dt][r] - lamv * ex[(dt * 16 + r) * 64 + lane]; o[dt][r] = d; ss += d * d; }
                        ss = xhalf_sum(ss);
                        const float rstd = rsqrtf(ss * (1.f / 128.f) + EPS) * (1.f - LAM_INIT);
#pragma unroll
                        for (int dt = 0; dt < 4; ++dt)
#pragma unroll
                            for (int r = 0; r < 16; ++r) { const int dv = 32 * dt + (r & 3) + 8 * (r >> 2) + 4 * hi; stg[l31 * 136 + dv] = (bf16_t)(pk2(o[dt][r] * rstd * p.subln[dv], 0.f) & 0xffffu); }
                    }
                    __syncthreads();
                    if (comp == 0) {
#pragma unroll
                        for (int it = 0; it < 8; ++it) { const int row = it * 4 + (lane >> 4), ch = lane & 15;
                            const u32x4 w = *(const LAS u32x4*)(stg + row * 136 + ch * 8);
                            *(u32x4*)(HN + (size_t)(qrow0 + wq * 32 + row) * D + head * 128 + ch * 8) = w; }
                    }
                }
                __syncthreads();
            }
            PH_END;
        } else {
            if (PH_ON) {
                pg8::Gemm g{(const bf16_t*)(ws + WS_CS), HN, 256, D, 256, 0, 256};
                pg8::Sched S; S.init(2, 136, 4);
                pg8::EpiChanDft E{(bf16_t*)(ws + WS_PQT), (bf16_t*)(ws + WS_PQC)};
                pg8::gemm_phase(lds, g, S, E, wave0);
            }
            PH_END;
            if (PH_ON) {
                { pg8::Gemm g{(const bf16_t*)(ws + WS_W1M), (const bf16_t*)(ws + WS_PQT), 128, 128, 128, 0, 0};
                  pg8::Sched S; S.init(1, 2048, 1); pg8::EpiFft1 E{(bf16_t*)(ws + WS_B2)}; pg8::gemm_phase(lds, g, S, E, wave0); }
                { pg8::Gemm g{(const bf16_t*)(ws + WS_CN256), (const bf16_t*)(ws + WS_PQC), 512, 512, 512, 0, (size_t)1024 * 512};
                  pg8::Sched S; S.init(1, 4, 8); pg8::EpiStore<0> E{HN + (size_t)TL * D, D, (size_t)256 * D}; pg8::gemm_phase(lds, g, S, E, wave0); }
            }
            PH_END;
            if (PH_ON) {
                pg8::Gemm g{(const bf16_t*)(ws + WS_W2M), (const bf16_t*)(ws + WS_B2), 128, 128, 128, 0, 0};
                pg8::Sched S; S.init(1, 2048, 1); pg8::EpiFft2 E{HN}; pg8::gemm_phase(lds, g, S, E, wave0);
            }
            PH_END;
        }
        if (kind != 0) {
            if (PH_ON) {
                { pg8::Gemm g{HN, kind == 1 ? WOT : FWT, D, D, D, 0, 0};
                  pg8::Sched S; S.init(128, 4, 1);
                  pg8::EpiResid E{xl, xc, p.out, XCTX, modl + 2 * D, kind == 2 ? p.fb : nullptr};
                  pg8::gemm_phase(lds, g, S, E, wave0); }
                if (!last) { pg8::Gemm g{HN, kind == 1 ? WOT : FWT, D, D, D / KSPLIT, (size_t)(D / KSPLIT), (size_t)(D / KSPLIT)};
                  pg8::Sched S; S.init(8, 4, KSPLIT, 128);
                  pg8::EpiPart E{PART};
                  pg8::gemm_phase(lds, g, S, E, wave0); }
            }
            PH_END;
        }
        if (PH_ON) { FRESH_IDS; for (int rep = 0; rep < NREP(3); ++rep) norm_rows_tok(p.out, XCTX, ng + D, modl, 3, HN, last ? TL : TA, gw, NGW, lane, false, fxF); }
        PH_END;
        if (PH_ON) {
            for (int rep = 0; rep < NREP(0); ++rep) {
            pg8::Gemm g{HN, W1T + (size_t)li * D * DFF, D, D, D, 0, 0};
            pg8::Sched S; S.init(last ? 128 : 136, 16, 1);
            pg8::EpiStore<1> E{HB, DFF, 0};
            pg8::gemm_phase(lds, g, S, E, wave0); }
        }
        PH_END;
        if (PH_ON) {
            if (!last) { pg8::Gemm g{HB, W2T + (size_t)li * D * DFF, DFF, DFF, DFF / KSPLIT, (size_t)(DFF / KSPLIT), (size_t)(DFF / KSPLIT)};
              pg8::Sched S; S.init(8, 4, KSPLIT, 128);
              pg8::EpiPart E{PART};
              pg8::gemm_phase(lds, g, S, E, wave0); }
            for (int rep = 0; rep < NREP(1); ++rep) {
            pg8::Gemm g{HB, W2T + (size_t)li * D * DFF, DFF, DFF, DFF, 0, 0};
            pg8::Sched S; S.init(128, 4, 1);
            pg8::EpiResid E{p.out, XCTX, p.out, XCTX, (rep + 1 < NREP(1)) ? (const float*)(ws + WS_ZERO) : modl + 5 * D, nullptr};
            pg8::gemm_phase(lds, g, S, E, wave0); }
        }
        PH_END;
    }
}

extern "C" void kernel_launch(void* const* d_in, const int* in_sizes, int n_in, void* d_out, int out_size, void* d_ws, size_t ws_size, hipStream_t stream) {
    static int grid = 0;
    if (grid == 0) {
        int dev = 0, cus = 0, per_cu = 0;
        hipGetDevice(&dev);
        hipDeviceGetAttribute(&cus, hipDeviceAttributeMultiprocessorCount, dev);
        hipFuncSetAttribute((const void*)mega_fwd, hipFuncAttributeMaxDynamicSharedMemorySize, LDS_BYTES);
        hipOccupancyMaxActiveBlocksPerMultiprocessor(&per_cu, (const void*)mega_fwd, 512, LDS_BYTES);
        if (per_cu < 1) per_cu = 1;
        grid = cus * per_cu;
        if (ws_size < WS_END) fprintf(stderr, "kernel_launch: workspace too small: %zu < %zu\n", ws_size, (size_t)WS_END);
    }
    (void)hipMemsetAsync((char*)d_ws + WS_CTL, 0, CTL_BYTES, stream);
    Params p{};
    const float** f = (const float**)&p;
    for (int i = 0; i < 26; ++i) f[i] = (const float*)d_in[i];
    p.out = (float*)d_out; p.ws = (unsigned char*)d_ws; p.ph_lo = 0; p.ph_hi = 1000;
    void* args[] = {&p};
    hipError_t e = hipLaunchCooperativeKernel((const void*)mega_fwd, dim3(grid), dim3(512), args, LDS_BYTES, stream);
    if (e != hipSuccess) fprintf(stderr, "cooperative launch failed: %s (grid %d)\n", hipGetErrorString(e), grid);
}
```

```cpp
#include <hip/hip_runtime.h>
#include <hip/hip_cooperative_groups.h>
#include <cstdio>
#include <cstdint>
namespace cg = cooperative_groups;

#define LAS __attribute__((address_space(3)))
typedef unsigned short bf16_t;
typedef short bf16x8 __attribute__((ext_vector_type(8)));
typedef float f32x2 __attribute__((ext_vector_type(2)));
typedef float f32x4 __attribute__((ext_vector_type(4)));
typedef float f32x16 __attribute__((ext_vector_type(16)));
typedef unsigned u32x2 __attribute__((ext_vector_type(2)));
typedef unsigned u32x4 __attribute__((ext_vector_type(4)));
typedef __bf16 bf16x2_t __attribute__((ext_vector_type(2)));

__device__ __forceinline__ unsigned pk2(float lo, float hi) { f32x2 v = {lo, hi}; bf16x2_t b = __builtin_convertvector(v, bf16x2_t); return __builtin_bit_cast(unsigned, b); }
__device__ __forceinline__ float bflo(unsigned w) { return __uint_as_float(w << 16); }
__device__ __forceinline__ float bfhi(unsigned w) { return __uint_as_float(w & 0xffff0000u); }
__device__ __forceinline__ float shx(float v, int lane, int m) { return __int_as_float(__builtin_amdgcn_ds_bpermute((lane ^ m) << 2, __float_as_int(v))); }
__device__ __forceinline__ float wave_sum(float v, int lane) {
#pragma unroll
    for (int o = 1; o < 64; o <<= 1) v += shx(v, lane, o);
    return v;
}
__device__ __forceinline__ float xhalf_max(float v) { auto rr = __builtin_amdgcn_permlane32_swap(__float_as_uint(v), __float_as_uint(v), false, false); return fmaxf(__uint_as_float(rr[0]), __uint_as_float(rr[1])); }
__device__ __forceinline__ float xhalf_sum(float v) { auto rr = __builtin_amdgcn_permlane32_swap(__float_as_uint(v), __float_as_uint(v), false, false); return __uint_as_float(rr[0]) + __uint_as_float(rr[1]); }
__device__ __forceinline__ int fresh_tid(int wave0) { int l; asm volatile("v_mbcnt_lo_u32_b32 %0, -1, 0\n\tv_mbcnt_hi_u32_b32 %0, -1, %0" : "=v"(l)); return wave0 * 64 + l; }
#define LAUNDER_V(x) asm volatile("" : "+v"(x))
__device__ __forceinline__ float max3f(float a, float b, float c) { float r; asm("v_max3_f32 %0, %1, %2, %3" : "=v"(r) : "v"(a), "v"(b), "v"(c)); return r; }
__device__ __forceinline__ float sigmoidf_(float x) { return __builtin_amdgcn_rcpf(1.0f + __builtin_amdgcn_exp2f(-1.4426950408889634f * x)); }
__device__ __forceinline__ float gelu_tanh(float x) { const float u = 0.7978845608028654f * (x + 0.044715f * x * x * x); return x * sigmoidf_(2.0f * u); }

constexpr int D = 1024, TL = 32768, TC = 2048, TA = TL + TC, DFF = 4096, NMOD = 6;
constexpr int NCH = 1088;
constexpr int UGP = 768;
constexpr float EPS = 1e-6f;
constexpr float LAM_INIT = 0.35550906759f;
constexpr float QSCALE = 0.125f * 1.4426950408889634f;
#ifndef REP_MASK
#define REP_MASK 0
#endif
#define NREP(bit) ((REP_MASK >> (bit)) & 1 ? 2 : 1)
#ifndef ATT_THR
#define ATT_THR 16.0f
#endif

constexpr size_t MiB = 1u << 20;
constexpr size_t WS_W1T = 0, WS_W2T = 32 * MiB, WS_GLUT = 64 * MiB, WS_QKVT = 72 * MiB, WS_WOT = 78 * MiB, WS_FWT = 80 * MiB;
constexpr size_t WS_ZERO = 474 * MiB, WS_CTL = 475 * MiB, CTL_BYTES = 16384;
constexpr size_t WS_PART = 476 * MiB;
constexpr int KSPLIT = 4;
constexpr size_t WS_MOD = 82 * MiB, WS_KTAB = 83 * MiB, WS_XCTX = 91 * MiB, WS_HN = 99 * MiB, WS_H = 202 * MiB, WS_END = 474 * MiB;
constexpr size_t WS_SLOC = WS_H, WS_W1S = WS_H + 68 * MiB, WS_W3S = WS_H + 84 * MiB, WS_Z = WS_H + 132 * MiB;
constexpr size_t WS_QK = WS_H, WS_VT = WS_H + 136 * MiB;
constexpr size_t WS_PQT = WS_H, WS_PQC = WS_H + 128 * MiB, WS_B2 = WS_H + 136 * MiB, WS_CS = WS_H + 264 * MiB, WS_CN256 = WS_H + 265 * MiB, WS_W1M = WS_H + 266 * MiB, WS_W2M = WS_H + 267 * MiB;

constexpr int LDS_BYTES = 147456;

struct Params {
    const float *x, *c, *ctx, *c_ctx, *w_mod, *b_mod, *norm_g, *mlp_w1, *mlp_w2;
    const float *s5_lre, *s5_lim, *s5_ldt, *s5_bre, *s5_bim, *s5_cre, *s5_cim, *s5_d, *s5_wglu;
    const float *wqkv, *qn, *kn, *dlam, *subln, *wo, *fw, *fb;
    float* out; unsigned char* ws;
    int ph_lo, ph_hi;
};

namespace pg8 {
constexpr int BM = 256, BK = 64, HALF = 128, HTB = HALF * BK * 2, STAGE_BYTES = 8 * HTB, NXCD = 8, WGM = 8;
__host__ __device__ __forceinline__ int lds_byte(int r, int c) { const int st = (r >> 4) * 2 + (c >> 5), rr = r & 15, cc = c & 31, ob = rr * 64 + cc * 2; return st * 1024 + (ob ^ (((ob >> 9) & 1) << 5)); }
__host__ __device__ __forceinline__ void stage_rc(int b, int& R, int& C) { const int st = b / 1024, sb = b % 1024, swz = sb ^ (((sb >> 9) & 1) << 5); R = (st >> 1) * 16 + swz / 64; C = (st & 1) * 32 + (swz % 64) / 2; }
__host__ __device__ __forceinline__ int perm32(int rho) { const int n = rho >> 4, i = rho & 15; return 8 * (i >> 2) + 4 * n + (i & 3); }

struct Unit { int pm, pn, pb; };
struct Gemm { const bf16_t* A; const bf16_t* Bt; int lda, ldb, K; size_t batchA, batchB; };
struct Sched {
    int nM, nN, nwg, G, c;
    int pm0;
    __device__ __forceinline__ void init(int nM_, int nN_, int nB_, int pm0_ = 0, int coff = 0) { nM = nM_; nN = nN_; nwg = nM_ * nN_ * nB_; G = gridDim.x; c = (blockIdx.x + coff) % gridDim.x; pm0 = pm0_; }
    __device__ __forceinline__ bool next(int i, Unit& u) const {
        const long L = (long)i * G + c; if (L >= nwg) return false;
        int wgid = (int)L; { const int q = nwg / NXCD, r = nwg % NXCD, xcd = wgid % NXCD, off = wgid / NXCD; wgid = (xcd < r ? xcd * (q + 1) : r * (q + 1) + (xcd - r) * q) + off; }
        const int upb = nM * nN; u.pb = wgid / upb; const int w = wgid - u.pb * upb;
        const int nig = WGM * nN, gid = w / nig, fm = gid * WGM, gsz = (nM - fm) < WGM ? (nM - fm) : WGM;
        u.pm = pm0 + fm + ((w % nig) % gsz); u.pn = (w % nig) / gsz; return true;
    }
};

template <class Epi>
__device__ __forceinline__ void gemm_phase(LAS unsigned char* lds, const Gemm g, const Sched& S, const Epi& E, int wave0) {
    const int tid = fresh_tid(wave0), wid = __builtin_amdgcn_readfirstlane(tid >> 6), lane = tid & 63, wr = wid >> 2, wc = wid & 3, fr = lane & 15, fq = lane >> 4;
    const int nt = g.K / BK;
    unsigned voffA[2], voffB[2];
#pragma unroll
    for (int i = 0; i < 2; ++i) { int R, C; stage_rc(tid * 16 + i * 8192, R, C); const int Rb = Epi::PERM ? ((R & ~31) + perm32(R & 31)) : R;
        voffA[i] = (unsigned)(R * g.lda + C) * 2u; voffB[i] = (unsigned)(Rb * g.ldb + C) * 2u; }
    const size_t kstep = (size_t)(BK * 2);
    const size_t hstepA = (size_t)HALF * g.lda * 2, hstepB = (size_t)HALF * g.ldb * 2;
    const unsigned ldsw = (unsigned)wid * 1024u;
    const int aoff = lds_byte(wr * 64 + fr, fq * 8), boff = lds_byte(wc * 32 + fr, fq * 8);
#define PG8_APTR(u) ((const char*)(g.A + (size_t)(u).pb * g.batchA + (size_t)(u).pm * BM * g.lda))
#define PG8_BPTR(u) ((const char*)(g.Bt + (size_t)(u).pb * g.batchB + (size_t)(u).pn * BM * g.ldb))
#define PG8_SA(b, h) (((b) * 2 + (h)) * HTB)
#define PG8_SB(b, h) ((4 + (b) * 2 + (h)) * HTB)
#define PG8_STAGE(bufoff, gbase, voff) do { const char* gb_ = (const char*)(gbase); asm volatile("" : "+s"(gb_)); _Pragma("unroll") for (int _i = 0; _i < 2; ++_i) \
        __builtin_amdgcn_global_load_lds((const unsigned*)(gb_ + (voff)[_i]), (LAS unsigned*)(lds + (bufoff) + ldsw + _i * 8192), 16, 0, 0); } while (0)
#define PG8_LDA(dst, b, h) do { _Pragma("unroll") for (int m = 0; m < 4; ++m) _Pragma("unroll") for (int k = 0; k < 2; ++k) dst[m][k] = *(const LAS bf16x8*)(lds + PG8_SA(b, h) + aoff + m * 2048 + k * 1024); } while (0)
#define PG8_LDB(dst, b, h) do { _Pragma("unroll") for (int n = 0; n < 2; ++n) _Pragma("unroll") for (int k = 0; k < 2; ++k) dst[n][k] = *(const LAS bf16x8*)(lds + PG8_SB(b, h) + boff + n * 2048 + k * 1024); } while (0)
#define PG8_MMA(ai, bj, At, Bt) do { __builtin_amdgcn_s_setprio(1); _Pragma("unroll") for (int m = 0; m < 4; ++m) _Pragma("unroll") for (int n = 0; n < 2; ++n) _Pragma("unroll") for (int k = 0; k < 2; ++k) \
        acc[ai][bj][m][n] = __builtin_amdgcn_mfma_f32_16x16x32_bf16(Bt[n][k], At[m][k], acc[ai][bj][m][n], 0, 0, 0); __builtin_amdgcn_s_setprio(0); } while (0)
#define PG8_WAIT_V(n) asm volatile("s_waitcnt vmcnt(" #n ")" ::: "memory")
#define PG8_WAIT_L(n) asm volatile("s_waitcnt lgkmcnt(" #n ")" ::: "memory")
#define PG8_BAR __builtin_amdgcn_s_barrier()
#define PG8_SCHED __builtin_amdgcn_sched_barrier(0)
    Unit cur, nxt; int ui = 0;
    if (!S.next(0, cur)) return;
    f32x4 acc[2][2][4][2];
#pragma unroll
    for (int a = 0; a < 2; ++a)
#pragma unroll
        for (int b = 0; b < 2; ++b)
#pragma unroll
            for (int m = 0; m < 4; ++m)
#pragma unroll
                for (int n = 0; n < 2; ++n) acc[a][b][m][n] = (f32x4){0.f, 0.f, 0.f, 0.f};
    bf16x8 At[4][2], B0[2][2], B1[2][2];
    const char* cA = PG8_APTR(cur); const char* cB = PG8_BPTR(cur);
    PG8_STAGE(PG8_SB(0, 0), cB, voffB); PG8_STAGE(PG8_SB(0, 1), cB + hstepB, voffB); PG8_STAGE(PG8_SA(0, 0), cA, voffA); PG8_STAGE(PG8_SA(0, 1), cA + hstepA, voffA);
    if (wr == 1) PG8_BAR;
    PG8_WAIT_V(2); PG8_BAR;
    PG8_STAGE(PG8_SB(1, 0), cB + kstep, voffB); PG8_STAGE(PG8_SA(1, 0), cA + kstep, voffA); PG8_STAGE(PG8_SB(1, 1), cB + hstepB + kstep, voffB);
    PG8_WAIT_V(6); PG8_BAR;
    for (;;) {
        const bool has_next = S.next(ui + 1, nxt);
        const char* nA = has_next ? PG8_APTR(nxt) : cA; const char* nB = has_next ? PG8_BPTR(nxt) : cB;
        for (int t = 0; t < nt; t += 2) {
            const bool last = (t == nt - 2);
            const char* a1 = cA + (size_t)(t + 1) * kstep;
            const char* a2 = last ? nA : cA + (size_t)(t + 2) * kstep; const char* b2 = last ? nB : cB + (size_t)(t + 2) * kstep;
            const char* a3 = a2 + kstep; const char* b3 = b2 + kstep;
            PG8_LDB(B0, 0, 0); PG8_LDB(B1, 0, 1); PG8_SCHED; PG8_LDA(At, 0, 0); PG8_STAGE(PG8_SA(1, 1), a1 + hstepA, voffA);
            PG8_WAIT_V(8); PG8_WAIT_L(0); PG8_BAR; PG8_MMA(0, 0, At, B0); PG8_MMA(0, 1, At, B1); PG8_BAR; PG8_SCHED;
            PG8_LDA(At, 0, 1); PG8_STAGE(PG8_SB(0, 0), b2, voffB); PG8_STAGE(PG8_SB(0, 1), b2 + hstepB, voffB); PG8_STAGE(PG8_SA(0, 0), a2, voffA);
            PG8_WAIT_V(8); PG8_WAIT_L(0); PG8_BAR; PG8_MMA(1, 0, At, B0); PG8_MMA(1, 1, At, B1); PG8_BAR; PG8_SCHED;
            PG8_LDB(B0, 1, 0); PG8_LDB(B1, 1, 1); PG8_SCHED; PG8_LDA(At, 1, 0); PG8_STAGE(PG8_SA(0, 1), a2 + hstepA, voffA);
            PG8_WAIT_V(8); PG8_WAIT_L(0); PG8_BAR; PG8_MMA(0, 0, At, B0); PG8_MMA(0, 1, At, B1); PG8_BAR; PG8_SCHED;
            PG8_LDA(At, 1, 1); PG8_STAGE(PG8_SB(1, 0), b3, voffB); PG8_STAGE(PG8_SB(1, 1), b3 + hstepB, voffB); PG8_STAGE(PG8_SA(1, 0), a3, voffA);
            PG8_WAIT_V(8); PG8_WAIT_L(0); PG8_BAR; PG8_MMA(1, 0, At, B0); PG8_MMA(1, 1, At, B1); PG8_BAR; PG8_SCHED;
        }
        if (wr == 0) PG8_BAR;
        { int l2_; asm volatile("v_mbcnt_lo_u32_b32 %0, -1, 0\n\tv_mbcnt_hi_u32_b32 %0, -1, %0" : "=v"(l2_)); E(acc, cur, wr, wc, l2_ & 15, l2_ >> 4); }
        if (!has_next) break;
#pragma unroll
        for (int a = 0; a < 2; ++a)
#pragma unroll
            for (int b = 0; b < 2; ++b)
#pragma unroll
                for (int m = 0; m < 4; ++m)
#pragma unroll
                    for (int n = 0; n < 2; ++n) acc[a][b][m][n] = (f32x4){0.f, 0.f, 0.f, 0.f};
        cur = nxt; cA = nA; cB = nB; ++ui;
        if (wr == 1) PG8_BAR;
    }
    PG8_WAIT_V(0);
    PG8_BAR;
#undef PG8_APTR
#undef PG8_BPTR
#undef PG8_SA
#undef PG8_SB
#undef PG8_STAGE
#undef PG8_LDA
#undef PG8_LDB
#undef PG8_MMA
#undef PG8_WAIT_V
#undef PG8_WAIT_L
#undef PG8_BAR
#undef PG8_SCHED
}

typedef f32x4 Acc[2][2][4][2];

template <int ACT  > struct EpiStore {
    static constexpr bool PERM = true;
    bf16_t* O; size_t ldc, bstride;
    __device__ __forceinline__ void operator()(const Acc& acc, const Unit& u, int wr, int wc, int fr, int fq) const {
        LAUNDER_V(fr); LAUNDER_V(fq);
        const int row0 = u.pm * BM + wr * 64 + fr, col0 = u.pn * BM + wc * 32 + 8 * fq;
        bf16_t* base = O + (size_t)u.pb * bstride;
#pragma unroll
        for (int ai = 0; ai < 2; ++ai)
#pragma unroll
            for (int m = 0; m < 4; ++m) { bf16_t* rowp = base + (size_t)(row0 + ai * HALF + m * 16) * ldc + col0;
#pragma unroll
                for (int bj = 0; bj < 2; ++bj) { f32x4 v0 = acc[ai][bj][m][0], v1 = acc[ai][bj][m][1];
                    if (ACT == 1) {
#pragma unroll
                        for (int e = 0; e < 4; ++e) { float a = fmaxf(v0[e], 0.f), b = fmaxf(v1[e], 0.f); v0[e] = a * a; v1[e] = b * b; } }
                    u32x4 w; w.x = pk2(v0[0], v0[1]); w.y = pk2(v0[2], v0[3]); w.z = pk2(v1[0], v1[1]); w.w = pk2(v1[2], v1[3]);
                    *(u32x4*)(rowp + bj * HALF) = w; } }
    }
};

struct EpiResid {
    static constexpr bool PERM = false;
    const float* base_lat; const float* base_ctx; float* out_lat; float* out_ctx; const float* gate; const float* bias;
    __device__ __forceinline__ void operator()(const Acc& acc, const Unit& u, int wr, int wc, int fr, int fq) const {
        LAUNDER_V(fr); LAUNDER_V(fq);
        const float* bp; float* op; int rbase, mi;
        if (u.pm < 128) { bp = base_lat; op = out_lat; rbase = u.pm * BM; mi = u.pm >> 4; } else { bp = base_ctx; op = out_ctx; rbase = (u.pm - 128) * BM; mi = 8; }
        const int col0 = u.pn * BM + wc * 32 + 4 * fq;
        f32x4 gv[2][2], bv[2][2];
#pragma unroll
        for (int bj = 0; bj < 2; ++bj)
#pragma unroll
            for (int n = 0; n < 2; ++n) { gv[bj][n] = *(const f32x4*)(gate + mi * (NMOD * D) + col0 + bj * HALF + n * 16);
                bv[bj][n] = bias ? *(const f32x4*)(bias + col0 + bj * HALF + n * 16) : (f32x4){0.f, 0.f, 0.f, 0.f}; }
#pragma unroll
        for (int ai = 0; ai < 2; ++ai)
#pragma unroll
            for (int m = 0; m < 4; ++m) { const size_t off = (size_t)(rbase + ai * HALF + wr * 64 + m * 16 + fr) * D + col0;
#pragma unroll
                for (int bj = 0; bj < 2; ++bj)
#pragma unroll
                    for (int n = 0; n < 2; ++n) { const f32x4 xv = *(const f32x4*)(bp + off + bj * HALF + n * 16);
                        *(f32x4*)(op + off + bj * HALF + n * 16) = xv + gv[bj][n] * (acc[ai][bj][m][n] + bv[bj][n]); } }
    }
};

struct EpiQK {
    static constexpr bool PERM = false;
    bf16_t* QKo; const float* qn; const float* kn;
    __device__ __forceinline__ void operator()(const Acc& acc, const Unit& u, int wr, int wc, int fr, int fq) const {
        LAUNDER_V(fr); LAUNDER_V(fq);
        const int lane = fq * 16 + fr, hc = u.pn * 4 + wc; const bool isq = hc < 16;
        const float* nwp = (isq ? qn : kn) + 4 * fq;
        f32x4 nw[2][2];
#pragma unroll
        for (int bj = 0; bj < 2; ++bj)
#pragma unroll
            for (int n = 0; n < 2; ++n) nw[bj][n] = *(const f32x4*)(nwp + 32 * bj + 16 * n);
        float invf[4];
#pragma unroll
        for (int i = 0; i < 4; ++i) invf[i] = __builtin_amdgcn_exp2f(-(float)(4 * fq + i) * 0.8304820237218406f) * 0.15915494309189535f;
        const float qs = isq ? QSCALE : 1.f;
#pragma unroll
        for (int ai = 0; ai < 2; ++ai)
#pragma unroll
            for (int m = 0; m < 4; ++m) { const int row = u.pm * BM + ai * HALF + wr * 64 + m * 16 + fr;
                float ss = 0.f;
#pragma unroll
                for (int bj = 0; bj < 2; ++bj)
#pragma unroll
                    for (int n = 0; n < 2; ++n) { const f32x4 a = acc[ai][bj][m][n]; ss += (a[0] * a[0] + a[1] * a[1]) + (a[2] * a[2] + a[3] * a[3]); }
                ss += shx(ss, lane, 16); ss += shx(ss, lane, 32);
                const float rstd = rsqrtf(ss * (1.f / 64.f) + EPS) ;
                const int l = row & 4095; const float posr = (float)(l >> 6), posc = (float)(l & 63);
                bf16_t* op = QKo + (size_t)row * 2048 + hc * 64 + 4 * fq;
#pragma unroll
                for (int bj = 0; bj < 2; ++bj) { f32x4 x1 = acc[ai][bj][m][0] * rstd * nw[bj][0], x2 = acc[ai][bj][m][1] * rstd * nw[bj][1];
                    if (row < TL) { const float pos = bj ? posc : posr;
#pragma unroll
                        for (int i = 0; i < 4; ++i) { const float rev = pos * invf[i]; const float cs = __builtin_amdgcn_cosf(rev), sn = __builtin_amdgcn_sinf(rev);
                            const float a = x1[i], b = x2[i]; x1[i] = a * cs - b * sn; x2[i] = a * sn + b * cs; } }
                    x1 *= qs; x2 *= qs;
                    *(u32x2*)(op + 32 * bj) = (u32x2){pk2(x1[0], x1[1]), pk2(x1[2], x1[3])};
                    *(u32x2*)(op + 32 * bj + 16) = (u32x2){pk2(x2[0], x2[1]), pk2(x2[2], x2[3])}; } }
    }
};

struct EpiPart {
    static constexpr bool PERM = false;
    float* P;
    __device__ __forceinline__ void operator()(const Acc& acc, const Unit& u, int wr, int wc, int fr, int fq) const {
        LAUNDER_V(fr); LAUNDER_V(fq);
        const int col0 = u.pn * BM + wc * 32 + 4 * fq;
#pragma unroll
        for (int ai = 0; ai < 2; ++ai)
#pragma unroll
            for (int m = 0; m < 4; ++m) { float* rp = P + ((size_t)u.pb * TC + (u.pm - 128) * BM + ai * HALF + wr * 64 + m * 16 + fr) * D + col0;
#pragma unroll
                for (int bj = 0; bj < 2; ++bj)
#pragma unroll
                    for (int n = 0; n < 2; ++n) *(f32x4*)(rp + bj * HALF + n * 16) = acc[ai][bj][m][n]; }
    }
};

struct EpiGlu {
    static constexpr bool PERM = false;
    const float* base_lat; const float* base_ctx; float* out_lat; float* out_ctx; const float* gate;
    __device__ __forceinline__ void operator()(const Acc& acc, const Unit& u, int wr, int wc, int fr, int fq) const {
        LAUNDER_V(fr); LAUNDER_V(fq);
        const float* bp; float* op; int rbase, mi;
        if (u.pm < 128) { bp = base_lat; op = out_lat; rbase = u.pm * BM; mi = u.pm >> 4; } else { bp = base_ctx; op = out_ctx; rbase = (u.pm - 128) * BM; mi = 8; }
        const int col0 = u.pn * HALF + wc * 32 + 4 * fq;
        f32x4 gv[2];
#pragma unroll
        for (int n = 0; n < 2; ++n) gv[n] = *(const f32x4*)(gate + mi * (NMOD * D) + col0 + n * 16);
#pragma unroll
        for (int ai = 0; ai < 2; ++ai)
#pragma unroll
            for (int m = 0; m < 4; ++m) { const size_t off = (size_t)(rbase + ai * HALF + wr * 64 + m * 16 + fr) * D + col0;
#pragma unroll
                for (int n = 0; n < 2; ++n) { const f32x4 xv = *(const f32x4*)(bp + off + n * 16); const f32x4 v = acc[ai][0][m][n], gt = acc[ai][1][m][n]; f32x4 o;
#pragma unroll
                    for (int e = 0; e < 4; ++e) o[e] = xv[e] + gv[n][e] * v[e] * sigmoidf_(gt[e]);
                    *(f32x4*)(op + off + n * 16) = o; } }
    }
};

struct EpiSloc {
    static constexpr bool PERM = false;
    float* S;
    __device__ __forceinline__ void operator()(const Acc& acc, const Unit& u, int wr, int wc, int fr, int fq) const {
        LAUNDER_V(fr); LAUNDER_V(fq);
        const int col0 = wc * 32 + 4 * fq;
#pragma unroll
        for (int ai = 0; ai < 2; ++ai)
#pragma unroll
            for (int m = 0; m < 4; ++m) { const int ci = u.pm * BM + ai * HALF + wr * 64 + m * 16 + fr;
                if (ci < NCH) { float* rp = S + ((size_t)u.pb * NCH + ci) * 256 + col0;
#pragma unroll
                    for (int bj = 0; bj < 2; ++bj)
#pragma unroll
                        for (int n = 0; n < 2; ++n) *(f32x4*)(rp + bj * HALF + n * 16) = acc[ai][bj][m][n]; } }
    }
};

struct EpiZ {
    static constexpr bool PERM = false;
    bf16_t* Z;
    __device__ __forceinline__ void operator()(const Acc& acc, const Unit& u, int wr, int wc, int fr, int fq) const {
        LAUNDER_V(fr); LAUNDER_V(fq);
#pragma unroll
        for (int ai = 0; ai < 2; ++ai)
#pragma unroll
            for (int m = 0; m < 4; ++m) { const int ci = u.pm * BM + ai * HALF + wr * 64 + m * 16 + fr;
                if (ci < NCH) { const int b = ci / 136, cc = ci - b * 136; const int tok0 = cc < 8 ? TL + b * 256 + cc * 32 : b * 4096 + (cc - 8) * 32;
#pragma unroll
                    for (int bj = 0; bj < 2; ++bj)
#pragma unroll
                        for (int n = 0; n < 2; ++n) { const int t = 16 * u.pn + 8 * bj + 2 * wc + n; const f32x4 v = acc[ai][bj][m][n];
                            u32x2 w; w.x = pk2(gelu_tanh(v[0]), gelu_tanh(v[1])); w.y = pk2(gelu_tanh(v[2]), gelu_tanh(v[3]));
                            *(u32x2*)(Z + (size_t)(tok0 + t) * D + u.pb * 16 + 4 * fq) = w; } } }
    }
};

struct EpiChanDft {
    static constexpr bool PERM = true;
    bf16_t* PQ1; bf16_t* PQC;
    __device__ __forceinline__ void operator()(const Acc& acc, const Unit& u, int wr, int wc, int fr, int fq) const {
        LAUNDER_V(fr); LAUNDER_V(fq);
        if (u.pn < 128) {
            const int b = u.pn >> 4;
#pragma unroll
            for (int ai = 0; ai < 2; ++ai)
#pragma unroll
                for (int m = 0; m < 4; ++m) { const int kc = ai * HALF + wr * 64 + m * 16 + fr;
                    bf16_t* rowp = PQ1 + (size_t)(b * 1024 + u.pb * 256 + kc) * 8192 + u.pm * 64;
#pragma unroll
                    for (int bj = 0; bj < 2; ++bj) { const int tp = (u.pn & 15) * 256 + bj * HALF + wc * 32 + 8 * fq;
                        const f32x4 v0 = acc[ai][bj][m][0], v1 = acc[ai][bj][m][1];
                        u32x4 w; w.x = pk2(v0[0], v0[1]); w.y = pk2(v0[2], v0[3]); w.z = pk2(v1[0], v1[1]); w.w = pk2(v1[2], v1[3]);
                        *(u32x4*)(rowp + (tp >> 6) * 128 + (tp & 63)) = w; } }
        } else {
            const int b = u.pn - 128;
            bf16_t* base = PQC + (size_t)(b * 1024 + u.pb * 256) * 512 + (size_t)u.pm * 256 + wc * 32 + 8 * fq;
#pragma unroll
            for (int ai = 0; ai < 2; ++ai)
#pragma unroll
                for (int m = 0; m < 4; ++m) { bf16_t* rowp = base + (size_t)(ai * HALF + wr * 64 + m * 16 + fr) * 512;
#pragma unroll
                    for (int bj = 0; bj < 2; ++bj) { const f32x4 v0 = acc[ai][bj][m][0], v1 = acc[ai][bj][m][1];
                        u32x4 w; w.x = pk2(v0[0], v0[1]); w.y = pk2(v0[2], v0[3]); w.z = pk2(v1[0], v1[1]); w.w = pk2(v1[2], v1[3]);
                        *(u32x4*)(rowp + bj * HALF) = w; } }
        }
    }
};

struct EpiFft1 {
    static constexpr bool PERM = true;
    bf16_t* B2;
    __device__ __forceinline__ void operator()(const Acc& acc, const Unit& u, int wr, int wc, int fr, int fq) const {
        LAUNDER_V(fr); LAUNDER_V(fq);
        if (wr != 0) return;
#pragma unroll
        for (int m = 0; m < 4; ++m) { const int m2 = 16 * m + fr;
#pragma unroll
            for (int bj = 0; bj < 2; ++bj) { const int n0 = u.pn * BM + bj * HALF + wc * 32 + 8 * fq; const int k2 = n0 & 63, c = (n0 >> 6) & 1023, b = n0 >> 16;
                float br[8], bi[8];
#pragma unroll
                for (int e = 0; e < 8; ++e) { const float ar = acc[0][bj][m][e >> 2][e & 3], ai_ = acc[1][bj][m][e >> 2][e & 3];
                    const float rev = (float)(m2 * (k2 + e)) * (1.f / 4096.f); const float cs = __builtin_amdgcn_cosf(rev), sn = __builtin_amdgcn_sinf(rev);
                    br[e] = (ar * cs + ai_ * sn) * (1.f / 64.f); bi[e] = (ai_ * cs - ar * sn) * (1.f / 64.f); }
                bf16_t* op = B2 + ((size_t)(b * 64 + m2) * 1024 + c) * 128 + k2;
                *(u32x4*)(op) = (u32x4){pk2(br[0], br[1]), pk2(br[2], br[3]), pk2(br[4], br[5]), pk2(br[6], br[7])};
                *(u32x4*)(op + 64) = (u32x4){pk2(bi[0], bi[1]), pk2(bi[2], bi[3]), pk2(bi[4], bi[5]), pk2(bi[6], bi[7])}; } }
    }
};

struct EpiFft2 {
    static constexpr bool PERM = true;
    bf16_t* F;
    __device__ __forceinline__ void operator()(const Acc& acc, const Unit& u, int wr, int wc, int fr, int fq) const {
        LAUNDER_V(fr); LAUNDER_V(fq);
        if (wr != 0) return;
#pragma unroll
        for (int m = 0; m < 4; ++m) { const int m1 = 16 * m + fr;
#pragma unroll
            for (int bj = 0; bj < 2; ++bj) { const int n0 = u.pn * BM + bj * HALF + wc * 32 + 8 * fq; const int c = n0 & 1023, m2 = (n0 >> 10) & 63, b = n0 >> 16;
                const f32x4 v0 = acc[0][bj][m][0], v1 = acc[0][bj][m][1];
                *(u32x4*)(F + (size_t)(b * 4096 + 64 * m1 + m2) * D + c) = (u32x4){pk2(v0[0], v0[1]), pk2(v0[2], v0[3]), pk2(v1[0], v1[1]), pk2(v1[2], v1[3])}; } }
    }
};
}

__device__ __forceinline__ void transpose_item(const float* W, int K, int N, bf16_t* WT, int glu, LAS float* scr, int item, int lane) {
    const int nblk = N / 32, kb = item / nblk, nb = item % nblk, k0 = 64 * kb, n0 = 32 * nb;
#pragma unroll 8
    for (int i = 0; i < 32; ++i) { const int kk = 2 * i + (lane >> 5); scr[kk * 33 + (lane & 31)] = W[(size_t)(k0 + kk) * N + n0 + (lane & 31)]; }
    asm volatile("s_waitcnt lgkmcnt(0)" ::: "memory");
    const int n0p = glu == 1 ? (((n0 & 1023) >> 7) * 256 + (n0 >> 10) * 128 + (n0 & 127))
                  : (glu == 2 && n0 < 2048) ? ((n0 & ~255) | (((n0 >> 5) & 1) << 7) | (((n0 >> 6) & 3) << 5)) : n0;
    const int c = lane & 7;
#pragma unroll
    for (int j = 0; j < 4; ++j) { const int n = (lane >> 3) + 8 * j; const LAS float* s = scr + (8 * c) * 33 + n;
        u32x4 o; o.x = pk2(s[0 * 33], s[1 * 33]); o.y = pk2(s[2 * 33], s[3 * 33]); o.z = pk2(s[4 * 33], s[5 * 33]); o.w = pk2(s[6 * 33], s[7 * 33]);
        *(u32x4*)(WT + (size_t)(n0p + n) * K + k0 + 8 * c) = o; }
    asm volatile("s_waitcnt lgkmcnt(0)" ::: "memory");
}

__device__ __forceinline__ const float* xrow_ptr(const float* xl, const float* xc, int row) { return row < TL ? xl + (size_t)row * D : xc + (size_t)(row - TL) * D; }

struct CtxFix { const float* part; const float* pgate; const float* pbias; float* xw; };
__device__ __forceinline__ void norm_rows_tok(const float* xl, const float* xc, const float* g, const float* modl  , int sidx, bf16_t* out, int nrows, int gw, int ngw, int lane, bool perm64, const CtxFix fx) {
    for (int row = gw; row < nrows; row += ngw) {
        const f32x4* xr = (const f32x4*)xrow_ptr(xl, xc, row) + lane;
        f32x4 v[4]; float ss = 0.f;
#pragma unroll
        for (int j = 0; j < 4; ++j) v[j] = xr[64 * j];
        if (fx.part && row >= TL) {
#pragma unroll
            for (int j = 0; j < 4; ++j) { const int c = 4 * lane + 256 * j; f32x4 s = fx.pbias ? *(const f32x4*)(fx.pbias + c) : (f32x4){0.f, 0.f, 0.f, 0.f};
#pragma unroll
                for (int k = 0; k < KSPLIT; ++k) s += *(const f32x4*)(fx.part + ((size_t)k * TC + (row - TL)) * D + c);
                v[j] += *(const f32x4*)(fx.pgate + c) * s;
                *(f32x4*)(fx.xw + (size_t)(row - TL) * D + c) = v[j]; } }
#pragma unroll
        for (int j = 0; j < 4; ++j) ss += (v[j].x * v[j].x + v[j].y * v[j].y) + (v[j].z * v[j].z + v[j].w * v[j].w);
        const float rstd = rsqrtf(wave_sum(ss, lane) * (1.f / D) + EPS);
        const int mi = row < TL ? row >> 12 : 8;
        const float* sh = modl + mi * (NMOD * D) + sidx * D; const float* sc = sh + D;
        const int orow = (perm64 && row < TL) ? ((row & ~4095) | ((row & 63) << 6) | ((row & 4095) >> 6)) : row;
        unsigned long long* o8 = (unsigned long long*)(out + (size_t)orow * D) + lane;
#pragma unroll
        for (int j = 0; j < 4; ++j) { const int c = 4 * lane + 256 * j; const f32x4 gg = *(const f32x4*)(g + c), s1 = *(const f32x4*)(sc + c), s0 = *(const f32x4*)(sh + c);
            f32x4 y;
#pragma unroll
            for (int e = 0; e < 4; ++e) y[e] = v[j][e] * rstd * gg[e] * (1.f + s1[e]) + s0[e];
            o8[64 * j] = (unsigned long long)pk2(y[0], y[1]) | ((unsigned long long)pk2(y[2], y[3]) << 32); }
    }
}
__device__ __forceinline__ void norm_rows_s5(const float* xl, const float* xc, const float* g, const float* modl, bf16_t* ug, int gw, int ngw, int lane, const CtxFix fx) {
    for (int row = gw; row < TA; row += ngw) {
        const f32x4* xr = (const f32x4*)xrow_ptr(xl, xc, row) + 4 * lane;
        f32x4 v[4]; float ss = 0.f;
#pragma unroll
        for (int j = 0; j < 4; ++j) v[j] = xr[j];
        if (fx.part && row >= TL) {
#pragma unroll
            for (int j = 0; j < 4; ++j) { const int c = 16 * lane + 4 * j; f32x4 s = fx.pbias ? *(const f32x4*)(fx.pbias + c) : (f32x4){0.f, 0.f, 0.f, 0.f};
#pragma unroll
                for (int k = 0; k < KSPLIT; ++k) s += *(const f32x4*)(fx.part + ((size_t)k * TC + (row - TL)) * D + c);
                v[j] += *(const f32x4*)(fx.pgate + c) * s;
                *(f32x4*)(fx.xw + (size_t)(row - TL) * D + c) = v[j]; } }
#pragma unroll
        for (int j = 0; j < 4; ++j) ss += (v[j].x * v[j].x + v[j].y * v[j].y) + (v[j].z * v[j].z + v[j].w * v[j].w);
        const float rstd = rsqrtf(wave_sum(ss, lane) * (1.f / D) + EPS);
        int mi, b, pos; if (row < TL) { b = row >> 12; pos = 256 + (row & 4095); mi = b; } else { b = (row - TL) >> 8; pos = (row - TL) & 255; mi = 8; }
        const float* sh = modl + mi * (NMOD * D); const float* sc = sh + D;
        const int chunk = b * 136 + (pos >> 5), s = pos & 31;
        unsigned w[8];
#pragma unroll
        for (int j = 0; j < 4; ++j) { const int c = 16 * lane + 4 * j; const f32x4 gg = *(const f32x4*)(g + c), s1 = *(const f32x4*)(sc + c), s0 = *(const f32x4*)(sh + c);
            f32x4 y;
#pragma unroll
            for (int e = 0; e < 4; ++e) y[e] = v[j][e] * rstd * gg[e] * (1.f + s1[e]) + s0[e];
            w[2 * j] = pk2(y[0], y[1]); w[2 * j + 1] = pk2(y[2], y[3]); }
        u32x4* op = (u32x4*)(ug + ((size_t)lane * NCH + chunk) * UGP + s * 16);
        op[0] = (u32x4){w[0], w[1], w[2], w[3]}; op[1] = (u32x4){w[4], w[5], w[6], w[7]};
    }
}

__device__ __forceinline__ void cpow(float lr_dt, float li_dt, float k, float& re, float& im) {
    const float mag = __expf(k * lr_dt); const float rev = k * li_dt * 0.15915494309189535f;
    re = mag * __builtin_amdgcn_cosf(rev); im = mag * __builtin_amdgcn_sinf(rev);
}
__device__ __forceinline__ void s5_kcoef(float lr, float li, float dt, float& kr, float& ki) {
    const float th = li * dt; const float rv = th * 0.15915494309189535f;
    const float c = __builtin_amdgcn_cosf(rv), s = __builtin_amdgcn_sinf(rv), sh = __builtin_amdgcn_sinf(0.5f * rv);
    const float em1 = expm1f(lr * dt);
    const float nre = em1 * c - 2.f * sh * sh, nim = (em1 + 1.f) * s;
    const float den = lr * lr + li * li;
    kr = (nre * lr + nim * li) / den; ki = (nim * lr - nre * li) / den;
}


#define XB_TMO      128
#define XB_XCNT(j)  (256  + 64 * (j))
#define XB_XSUB(j)  (1280 + 64 * (j))
#define XB_XGEN(j)  (2304 + 64 * (j))
#define XB_TOP      3328
#define XB_TOPGEN   3392
#define XCD_BAR_WORDS 3456
#define XB_SPIN_CAP (1u << 18)
__device__ __forceinline__ unsigned xb_ld(unsigned* p)              { return __hip_atomic_load(p, __ATOMIC_RELAXED, __HIP_MEMORY_SCOPE_AGENT); }
__device__ __forceinline__ unsigned xb_add(unsigned* p, unsigned v) { return __hip_atomic_fetch_add(p, v, __ATOMIC_RELAXED, __HIP_MEMORY_SCOPE_AGENT); }
__device__ __forceinline__ unsigned xb_xcc_id() { return (unsigned)__builtin_amdgcn_s_getreg((3 << 11) | 20) & 0xFu; }
#define XB_SPIN(cond, bar) do { unsigned _sp = 0; while (cond) { __builtin_amdgcn_s_sleep(1); \
    if ((++_sp & 255u) == 0u) { if (xb_ld(&(bar)[XB_TMO])) break; if (_sp > XB_SPIN_CAP) { atomicAdd(&(bar)[XB_TMO], 1u); break; } } } } while (0)
struct XcdBarrier { unsigned* bar; unsigned x; volatile LAS unsigned* st; };
__device__ __forceinline__ XcdBarrier xcd_barrier_post(unsigned* bar, volatile LAS unsigned* st) {
    XcdBarrier b; b.bar = bar; b.x = xb_xcc_id(); b.st = st;
    if (threadIdx.x == 0) (void)xb_add(&bar[XB_XCNT(b.x)], 1u);
    return b;
}
__device__ __forceinline__ void xcd_barrier_complete(unsigned* bar, unsigned x, unsigned& nloc, unsigned& nx) {
    const unsigned G = gridDim.x * gridDim.y * gridDim.z;
    unsigned sum, cnt, mine, sp = 0u;
    for (;;) {
        sum = 0u; cnt = 0u; mine = 0u;
#pragma unroll
        for (unsigned j = 0; j < 16; ++j) { const unsigned c = xb_ld(&bar[XB_XCNT(j)]); sum += c; cnt += (c > 0u) ? 1u : 0u; mine = (j == x) ? c : mine; }
        if (sum == G) break;
        __builtin_amdgcn_s_sleep(1);
        if ((++sp & 255u) == 0u) { if (xb_ld(&bar[XB_TMO])) break; if (sp > XB_SPIN_CAP) { atomicAdd(&bar[XB_TMO], 1u); break; } }
    }
    nloc = mine > 0u ? mine : 1u; nx = cnt > 0u ? cnt : 1u;
}
__device__ __forceinline__ void xcd_barrier(const XcdBarrier& b) {
    asm volatile("s_waitcnt vmcnt(0)" ::: "memory");
    __syncthreads();
    if (threadIdx.x == 0) {
        unsigned* bar = b.bar;
        __builtin_amdgcn_s_waitcnt(0);
        unsigned nloc = b.st[0], nx = b.st[1];
        if (nloc == 0u) { xcd_barrier_complete(bar, b.x, nloc, nx); b.st[0] = nloc; b.st[1] = nx; }
        const unsigned old = xb_add(&bar[XB_XSUB(b.x)], 1u);
        const unsigned gen = old / nloc;
        if (old + 1u == (gen + 1u) * nloc) {
            __builtin_amdgcn_fence(__ATOMIC_RELEASE, "agent");
            asm volatile("s_waitcnt vmcnt(0)" ::: "memory");
            const unsigned og = xb_add(&bar[XB_TOP], 1u);
            const unsigned tg = og / nx;
            if (og + 1u == (tg + 1u) * nx) xb_add(&bar[XB_TOPGEN], 1u);
            else XB_SPIN(xb_ld(&bar[XB_TOPGEN]) == tg, bar);
            __builtin_amdgcn_fence(__ATOMIC_ACQUIRE, "agent");
            xb_add(&bar[XB_XGEN(b.x)], 1u);
            asm volatile("s_waitcnt vmcnt(0)" ::: "memory");
        } else {
            XB_SPIN(xb_ld(&bar[XB_XGEN(b.x)]) == gen, bar);
            __builtin_amdgcn_fence(__ATOMIC_ACQUIRE, "agent");
            asm volatile("s_waitcnt vmcnt(0)" ::: "memory");
        }
    }
    __syncthreads();
}

__global__ void __launch_bounds__(512) mega_fwd(Params p) {
    extern __shared__ __attribute__((aligned(16))) unsigned char lds_raw[];
    LAS unsigned char* lds = (LAS unsigned char*)lds_raw;
    cg::grid_group grid = cg::this_grid();
    const int G = gridDim.x, bid = blockIdx.x, NGW = G * 8;
    const int wave0 = __builtin_amdgcn_readfirstlane(threadIdx.x >> 6);
#define FRESH_IDS const int tid = fresh_tid(wave0), lane = tid & 63, wave = __builtin_amdgcn_readfirstlane(tid >> 6), gw = bid * 8 + wave; (void)lane; (void)gw
    unsigned char* ws = p.ws;
    bf16_t* W1T = (bf16_t*)(ws + WS_W1T); bf16_t* W2T = (bf16_t*)(ws + WS_W2T); bf16_t* GLUT = (bf16_t*)(ws + WS_GLUT);
    bf16_t* QKVT = (bf16_t*)(ws + WS_QKVT); bf16_t* WOT = (bf16_t*)(ws + WS_WOT); bf16_t* FWT = (bf16_t*)(ws + WS_FWT);
    float* MOD = (float*)(ws + WS_MOD); float* KTAB = (float*)(ws + WS_KTAB); float* XCTX = (float*)(ws + WS_XCTX);
    bf16_t* HN = (bf16_t*)(ws + WS_HN); bf16_t* HB = (bf16_t*)(ws + WS_H);
    int ph = 0;
#define PH_ON (ph >= p.ph_lo && ph < p.ph_hi)
    volatile LAS unsigned* bst = (volatile LAS unsigned*)(lds + LDS_BYTES - 64);
    if (threadIdx.x < 2) bst[threadIdx.x] = 0u;
    __syncthreads();
    const XcdBarrier xbar = xcd_barrier_post((unsigned*)(ws + WS_CTL), bst);
#define PH_END do { if (ph >= p.ph_lo && ph + 1 < p.ph_hi) { for (int r_ = 0; r_ < NREP(8); ++r_) { if (ph == 0) grid.sync(); else xcd_barrier(xbar); } } ++ph; } while (0)

    if (PH_ON) {
        FRESH_IDS;
        {
            LAS float* scr = (LAS float*)(lds + wave * 16384);
            constexpr int I_W1 = 16 * 128, I_W2 = 64 * 32, I_GLU = 16 * 64, I_QKV = 16 * 96, I_SQ = 16 * 32;
            constexpr int NIT = 4 * (I_W1 + I_W2) + 2 * I_GLU + I_QKV + 2 * I_SQ;
            for (int it = gw; it < NIT; it += NGW) {
                int r = it;
                if (r < 4 * I_W1) { const int l = r / I_W1; transpose_item(p.mlp_w1 + (size_t)l * D * DFF, D, DFF, W1T + (size_t)l * D * DFF, 0, scr, r % I_W1, lane); continue; } r -= 4 * I_W1;
                if (r < 4 * I_W2) { const int l = r / I_W2; transpose_item(p.mlp_w2 + (size_t)l * D * DFF, DFF, D, W2T + (size_t)l * D * DFF, 0, scr, r % I_W2, lane); continue; } r -= 4 * I_W2;
                if (r < 2 * I_GLU) { const int l = r / I_GLU; transpose_item(p.s5_wglu + (size_t)l * D * 2 * D, D, 2 * D, GLUT + (size_t)l * D * 2 * D, 1, scr, r % I_GLU, lane); continue; } r -= 2 * I_GLU;
                if (r < I_QKV) { transpose_item(p.wqkv, D, 3 * D, QKVT, 2, scr, r, lane); continue; } r -= I_QKV;
                if (r < I_SQ) { transpose_item(p.wo, D, D, WOT, 0, scr, r, lane); continue; } r -= I_SQ;
                transpose_item(p.fw, D, D, FWT, 0, scr, r, lane);
            }
        }
        if (REP_MASK) { for (int e = bid * 512 + tid; e < 9 * NMOD * D; e += G * 512) ((float*)(ws + WS_ZERO))[e] = 0.f; }
        __syncthreads();
        {
            LAS float* sc = (LAS float*)lds;
            LAS float* red = (LAS float*)(lds + 9 * 4096);
            for (int e = tid; e < 9 * D; e += 512) { const float v = e < 8 * D ? p.c[e] : p.c_ctx[e - 8 * D]; sc[e] = v * sigmoidf_(v); }
            __syncthreads();
            const int col = tid & 63, kp = tid >> 6;
            for (int item = bid; item < 4 * 96; item += G) {
                const int i = item / 96, nb = item % 96;
                float a[9];
#pragma unroll
                for (int r = 0; r < 9; ++r) a[r] = 0.f;
                const float* wp = p.w_mod + ((size_t)i * D + kp * 128) * (NMOD * D) + nb * 64 + col;
#pragma unroll 8
                for (int k = 0; k < 128; ++k) { const float w = wp[(size_t)k * (NMOD * D)];
#pragma unroll
                    for (int r = 0; r < 9; ++r) a[r] += sc[r * D + kp * 128 + k] * w; }
#pragma unroll
                for (int r = 0; r < 9; ++r) red[(kp * 64 + col) * 9 + r] = a[r];
                __syncthreads();
                for (int e = tid; e < 576; e += 512) { const int r = e >> 6, cc = e & 63; float s = p.b_mod[i * (NMOD * D) + nb * 64 + cc];
#pragma unroll
                    for (int q = 0; q < 8; ++q) s += red[(q * 64 + cc) * 9 + r];
                    MOD[((size_t)i * 9 + r) * (NMOD * D) + nb * 64 + cc] = s; }
                __syncthreads();
            }
        }
        {
            LAS float* Bb = (LAS float*)lds;
            LAS float* Cc = (LAS float*)(lds + 8192);
            LAS float* ap = (LAS float*)(lds + 16384);
            for (int item = bid; item < 256; item += G) {
                const int j = item >> 7, g = (item >> 1) & 63, dir = item & 1;
                const int pg = (j * 2 + dir) * 64 + g;
                const float dt = __expf(p.s5_ldt[pg]);
                __syncthreads();
                for (int e = tid; e < 1024; e += 512) { const int pp = e >> 4, h = e & 15; float kr, ki; s5_kcoef(p.s5_lre[pg * 64 + pp], p.s5_lim[pg * 64 + pp], dt, kr, ki);
                    const float br = p.s5_bre[((size_t)pg * 64 + pp) * 16 + h], bi = p.s5_bim[((size_t)pg * 64 + pp) * 16 + h];
                    Bb[e * 2] = kr * br - ki * bi; Bb[e * 2 + 1] = kr * bi + ki * br;
                    const int h2 = e >> 6, p2 = e & 63; Cc[e * 2] = p.s5_cre[((size_t)pg * 16 + h2) * 64 + p2]; Cc[e * 2 + 1] = p.s5_cim[((size_t)pg * 16 + h2) * 64 + p2]; }
                for (int e = tid; e < 2048; e += 512) { const int tau = e >> 6, pp = e & 63; float re, im; cpow(p.s5_lre[pg * 64 + pp] * dt, p.s5_lim[pg * 64 + pp] * dt, (float)tau, re, im); ap[e * 2] = re; ap[e * 2 + 1] = im; }
                __syncthreads();
                const int hh = tid & 255, h = hh >> 4, hp = hh & 15, th = tid >> 8;
                float a[16];
#pragma unroll
                for (int q = 0; q < 16; ++q) a[q] = 0.f;
                for (int pp = 0; pp < 64; ++pp) { const float cr = Cc[(h * 64 + pp) * 2], ci = Cc[(h * 64 + pp) * 2 + 1], br = Bb[(pp * 16 + hp) * 2], bi = Bb[(pp * 16 + hp) * 2 + 1];
                    const float cbr = cr * br - ci * bi, cbi = cr * bi + ci * br;
#pragma unroll
                    for (int q = 0; q < 16; ++q) { const float ar = ap[((th * 16 + q) * 64 + pp) * 2], ai = ap[((th * 16 + q) * 64 + pp) * 2 + 1]; a[q] += cbr * ar - cbi * ai; } }
#pragma unroll
                for (int q = 0; q < 16; ++q) KTAB[((((size_t)j * 64 + g) * 2 + dir) * 32 + th * 16 + q) * 256 + hh] = a[q];
            }
            __syncthreads();
        }
    }
    PH_END;

    for (int li = 0; li < 4; ++li) {
        const int kind = li % 3, jj = li / 3; const bool last = (li == 3);
        const float* xl = li == 0 ? p.x : p.out; const float* xc = li == 0 ? p.ctx : XCTX;
        const float* modl = MOD + (size_t)li * 9 * (NMOD * D);
        const float* ng = p.norm_g + (size_t)li * 2 * D;
        float* PART = (float*)(ws + WS_PART);
        const CtxFix fxA{li > 0 ? PART : nullptr, MOD + ((size_t)(li - 1) * 9 + 8) * (NMOD * D) + 5 * D, nullptr, XCTX};
        const CtxFix fxF{(kind != 0 && !last) ? PART : nullptr, modl + 8 * (NMOD * D) + 2 * D, kind == 2 ? p.fb : nullptr, XCTX};

        if (PH_ON) {
            FRESH_IDS;
            if (kind == 0) {
                for (int rep = 0; rep < NREP(3); ++rep) norm_rows_s5(xl, xc, ng, modl, HN, gw, NGW, lane, fxA);
                bf16_t* W1S = (bf16_t*)(ws + WS_W1S); bf16_t* W3S = (bf16_t*)(ws + WS_W3S);
                LAS float* apf = (LAS float*)lds;
                LAS float* apb = (LAS float*)(lds + 16896);
                LAS float* Cf = (LAS float*)(lds + 33792);
                LAS float* Cb = (LAS float*)(lds + 41984);
                LAS float* Bbf = (LAS float*)(lds + 50176);
                LAS float* Bbb = (LAS float*)(lds + 58368);
                for (int item = bid; item < 256; item += G) {
                    const int g = item >> 2, tq = item & 3;
                    __syncthreads();
                    for (int e = tid; e < 2 * 33 * 64; e += 512) { const int dir = e / (33 * 64), r = e % (33 * 64), k = r >> 6, pp = r & 63; const int pg = (jj * 2 + dir) * 64 + g;
                        const float dt = __expf(p.s5_ldt[pg]); float re, im; cpow(p.s5_lre[pg * 64 + pp] * dt, p.s5_lim[pg * 64 + pp] * dt, (float)k, re, im);
                        LAS float* d = dir ? apb : apf; d[r * 2] = re; d[r * 2 + 1] = im; }
                    for (int e = tid; e < 2048; e += 512) { const int dir = e >> 10, r = e & 1023; const int pg = (jj * 2 + dir) * 64 + g;
                        { const int h2 = r >> 6, p2 = r & 63; LAS float* d = dir ? Cb : Cf; d[r * 2] = p.s5_cre[((size_t)pg * 16 + h2) * 64 + p2]; d[r * 2 + 1] = p.s5_cim[((size_t)pg * 16 + h2) * 64 + p2]; }
                        { const int pp = r >> 4, h = r & 15; const float dt = __expf(p.s5_ldt[pg]); float kr, ki; s5_kcoef(p.s5_lre[pg * 64 + pp], p.s5_lim[pg * 64 + pp], dt, kr, ki);
                          const float br = p.s5_bre[((size_t)pg * 64 + pp) * 16 + h], bi = p.s5_bim[((size_t)pg * 64 + pp) * 16 + h];
                          LAS float* d = dir ? Bbb : Bbf; d[r * 2] = kr * br - ki * bi; d[r * 2 + 1] = kr * bi + ki * br; } }
                    __syncthreads();
                    for (int e = tid; e < 4096; e += 512) { const int ee = tq * 4096 + e; const int hh = ee & 1, s = (ee >> 1) & 31, pp = (ee >> 6) & 63, ri = (ee >> 12) & 1, dir = ee >> 13;
                        const int ex = dir ? s : 31 - s; const LAS float* apd = dir ? apb : apf; const LAS float* bd = dir ? Bbb : Bbf;
                        const float ar = apd[(ex * 64 + pp) * 2], ai = apd[(ex * 64 + pp) * 2 + 1];
                        float v[8];
#pragma unroll
                        for (int i = 0; i < 8; ++i) { const float br = bd[(pp * 16 + hh * 8 + i) * 2], bi = bd[(pp * 16 + hh * 8 + i) * 2 + 1]; v[i] = ri ? ar * bi + ai * br : ar * br - ai * bi; }
                        *(u32x4*)(W1S + ((size_t)(g * 256 + dir * 128 + ri * 64 + pp)) * 512 + s * 16 + hh * 8) = (u32x4){pk2(v[0], v[1]), pk2(v[2], v[3]), pk2(v[4], v[5]), pk2(v[6], v[7])}; }
                    const float* ktf = KTAB + (((size_t)jj * 64 + g) * 2 + 0) * 32 * 256; const float* ktb = ktf + 32 * 256;
                    for (int e = tid; e < 128 * 96; e += 512) { const int kc = e % 96, rowi = e / 96, t = tq * 8 + (rowi >> 4), h = rowi & 15;
                        float v[8];
                        if (kc < 64) { const int s = kc >> 1, h0 = (kc & 1) * 8;
#pragma unroll
                            for (int i = 0; i < 8; ++i) v[i] = 0.f;
                            if (s <= t) { const f32x4* kp = (const f32x4*)(ktf + (t - s) * 256 + h * 16 + h0); const f32x4 a = kp[0], b = kp[1];
#pragma unroll
                                for (int i = 0; i < 4; ++i) { v[i] += a[i]; v[4 + i] += b[i]; } }
                            if (s >= t) { const f32x4* kp = (const f32x4*)(ktb + (s - t) * 256 + h * 16 + h0); const f32x4 a = kp[0], b = kp[1];
#pragma unroll
                                for (int i = 0; i < 4; ++i) { v[i] += a[i]; v[4 + i] += b[i]; } }
                            if (s == t) { const float dd = p.s5_d[jj * D + g * 16 + h];
#pragma unroll
                                for (int i = 0; i < 8; ++i) if (h0 + i == h) v[i] += dd; }
                        } else { const int q = kc - 64, dir = q >> 4, ri = (q >> 3) & 1, p0 = (q & 7) * 8; const int ex = dir ? 32 - t : t + 1;
                            const LAS float* apd = dir ? apb : apf; const LAS float* cd = dir ? Cb : Cf;
#pragma unroll
                            for (int i = 0; i < 8; ++i) { const int pp = p0 + i; const float ar = apd[(ex * 64 + pp) * 2], ai = apd[(ex * 64 + pp) * 2 + 1], cr = cd[(h * 64 + pp) * 2], ci = cd[(h * 64 + pp) * 2 + 1];
                                v[i] = ri ? -(cr * ai + ci * ar) : cr * ar - ci * ai; } }
                        *(u32x4*)(W3S + ((size_t)(g * 512 + t * 16 + h)) * UGP + kc * 8) = (u32x4){pk2(v[0], v[1]), pk2(v[2], v[3]), pk2(v[4], v[5]), pk2(v[6], v[7])}; }
                }
                __syncthreads();
            } else {
                for (int rep = 0; rep < NREP(3); ++rep) norm_rows_tok(xl, xc, ng, modl, 0, HN, TA, gw, NGW, lane, kind == 2, fxA);
                if (kind == 2) {
                    bf16_t* CS = (bf16_t*)(ws + WS_CS); bf16_t* CN2 = (bf16_t*)(ws + WS_CN256); bf16_t* W1M = (bf16_t*)(ws + WS_W1M); bf16_t* W2M = (bf16_t*)(ws + WS_W2M);
                    const int gt = bid * 512 + tid, NT = G * 512;
                    for (int e = gt; e < 2 * 256 * 16; e += NT) { const int which = e >> 12, r = (e >> 4) & 255, kc = e & 15, k0 = (kc & 7) * 8, hs = kc >> 3; float v[8];
#pragma unroll
                        for (int i = 0; i < 8; ++i) { const int mm = r & 63; const float rev = (float)((mm * (k0 + i)) & 63) * (1.f / 64.f); const float cs = __builtin_amdgcn_cosf(rev), sn = __builtin_amdgcn_sinf(rev);
                            float val = 0.f;
                            if (which == 0) { if (r < 64) val = hs ? -sn : cs; else if (r >= 128 && r < 192) val = hs ? -cs : -sn; }
                            else { if (r < 64) val = hs ? sn : cs; }
                            v[i] = val; }
                        *(u32x4*)((which ? W2M : W1M) + (size_t)r * 128 + kc * 8) = (u32x4){pk2(v[0], v[1]), pk2(v[2], v[3]), pk2(v[4], v[5]), pk2(v[6], v[7])}; }
                    for (int e = gt; e < 512 * 32; e += NT) { const int m = e >> 5, kc = m & 255, isS = m >> 8, k0 = (e & 31) * 8; float v[8];
#pragma unroll
                        for (int i = 0; i < 8; ++i) { const float rev = (float)((kc * (k0 + i)) & 255) * (1.f / 256.f); v[i] = (isS ? __builtin_amdgcn_sinf(rev) : __builtin_amdgcn_cosf(rev)) * (1.f / 16.f); }
                        *(u32x4*)(CS + (size_t)m * 256 + k0) = (u32x4){pk2(v[0], v[1]), pk2(v[2], v[3]), pk2(v[4], v[5]), pk2(v[6], v[7])}; }
                    for (int e = gt; e < 256 * 64; e += NT) { const int m = e >> 6, kc = e & 63, k0 = (kc & 31) * 8, isS = kc >> 5; float v[8];
#pragma unroll
                        for (int i = 0; i < 8; ++i) { const float rev = (float)((m * (k0 + i)) & 255) * (1.f / 256.f); v[i] = (isS ? -__builtin_amdgcn_sinf(rev) : __builtin_amdgcn_cosf(rev)) * (1.f / 16.f); }
                        *(u32x4*)(CN2 + (size_t)m * 512 + kc * 8) = (u32x4){pk2(v[0], v[1]), pk2(v[2], v[3]), pk2(v[4], v[5]), pk2(v[6], v[7])}; }
                }
            }
        }
        PH_END;

        if (kind == 0) {
            if (PH_ON) {
                pg8::Gemm g{HN, (const bf16_t*)(ws + WS_W1S), UGP, 512, 512, (size_t)NCH * UGP, (size_t)256 * 512};
                pg8::Sched S; S.init(5, 1, 64);
                pg8::EpiSloc E{(float*)(ws + WS_SLOC)};
                pg8::gemm_phase(lds, g, S, E, wave0);
            }
            PH_END;
            if (PH_ON) {
                FRESH_IDS;
                const float* SL = (const float*)(ws + WS_SLOC);
                for (int id = bid * 512 + tid; id < 8 * 64 * 2 * 64; id += G * 512) {
                    const int pp = id & 63, dir = (id >> 6) & 1, g = (id >> 7) & 63, b = id >> 13;
                    const int pg = (jj * 2 + dir) * 64 + g; const float dt = __expf(p.s5_ldt[pg]);
                    float ar, ai; cpow(p.s5_lre[pg * 64 + pp] * dt, p.s5_lim[pg * 64 + pp] * dt, 32.f, ar, ai);
                    float sr = 0.f, si = 0.f;
                    const size_t rb = (size_t)g * NCH + b * 136;
                    for (int k0 = 0; k0 < 136; k0 += 8) {
                        float lr[8], lim[8];
#pragma unroll
                        for (int q = 0; q < 8; ++q) { const int k = k0 + q; const int cc = dir == 0 ? k : (k < 8 ? 7 - k : 143 - k);
                            lr[q] = SL[(rb + cc) * 256 + dir * 128 + pp]; lim[q] = SL[(rb + cc) * 256 + dir * 128 + 64 + pp]; }
#pragma unroll
                        for (int q = 0; q < 8; ++q) { const int k = k0 + q; const int cc = dir == 0 ? k : (k < 8 ? 7 - k : 143 - k);
                            bf16_t* o = HN + (rb + cc) * UGP + 512 + dir * 128 + pp;
                            o[0] = (bf16_t)(pk2(sr, 0.f) & 0xffffu); o[64] = (bf16_t)(pk2(si, 0.f) & 0xffffu);
                            const float nr = ar * sr - ai * si + lr[q], ni = ar * si + ai * sr + lim[q]; sr = nr; si = ni; }
                    }
                }
            }
            PH_END;
            if (PH_ON) {
                pg8::Gemm g{HN, (const bf16_t*)(ws + WS_W3S), UGP, UGP, UGP, (size_t)NCH * UGP, (size_t)512 * UGP};
                pg8::Sched S; S.init(5, 2, 64);
                pg8::EpiZ E{(bf16_t*)(ws + WS_Z)};
                pg8::gemm_phase(lds, g, S, E, wave0);
            }
            PH_END;
            if (PH_ON) {
                pg8::Gemm g{(const bf16_t*)(ws + WS_Z), GLUT + (size_t)jj * D * 2 * D, D, D, D, 0, 0};
                pg8::Sched S; S.init(last ? 128 : 136, 8, 1);
                pg8::EpiGlu E{xl, xc, p.out, XCTX, modl + 2 * D};
                pg8::gemm_phase(lds, g, S, E, wave0);
            }
            PH_END;
        } else if (kind == 1) {
            bf16_t* QK = (bf16_t*)(ws + WS_QK); bf16_t* VT = (bf16_t*)(ws + WS_VT);
            if (PH_ON) {
                { pg8::Gemm g{HN, QKVT, D, D, D, 0, 0}; pg8::Sched S; S.init(136, 8, 1); pg8::EpiQK E{QK, p.qn, p.kn}; pg8::gemm_phase(lds, g, S, E, wave0); }
                { pg8::Gemm g{QKVT + (size_t)2048 * D, HN, D, D, D, 0, 0}; pg8::Sched S; S.init(4, 136, 1, 0, 128); pg8::EpiStore<0> E{VT, (size_t)TA, 0}; pg8::gemm_phase(lds, g, S, E, wave0); }
            }
            PH_END;
            if (PH_ON) {
                FRESH_IDS;
                const int l31 = lane & 31, hi = lane >> 5, comp = wave >> 2, wq = wave & 3;
                float lamv; { const float a = wave_sum(p.dlam[lane] * p.dlam[64 + lane], lane), b = wave_sum(p.dlam[128 + lane] * p.dlam[192 + lane], lane); lamv = __expf(a) - __expf(b) + LAM_INIT; }
                const int vcu = (G % 8 == 0) ? (bid % 8) * (G / 8) + bid / 8 : bid;
                constexpr int KROW = 144, KTILE = 64 * KROW, VTILE = 128 * KROW, VRING = 4 * KTILE;
                const int kr = tid >> 3, kch = tid & 7;
                const int kst = kr * KROW + kch * 16, vst = kr * KROW + ((kch >> 1) * 32 + (kch & 1) * 8);
                for (int rep = 0; rep < NREP(2); ++rep)
                for (int u = vcu; u < 2176; u += G) {
                    int b, head, qrow0, j0;
                    if (u < 2048) { b = u >> 8; head = (u >> 5) & 7; qrow0 = b * 4096 + (u & 31) * 128; j0 = 0; }
                    else { const int v = u - 2048; b = v >> 4; head = (v >> 1) & 7; qrow0 = TL + b * 256 + (v & 1) * 128; j0 = 64; }
                    bf16x8 qf[4];
                    { const bf16_t* qp = QK + (size_t)(qrow0 + wq * 32 + l31) * 2048 + head * 128 + comp * 64 + hi * 8;
#pragma unroll
                      for (int ds = 0; ds < 4; ++ds) qf[ds] = *(const bf16x8*)(qp + ds * 16); }
                    const bf16_t* kbase = QK + (size_t)kr * 2048 + 1024 + head * 128 + kch * 8;
                    const bf16_t* vbase = VT + (size_t)(head * 128 + kr) * TA + kch * 8;
                    u32x4 pk0, pk1, pv0, pv1;
#define ATT_TOKBASE(j) ((j) < 64 ? b * 4096 + 64 * (j) : TL + b * 256 + 64 * ((j) - 64))
#define ATT_LOADK(j) do { const bf16_t* kp_ = kbase + (size_t)ATT_TOKBASE(j) * 2048; pk0 = *(const u32x4*)kp_; pk1 = *(const u32x4*)(kp_ + 64); } while (0)
#define ATT_LOADV(j) do { const bf16_t* vp_ = vbase + ATT_TOKBASE(j); pv0 = *(const u32x4*)vp_; pv1 = *(const u32x4*)(vp_ + (size_t)64 * TA); } while (0)
#define ATT_STOREK(sl) do { LAS unsigned char* bb_ = lds + (sl) * (2 * KTILE) + kst; *(LAS u32x4*)(bb_) = pk0; *(LAS u32x4*)(bb_ + KTILE) = pk1; } while (0)
#define ATT_STOREV(sl) do { LAS unsigned char* vb_ = lds + VRING + (sl) * VTILE + vst; \
                        *(LAS u32x2*)(vb_) = (u32x2){pv0.x, pv0.y}; *(LAS u32x2*)(vb_ + 16) = (u32x2){pv0.z, pv0.w}; \
                        *(LAS u32x2*)(vb_ + 64 * KROW) = (u32x2){pv1.x, pv1.y}; *(LAS u32x2*)(vb_ + 64 * KROW + 16) = (u32x2){pv1.z, pv1.w}; } while (0)
#define ATT_QK(S0, S1, sl, CI) do { const LAS unsigned char* kb_ = lds + (sl) * (2 * KTILE) + comp * KTILE + l31 * KROW + hi * 16; bf16x8 kf_[8]; \
                        _Pragma("unroll") for (int ds = 0; ds < 4; ++ds) { kf_[2 * ds] = *(const LAS bf16x8*)(kb_ + ds * 32); kf_[2 * ds + 1] = *(const LAS bf16x8*)(kb_ + 32 * KROW + ds * 32); } \
                        __builtin_amdgcn_sched_barrier(0); \
                        _Pragma("unroll") for (int ds = 0; ds < 4; ++ds) { \
                            S0 = __builtin_amdgcn_mfma_f32_32x32x16_bf16(kf_[2 * ds], qf[ds], ds == 0 ? CI : S0, 0, 0, 0); S1 = __builtin_amdgcn_mfma_f32_32x32x16_bf16(kf_[2 * ds + 1], qf[ds], ds == 0 ? CI : S1, 0, 0, 0); } } while (0)
#define ATT_PV(sl) do { const LAS unsigned char* vb_ = lds + VRING + (sl) * VTILE + l31 * KROW + hi * 16; \
                        _Pragma("unroll") for (int ks = 0; ks < 4; ++ks) _Pragma("unroll") for (int dt = 0; dt < 4; ++dt) { const bf16x8 a_ = *(const LAS bf16x8*)(vb_ + dt * 32 * KROW + ks * 32); \
                            o[dt] = __builtin_amdgcn_mfma_f32_32x32x16_bf16(a_, pp[ks], o[dt], 0, 0, 0); } } while (0)
#define ATT_SOFT(S0, S1, PD) do { f32x2 ls_ = {0.f, 0.f}; \
                        _Pragma("unroll") for (int r = 0; r < 16; ++r) { S0[r] = __builtin_amdgcn_exp2f(S0[r]); S1[r] = __builtin_amdgcn_exp2f(S1[r]); } \
                        _Pragma("unroll") for (int r = 0; r < 16; r += 2) { ls_ += (f32x2){S0[r], S0[r + 1]}; ls_ += (f32x2){S1[r], S1[r + 1]}; } \
                        l_run += ls_.x + ls_.y; \
                        { u32x4 w_; \
                          w_ = (u32x4){pk2(S0[0], S0[1]), pk2(S0[2], S0[3]), pk2(S0[4], S0[5]), pk2(S0[6], S0[7])}; PD[0] = __builtin_bit_cast(bf16x8, w_); \
                          w_ = (u32x4){pk2(S0[8], S0[9]), pk2(S0[10], S0[11]), pk2(S0[12], S0[13]), pk2(S0[14], S0[15])}; PD[1] = __builtin_bit_cast(bf16x8, w_); \
                          w_ = (u32x4){pk2(S1[0], S1[1]), pk2(S1[2], S1[3]), pk2(S1[4], S1[5]), pk2(S1[6], S1[7])}; PD[2] = __builtin_bit_cast(bf16x8, w_); \
                          w_ = (u32x4){pk2(S1[8], S1[9]), pk2(S1[10], S1[11]), pk2(S1[12], S1[13]), pk2(S1[14], S1[15])}; PD[3] = __builtin_bit_cast(bf16x8, w_); } } while (0)
                    f32x16 o[4];
#pragma unroll
                    for (int dt = 0; dt < 4; ++dt)
#pragma unroll
                        for (int r = 0; r < 16; ++r) o[dt][r] = 0.f;
                    float m_ref, l_run = 0.f;
                    f32x16 negm, zero16;
#pragma unroll
                    for (int r = 0; r < 16; ++r) zero16[r] = 0.f;
                    bf16x8 pp[4];
                    __syncthreads();
                    ATT_LOADK(j0); ATT_STOREK(j0 & 1);
                    __syncthreads();
                    {
                        ATT_LOADK(j0 + 1); ATT_LOADV(j0);
                        f32x16 s0, s1;
                        ATT_QK(s0, s1, j0 & 1, zero16);
                        float mx = fmaxf(s0[0], s1[0]);
#pragma unroll
                        for (int r = 1; r < 16; ++r) mx = fmaxf(mx, fmaxf(s0[r], s1[r]));
                        m_ref = xhalf_max(mx);
#pragma unroll
                        for (int r = 0; r < 16; ++r) { s0[r] -= m_ref; s1[r] -= m_ref; negm[r] = -m_ref; }
                        ATT_SOFT(s0, s1, pp);
                        ATT_STOREK((j0 + 1) & 1); ATT_STOREV(j0 & 1);
                        __syncthreads();
                    }
                    for (int j = j0 + 1; j < 68; ++j) {
                        const int jn = j + 1 < 68 ? j + 1 : 67;
                        ATT_LOADK(jn); ATT_LOADV(j);
                        f32x16 s0, s1;
                        ATT_QK(s0, s1, j & 1, negm);
                        float mx = max3f(s0[0], s1[0], s0[1]), mx2 = max3f(s1[1], s0[2], s1[2]);
#pragma unroll
                        for (int r = 3; r < 15; r += 2) { mx = max3f(mx, s0[r], s1[r]); mx2 = max3f(mx2, s0[r + 1], s1[r + 1]); }
                        mx = max3f(mx, s0[15], s1[15]); mx = fmaxf(mx, mx2);
                        mx = xhalf_max(mx);
                        if (__builtin_expect(__any(mx > ATT_THR), 0)) {
                            const float dl = ceilf(fmaxf(mx, 0.f)), f = __builtin_amdgcn_exp2f(-dl);
                            m_ref += dl; l_run *= f;
#pragma unroll
                            for (int r = 0; r < 16; ++r) { s0[r] -= dl; s1[r] -= dl; negm[r] = -m_ref; }
#pragma unroll
                            for (int dt = 0; dt < 4; ++dt)
#pragma unroll
                                for (int r = 0; r < 16; ++r) o[dt][r] *= f;
#pragma unroll
                            for (int ks = 0; ks < 4; ++ks) { u32x4 w = __builtin_bit_cast(u32x4, pp[ks]);
                                w.x = pk2(bflo(w.x) * f, bfhi(w.x) * f); w.y = pk2(bflo(w.y) * f, bfhi(w.y) * f); w.z = pk2(bflo(w.z) * f, bfhi(w.z) * f); w.w = pk2(bflo(w.w) * f, bfhi(w.w) * f);
                                pp[ks] = __builtin_bit_cast(bf16x8, w); }
                        }
                        __builtin_amdgcn_sched_barrier(0);
                        unsigned pw[16]; f32x2 ls = {0.f, 0.f};
                        {
                            const LAS unsigned char* vb_ = lds + VRING + ((j - 1) & 1) * VTILE + l31 * KROW + hi * 16;
                            bf16x8 vf[16];
#define ATT_VRD(i) vf[i] = *(const LAS bf16x8*)(vb_ + ((i) & 3) * 32 * KROW + ((i) >> 2) * 32)
                            ATT_VRD(0); ATT_VRD(1);
#pragma unroll
                            for (int i = 0; i < 16; ++i) {
                                if (i + 2 < 16) ATT_VRD(i + 2);
                                o[i & 3] = __builtin_amdgcn_mfma_f32_32x32x16_bf16(vf[i], pp[i >> 2], o[i & 3], 0, 0, 0);
                                s0[i] = __builtin_amdgcn_exp2f(s0[i]); s1[i] = __builtin_amdgcn_exp2f(s1[i]);
                                if (i & 1) { pw[i >> 1] = pk2(s0[i - 1], s0[i]); pw[8 + (i >> 1)] = pk2(s1[i - 1], s1[i]); ls += (f32x2){s0[i - 1], s0[i]}; ls += (f32x2){s1[i - 1], s1[i]}; }
                                __builtin_amdgcn_sched_barrier(0);
                            }
#undef ATT_VRD
                        }
                        l_run += ls.x + ls.y;
#pragma unroll
                        for (int ks = 0; ks < 4; ++ks) { const u32x4 w = {pw[4 * ks], pw[4 * ks + 1], pw[4 * ks + 2], pw[4 * ks + 3]}; pp[ks] = __builtin_bit_cast(bf16x8, w); }
                        ATT_STOREK(jn & 1); ATT_STOREV(j & 1);
                        __syncthreads();
                    }
                    ATT_PV(67 & 1);
#undef ATT_TOKBASE
#undef ATT_LOADK
#undef ATT_LOADV
#undef ATT_STOREK
#undef ATT_STOREV
#undef ATT_QK
#undef ATT_PV
#undef ATT_SOFT
                    { const float lt = xhalf_sum(l_run); const float inv = 1.f / lt;
#pragma unroll
                      for (int dt = 0; dt < 4; ++dt)
#pragma unroll
                          for (int r = 0; r < 16; ++r) o[dt][r] *= inv; }
                    __syncthreads();
                    LAS float* ex = (LAS float*)lds + wq * 4096;
                    if (comp == 1) {
#pragma unroll
                        for (int dt = 0; dt < 4; ++dt)
#pragma unroll
                            for (int r = 0; r < 16; ++r) ex[(dt * 16 + r) * 64 + lane] = o[dt][r];
                    }
                    __syncthreads();
                    LAS bf16_t* stg = (LAS bf16_t*)(lds + 81920) + wq * (32 * 136);
                    if (comp == 0) {
                        float ss = 0.f;
#pragma unroll
                        for (int dt = 0; dt < 4; ++dt)
#pragma unroll
                            for (int r = 0; r < 16; ++r) { const float d = o[dt][r] - lamv * ex[(dt * 16 + r) * 64 + lane]; o[dt][r] = d; ss += d * d; }
                        ss = xhalf_sum(ss);
                        const float rstd = rsqrtf(ss * (1.f / 128.f) + EPS) * (1.f - LAM_INIT);
#pragma unroll
                        for (int dt = 0; dt < 4; ++dt)
#pragma unroll
                            for (int r = 0; r < 16; ++r) { const int dv = 32 * dt + (r & 3) + 8 * (r >> 2) + 4 * hi; stg[l31 * 136 + dv] = (bf16_t)(pk2(o[dt][r] * rstd * p.subln[dv], 0.f) & 0xffffu); }
                    }
                    __syncthreads();
                    if (comp == 0) {
#pragma unroll
                        for (int it = 0; it < 8; ++it) { const int row = it * 4 + (lane >> 4), ch = lane & 15;
                            const u32x4 w = *(const LAS u32x4*)(stg + row * 136 + ch * 8);
                            *(u32x4*)(HN + (size_t)(qrow0 + wq * 32 + row) * D + head * 128 + ch * 8) = w; }
                    }
                }
                __syncthreads();
            }
            PH_END;
        } else {
            if (PH_ON) {
                pg8::Gemm g{(const bf16_t*)(ws + WS_CS), HN, 256, D, 256, 0, 256};
                pg8::Sched S; S.init(2, 136, 4);
                pg8::EpiChanDft E{(bf16_t*)(ws + WS_PQT), (bf16_t*)(ws + WS_PQC)};
                pg8::gemm_phase(lds, g, S, E, wave0);
            }
            PH_END;
            if (PH_ON) {
                { pg8::Gemm g{(const bf16_t*)(ws + WS_W1M), (const bf16_t*)(ws + WS_PQT), 128, 128, 128, 0, 0};
                  pg8::Sched S; S.init(1, 2048, 1); pg8::EpiFft1 E{(bf16_t*)(ws + WS_B2)}; pg8::gemm_phase(lds, g, S, E, wave0); }
                { pg8::Gemm g{(const bf16_t*)(ws + WS_CN256), (const bf16_t*)(ws + WS_PQC), 512, 512, 512, 0, (size_t)1024 * 512};
                  pg8::Sched S; S.init(1, 4, 8); pg8::EpiStore<0> E{HN + (size_t)TL * D, D, (size_t)256 * D}; pg8::gemm_phase(lds, g, S, E, wave0); }
            }
            PH_END;
            if (PH_ON) {
                pg8::Gemm g{(const bf16_t*)(ws + WS_W2M), (const bf16_t*)(ws + WS_B2), 128, 128, 128, 0, 0};
                pg8::Sched S; S.init(1, 2048, 1); pg8::EpiFft2 E{HN}; pg8::gemm_phase(lds, g, S, E, wave0);
            }
            PH_END;
        }
        if (kind != 0) {
            if (PH_ON) {
                { pg8::Gemm g{HN, kind == 1 ? WOT : FWT, D, D, D, 0, 0};
                  pg8::Sched S; S.init(128, 4, 1);
                  pg8::EpiResid E{xl, xc, p.out, XCTX, modl + 2 * D, kind == 2 ? p.fb : nullptr};
                  pg8::gemm_phase(lds, g, S, E, wave0); }
                if (!last) { pg8::Gemm g{HN, kind == 1 ? WOT : FWT, D, D, D / KSPLIT, (size_t)(D / KSPLIT), (size_t)(D / KSPLIT)};
                  pg8::Sched S; S.init(8, 4, KSPLIT, 128);
                  pg8::EpiPart E{PART};
                  pg8::gemm_phase(lds, g, S, E, wave0); }
            }
            PH_END;
        }
        if (PH_ON) { FRESH_IDS; for (int rep = 0; rep < NREP(3); ++rep) norm_rows_tok(p.out, XCTX, ng + D, modl, 3, HN, last ? TL : TA, gw, NGW, lane, false, fxF); }
        PH_END;
        if (PH_ON) {
            for (int rep = 0; rep < NREP(0); ++rep) {
            pg8::Gemm g{HN, W1T + (size_t)li * D * DFF, D, D, D, 0, 0};
            pg8::Sched S; S.init(last ? 128 : 136, 16, 1);
            pg8::EpiStore<1> E{HB, DFF, 0};
            pg8::gemm_phase(lds, g, S, E, wave0); }
        }
        PH_END;
        if (PH_ON) {
            if (!last) { pg8::Gemm g{HB, W2T + (size_t)li * D * DFF, DFF, DFF, DFF / KSPLIT, (size_t)(DFF / KSPLIT), (size_t)(DFF / KSPLIT)};
              pg8::Sched S; S.init(8, 4, KSPLIT, 128);
              pg8::EpiPart E{PART};
              pg8::gemm_phase(lds, g, S, E, wave0); }
            for (int rep = 0; rep < NREP(1); ++rep) {
            pg8::Gemm g{HB, W2T + (size_t)li * D * DFF, DFF, DFF, DFF, 0, 0};
            pg8::Sched S; S.init(128, 4, 1);
            pg8::EpiResid E{p.out, XCTX, p.out, XCTX, (rep + 1 < NREP(1)) ? (const float*)(ws + WS_ZERO) : modl + 5 * D, nullptr};
            pg8::gemm_phase(lds, g, S, E, wave0); }
        }
        PH_END;
    }
}

extern "C" void kernel_launch(void* const* d_in, const int* in_sizes, int n_in, void* d_out, int out_size, void* d_ws, size_t ws_size, hipStream_t stream) {
    static int grid = 0;
    if (grid == 0) {
        int dev = 0, cus = 0, per_cu = 0;
        hipGetDevice(&dev);
        hipDeviceGetAttribute(&cus, hipDeviceAttributeMultiprocessorCount, dev);
        hipFuncSetAttribute((const void*)mega_fwd, hipFuncAttributeMaxDynamicSharedMemorySize, LDS_BYTES);
        hipOccupancyMaxActiveBlocksPerMultiprocessor(&per_cu, (const void*)mega_fwd, 512, LDS_BYTES);
        if (per_cu < 1) per_cu = 1;
        grid = cus * per_cu;
        if (ws_size < WS_END) fprintf(stderr, "kernel_launch: workspace too small: %zu < %zu\n", ws_size, (size_t)WS_END);
    }
    (void)hipMemsetAsync((char*)d_ws + WS_CTL, 0, CTL_BYTES, stream);
    Params p{};
    const float** f = (const float**)&p;
    for (int i = 0; i < 26; ++i) f[i] = (const float*)d_in[i];
    p.out = (float*)d_out; p.ws = (unsigned char*)d_ws; p.ph_lo = 0; p.ph_hi = 1000;
    void* args[] = {&p};
    hipError_t e = hipLaunchCooperativeKernel((const void*)mega_fwd, dim3(grid), dim3(512), args, LDS_BYTES, stream);
    if (e != hipSuccess) fprintf(stderr, "cooperative launch failed: %s (grid %d)\n", hipGetErrorString(e), grid);
}
```

```cpp
#include <hip/hip_runtime.h>
#include <hip/hip_cooperative_groups.h>
#include <cstdio>
#include <cstdint>
namespace cg = cooperative_groups;

#define LAS __attribute__((address_space(3)))
typedef unsigned short bf16_t;
typedef short bf16x8 __attribute__((ext_vector_type(8)));
typedef float f32x2 __attribute__((ext_vector_type(2)));
typedef float f32x4 __attribute__((ext_vector_type(4)));
typedef float f32x16 __attribute__((ext_vector_type(16)));
typedef unsigned u32x2 __attribute__((ext_vector_type(2)));
typedef unsigned u32x4 __attribute__((ext_vector_type(4)));
typedef __bf16 bf16x2_t __attribute__((ext_vector_type(2)));

__device__ __forceinline__ unsigned pk2(float lo, float hi) { f32x2 v = {lo, hi}; bf16x2_t b = __builtin_convertvector(v, bf16x2_t); return __builtin_bit_cast(unsigned, b); }
__device__ __forceinline__ float bflo(unsigned w) { return __uint_as_float(w << 16); }
__device__ __forceinline__ float bfhi(unsigned w) { return __uint_as_float(w & 0xffff0000u); }
__device__ __forceinline__ float shx(float v, int lane, int m) { return __int_as_float(__builtin_amdgcn_ds_bpermute((lane ^ m) << 2, __float_as_int(v))); }
__device__ __forceinline__ float wave_sum(float v, int lane) {
#pragma unroll
    for (int o = 1; o < 64; o <<= 1) v += shx(v, lane, o);
    return v;
}
__device__ __forceinline__ float xhalf_max(float v) { auto rr = __builtin_amdgcn_permlane32_swap(__float_as_uint(v), __float_as_uint(v), false, false); return fmaxf(__uint_as_float(rr[0]), __uint_as_float(rr[1])); }
__device__ __forceinline__ float xhalf_sum(float v) { auto rr = __builtin_amdgcn_permlane32_swap(__float_as_uint(v), __float_as_uint(v), false, false); return __uint_as_float(rr[0]) + __uint_as_float(rr[1]); }
__device__ __forceinline__ int fresh_tid(int wave0) { int l; asm volatile("v_mbcnt_lo_u32_b32 %0, -1, 0\n\tv_mbcnt_hi_u32_b32 %0, -1, %0" : "=v"(l)); return wave0 * 64 + l; }
#define LAUNDER_V(x) asm volatile("" : "+v"(x))
__device__ __forceinline__ float max3f(float a, float b, float c) { float r; asm("v_max3_f32 %0, %1, %2, %3" : "=v"(r) : "v"(a), "v"(b), "v"(c)); return r; }
__device__ __forceinline__ float sigmoidf_(float x) { return __builtin_amdgcn_rcpf(1.0f + __builtin_amdgcn_exp2f(-1.4426950408889634f * x)); }
__device__ __forceinline__ float gelu_tanh(float x) { const float u = 0.7978845608028654f * (x + 0.044715f * x * x * x); return x * sigmoidf_(2.0f * u); }

constexpr int D = 1024, TL = 32768, TC = 2048, TA = TL + TC, DFF = 4096, NMOD = 6;
constexpr int NCH = 1088;
constexpr int UGP = 768;
constexpr float EPS = 1e-6f;
constexpr float LAM_INIT = 0.35550906759f;
constexpr float QSCALE = 0.125f * 1.4426950408889634f;
#ifndef REP_MASK
#define REP_MASK 0
#endif
#define NREP(bit) ((REP_MASK >> (bit)) & 1 ? 2 : 1)
#ifndef ATT_THR
#define ATT_THR 16.0f
#endif

constexpr size_t MiB = 1u << 20;
constexpr size_t WS_W1T = 0, WS_W2T = 32 * MiB, WS_GLUT = 64 * MiB, WS_QKVT = 72 * MiB, WS_WOT = 78 * MiB, WS_FWT = 80 * MiB;
constexpr size_t WS_ZERO = 474 * MiB, WS_CTL = 475 * MiB, CTL_BYTES = 16384;
constexpr size_t WS_PART = 476 * MiB;
constexpr int KSPLIT = 4;
constexpr size_t WS_MOD = 82 * MiB, WS_KTAB = 83 * MiB, WS_XCTX = 91 * MiB, WS_HN = 99 * MiB, WS_H = 202 * MiB, WS_END = 474 * MiB;
constexpr size_t WS_SLOC = WS_H, WS_W1S = WS_H + 68 * MiB, WS_W3S = WS_H + 84 * MiB, WS_Z = WS_H + 132 * MiB;
constexpr size_t WS_QK = WS_H, WS_VT = WS_H + 136 * MiB;
constexpr size_t WS_PQT = WS_H, WS_PQC = WS_H + 128 * MiB, WS_B2 = WS_H + 136 * MiB, WS_CS = WS_H + 264 * MiB, WS_CN256 = WS_H + 265 * MiB, WS_W1M = WS_H + 266 * MiB, WS_W2M = WS_H + 267 * MiB;

constexpr int LDS_BYTES = 147456;

struct Params {
    const float *x, *c, *ctx, *c_ctx, *w_mod, *b_mod, *norm_g, *mlp_w1, *mlp_w2;
    const float *s5_lre, *s5_lim, *s5_ldt, *s5_bre, *s5_bim, *s5_cre, *s5_cim, *s5_d, *s5_wglu;
    const float *wqkv, *qn, *kn, *dlam, *subln, *wo, *fw, *fb;
    float* out; unsigned char* ws;
    int ph_lo, ph_hi;
};

namespace pg8 {
constexpr int BM = 256, BK = 64, HALF = 128, HTB = HALF * BK * 2, STAGE_BYTES = 8 * HTB, NXCD = 8, WGM = 8;
__host__ __device__ __forceinline__ int lds_byte(int r, int c) { const int st = (r >> 4) * 2 + (c >> 5), rr = r & 15, cc = c & 31, ob = rr * 64 + cc * 2; return st * 1024 + (ob ^ (((ob >> 9) & 1) << 5)); }
__host__ __device__ __forceinline__ void stage_rc(int b, int& R, int& C) { const int st = b / 1024, sb = b % 1024, swz = sb ^ (((sb >> 9) & 1) << 5); R = (st >> 1) * 16 + swz / 64; C = (st & 1) * 32 + (swz % 64) / 2; }
__host__ __device__ __forceinline__ int perm32(int rho) { const int n = rho >> 4, i = rho & 15; return 8 * (i >> 2) + 4 * n + (i & 3); }

struct Unit { int pm, pn, pb; };
struct Gemm { const bf16_t* A; const bf16_t* Bt; int lda, ldb, K; size_t batchA, batchB; };
struct Sched {
    int nM, nN, nwg, G, c;
    int pm0;
    __device__ __forceinline__ void init(int nM_, int nN_, int nB_, int pm0_ = 0, int coff = 0) { nM = nM_; nN = nN_; nwg = nM_ * nN_ * nB_; G = gridDim.x; c = (blockIdx.x + coff) % gridDim.x; pm0 = pm0_; }
    __device__ __forceinline__ bool next(int i, Unit& u) const {
        const long L = (long)i * G + c; if (L >= nwg) return false;
        int wgid = (int)L; { const int q = nwg / NXCD, r = nwg % NXCD, xcd = wgid % NXCD, off = wgid / NXCD; wgid = (xcd < r ? xcd * (q + 1) : r * (q + 1) + (xcd - r) * q) + off; }
        const int upb = nM * nN; u.pb = wgid / upb; const int w = wgid - u.pb * upb;
        const int nig = WGM * nN, gid = w / nig, fm = gid * WGM, gsz = (nM - fm) < WGM ? (nM - fm) : WGM;
        u.pm = pm0 + fm + ((w % nig) % gsz); u.pn = (w % nig) / gsz; return true;
    }
};

template <class Epi>
__device__ __forceinline__ void gemm_phase(LAS unsigned char* lds, const Gemm g, const Sched& S, const Epi& E, int wave0) {
    const int tid = fresh_tid(wave0), wid = __builtin_amdgcn_readfirstlane(tid >> 6), lane = tid & 63, wr = wid >> 2, wc = wid & 3, fr = lane & 15, fq = lane >> 4;
    const int nt = g.K / BK;
    unsigned voffA[2], voffB[2];
#pragma unroll
    for (int i = 0; i < 2; ++i) { int R, C; stage_rc(tid * 16 + i * 8192, R, C); const int Rb = Epi::PERM ? ((R & ~31) + perm32(R & 31)) : R;
        voffA[i] = (unsigned)(R * g.lda + C) * 2u; voffB[i] = (unsigned)(Rb * g.ldb + C) * 2u; }
    const size_t kstep = (size_t)(BK * 2);
    const size_t hstepA = (size_t)HALF * g.lda * 2, hstepB = (size_t)HALF * g.ldb * 2;
    const unsigned ldsw = (unsigned)wid * 1024u;
    const int aoff = lds_byte(wr * 64 + fr, fq * 8), boff = lds_byte(wc * 32 + fr, fq * 8);
#define PG8_APTR(u) ((const char*)(g.A + (size_t)(u).pb * g.batchA + (size_t)(u).pm * BM * g.lda))
#define PG8_BPTR(u) ((const char*)(g.Bt + (size_t)(u).pb * g.batchB + (size_t)(u).pn * BM * g.ldb))
#define PG8_SA(b, h) (((b) * 2 + (h)) * HTB)
#define PG8_SB(b, h) ((4 + (b) * 2 + (h)) * HTB)
#define PG8_STAGE(bufoff, gbase, voff) do { const char* gb_ = (const char*)(gbase); asm volatile("" : "+s"(gb_)); _Pragma("unroll") for (int _i = 0; _i < 2; ++_i) \
        __builtin_amdgcn_global_load_lds((const unsigned*)(gb_ + (voff)[_i]), (LAS unsigned*)(lds + (bufoff) + ldsw + _i * 8192), 16, 0, 0); } while (0)
#define PG8_LDA(dst, b, h) do { _Pragma("unroll") for (int m = 0; m < 4; ++m) _Pragma("unroll") for (int k = 0; k < 2; ++k) dst[m][k] = *(const LAS bf16x8*)(lds + PG8_SA(b, h) + aoff + m * 2048 + k * 1024); } while (0)
#define PG8_LDB(dst, b, h) do { _Pragma("unroll") for (int n = 0; n < 2; ++n) _Pragma("unroll") for (int k = 0; k < 2; ++k) dst[n][k] = *(const LAS bf16x8*)(lds + PG8_SB(b, h) + boff + n * 2048 + k * 1024); } while (0)
#define PG8_MMA(ai, bj, At, Bt) do { __builtin_amdgcn_s_setprio(1); _Pragma("unroll") for (int m = 0; m < 4; ++m) _Pragma("unroll") for (int n = 0; n < 2; ++n) _Pragma("unroll") for (int k = 0; k < 2; ++k) \
        acc[ai][bj][m][n] = __builtin_amdgcn_mfma_f32_16x16x32_bf16(Bt[n][k], At[m][k], acc[ai][bj][m][n], 0, 0, 0); __builtin_amdgcn_s_setprio(0); } while (0)
#define PG8_WAIT_V(n) asm volatile("s_waitcnt vmcnt(" #n ")" ::: "memory")
#define PG8_WAIT_L(n) asm volatile("s_waitcnt lgkmcnt(" #n ")" ::: "memory")
#define PG8_BAR __builtin_amdgcn_s_barrier()
#define PG8_SCHED __builtin_amdgcn_sched_barrier(0)
    Unit cur, nxt; int ui = 0;
    if (!S.next(0, cur)) return;
    f32x4 acc[2][2][4][2];
#pragma unroll
    for (int a = 0; a < 2; ++a)
#pragma unroll
        for (int b = 0; b < 2; ++b)
#pragma unroll
            for (int m = 0; m < 4; ++m)
#pragma unroll
                for (int n = 0; n < 2; ++n) acc[a][b][m][n] = (f32x4){0.f, 0.f, 0.f, 0.f};
    bf16x8 At[4][2], B0[2][2], B1[2][2];
    const char* cA = PG8_APTR(cur); const char* cB = PG8_BPTR(cur);
    PG8_STAGE(PG8_SB(0, 0), cB, voffB); PG8_STAGE(PG8_SB(0, 1), cB + hstepB, voffB); PG8_STAGE(PG8_SA(0, 0), cA, voffA); PG8_STAGE(PG8_SA(0, 1), cA + hstepA, voffA);
    if (wr == 1) PG8_BAR;
    PG8_WAIT_V(2); PG8_BAR;
    PG8_STAGE(PG8_SB(1, 0), cB + kstep, voffB); PG8_STAGE(PG8_SA(1, 0), cA + kstep, voffA); PG8_STAGE(PG8_SB(1, 1), cB + hstepB + kstep, voffB);
    PG8_WAIT_V(6); PG8_BAR;
    for (;;) {
        const bool has_next = S.next(ui + 1, nxt);
        const char* nA = has_next ? PG8_APTR(nxt) : cA; const char* nB = has_next ? PG8_BPTR(nxt) : cB;
        for (int t = 0; t < nt; t += 2) {
            const bool last = (t == nt - 2);
            const char* a1 = cA + (size_t)(t + 1) * kstep;
            const char* a2 = last ? nA : cA + (size_t)(t + 2) * kstep; const char* b2 = last ? nB : cB + (size_t)(t + 2) * kstep;
            const char* a3 = a2 + kstep; const char* b3 = b2 + kstep;
            PG8_LDB(B0, 0, 0); PG8_LDB(B1, 0, 1); PG8_SCHED; PG8_LDA(At, 0, 0); PG8_STAGE(PG8_SA(1, 1), a1 + hstepA, voffA);
            PG8_WAIT_V(8); PG8_WAIT_L(0); PG8_BAR; PG8_MMA(0, 0, At, B0); PG8_MMA(0, 1, At, B1); PG8_BAR; PG8_SCHED;
            PG8_LDA(At, 0, 1); PG8_STAGE(PG8_SB(0, 0), b2, voffB); PG8_STAGE(PG8_SB(0, 1), b2 + hstepB, voffB); PG8_STAGE(PG8_SA(0, 0), a2, voffA);
            PG8_WAIT_V(8); PG8_WAIT_L(0); PG8_BAR; PG8_MMA(1, 0, At, B0); PG8_MMA(1, 1, At, B1); PG8_BAR; PG8_SCHED;
            PG8_LDB(B0, 1, 0); PG8_LDB(B1, 1, 1); PG8_SCHED; PG8_LDA(At, 1, 0); PG8_STAGE(PG8_SA(0, 1), a2 + hstepA, voffA);
            PG8_WAIT_V(8); PG8_WAIT_L(0); PG8_BAR; PG8_MMA(0, 0, At, B0); PG8_MMA(0, 1, At, B1); PG8_BAR; PG8_SCHED;
            PG8_LDA(At, 1, 1); PG8_STAGE(PG8_SB(1, 0), b3, voffB); PG8_STAGE(PG8_SB(1, 1), b3 + hstepB, voffB); PG8_STAGE(PG8_SA(1, 0), a3, voffA);
            PG8_WAIT_V(8); PG8_WAIT_L(0); PG8_BAR; PG8_MMA(1, 0, At, B0); PG8_MMA(1, 1, At, B1); PG8_BAR; PG8_SCHED;
        }
        if (wr == 0) PG8_BAR;
        { int l2_; asm volatile("v_mbcnt_lo_u32_b32 %0, -1, 0\n\tv_mbcnt_hi_u32_b32 %0, -1, %0" : "=v"(l2_)); E(acc, cur, wr, wc, l2_ & 15, l2_ >> 4); }
        if (!has_next) break;
#pragma unroll
        for (int a = 0; a < 2; ++a)
#pragma unroll
            for (int b = 0; b < 2; ++b)
#pragma unroll
                for (int m = 0; m < 4; ++m)
#pragma unroll
                    for (int n = 0; n < 2; ++n) acc[a][b][m][n] = (f32x4){0.f, 0.f, 0.f, 0.f};
        cur = nxt; cA = nA; cB = nB; ++ui;
        if (wr == 1) PG8_BAR;
    }
    PG8_WAIT_V(0);
    PG8_BAR;
#undef PG8_APTR
#undef PG8_BPTR
#undef PG8_SA
#undef PG8_SB
#undef PG8_STAGE
#undef PG8_LDA
#undef PG8_LDB
#undef PG8_MMA
#undef PG8_WAIT_V
#undef PG8_WAIT_L
#undef PG8_BAR
#undef PG8_SCHED
}

typedef f32x4 Acc[2][2][4][2];

template <int ACT  > struct EpiStore {
    static constexpr bool PERM = true;
    bf16_t* O; size_t ldc, bstride;
    __device__ __forceinline__ void operator()(const Acc& acc, const Unit& u, int wr, int wc, int fr, int fq) const {
        LAUNDER_V(fr); LAUNDER_V(fq);
        const int row0 = u.pm * BM + wr * 64 + fr, col0 = u.pn * BM + wc * 32 + 8 * fq;
        bf16_t* base = O + (size_t)u.pb * bstride;
#pragma unroll
        for (int ai = 0; ai < 2; ++ai)
#pragma unroll
            for (int m = 0; m < 4; ++m) { bf16_t* rowp = base + (size_t)(row0 + ai * HALF + m * 16) * ldc + col0;
#pragma unroll
                for (int bj = 0; bj < 2; ++bj) { f32x4 v0 = acc[ai][bj][m][0], v1 = acc[ai][bj][m][1];
                    if (ACT == 1) {
#pragma unroll
                        for (int e = 0; e < 4; ++e) { float a = fmaxf(v0[e], 0.f), b = fmaxf(v1[e], 0.f); v0[e] = a * a; v1[e] = b * b; } }
                    u32x4 w; w.x = pk2(v0[0], v0[1]); w.y = pk2(v0[2], v0[3]); w.z = pk2(v1[0], v1[1]); w.w = pk2(v1[2], v1[3]);
                    *(u32x4*)(rowp + bj * HALF) = w; } }
    }
};

struct EpiResid {
    static constexpr bool PERM = false;
    const float* base_lat; const float* base_ctx; float* out_lat; float* out_ctx; const float* gate; const float* bias;
    __device__ __forceinline__ void operator()(const Acc& acc, const Unit& u, int wr, int wc, int fr, int fq) const {
        LAUNDER_V(fr); LAUNDER_V(fq);
        const float* bp; float* op; int rbase, mi;
        if (u.pm < 128) { bp = base_lat; op = out_lat; rbase = u.pm * BM; mi = u.pm >> 4; } else { bp = base_ctx; op = out_ctx; rbase = (u.pm - 128) * BM; mi = 8; }
        const int col0 = u.pn * BM + wc * 32 + 4 * fq;
        f32x4 gv[2][2], bv[2][2];
#pragma unroll
        for (int bj = 0; bj < 2; ++bj)
#pragma unroll
            for (int n = 0; n < 2; ++n) { gv[bj][n] = *(const f32x4*)(gate + mi * (NMOD * D) + col0 + bj * HALF + n * 16);
                bv[bj][n] = bias ? *(const f32x4*)(bias + col0 + bj * HALF + n * 16) : (f32x4){0.f, 0.f, 0.f, 0.f}; }
#pragma unroll
        for (int ai = 0; ai < 2; ++ai)
#pragma unroll
            for (int m = 0; m < 4; ++m) { const size_t off = (size_t)(rbase + ai * HALF + wr * 64 + m * 16 + fr) * D + col0;
#pragma unroll
                for (int bj = 0; bj < 2; ++bj)
#pragma unroll
                    for (int n = 0; n < 2; ++n) { const f32x4 xv = *(const f32x4*)(bp + off + bj * HALF + n * 16);
                        *(f32x4*)(op + off + bj * HALF + n * 16) = xv + gv[bj][n] * (acc[ai][bj][m][n] + bv[bj][n]); } }
    }
};

struct EpiQK {
    static constexpr bool PERM = false;
    bf16_t* QKo; const float* qn; const float* kn;
    __device__ __forceinline__ void operator()(const Acc& acc, const Unit& u, int wr, int wc, int fr, int fq) const {
        LAUNDER_V(fr); LAUNDER_V(fq);
        const int lane = fq * 16 + fr, hc = u.pn * 4 + wc; const bool isq = hc < 16;
        const float* nwp = (isq ? qn : kn) + 4 * fq;
        f32x4 nw[2][2];
#pragma unroll
        for (int bj = 0; bj < 2; ++bj)
#pragma unroll
            for (int n = 0; n < 2; ++n) nw[bj][n] = *(const f32x4*)(nwp + 32 * bj + 16 * n);
        float invf[4];
#pragma unroll
        for (int i = 0; i < 4; ++i) invf[i] = __builtin_amdgcn_exp2f(-(float)(4 * fq + i) * 0.8304820237218406f) * 0.15915494309189535f;
        const float qs = isq ? QSCALE : 1.f;
#pragma unroll
        for (int ai = 0; ai < 2; ++ai)
#pragma unroll
            for (int m = 0; m < 4; ++m) { const int row = u.pm * BM + ai * HALF + wr * 64 + m * 16 + fr;
                float ss = 0.f;
#pragma unroll
                for (int bj = 0; bj < 2; ++bj)
#pragma unroll
                    for (int n = 0; n < 2; ++n) { const f32x4 a = acc[ai][bj][m][n]; ss += (a[0] * a[0] + a[1] * a[1]) + (a[2] * a[2] + a[3] * a[3]); }
                ss += shx(ss, lane, 16); ss += shx(ss, lane, 32);
                const float rstd = rsqrtf(ss * (1.f / 64.f) + EPS) ;
                const int l = row & 4095; const float posr = (float)(l >> 6), posc = (float)(l & 63);
                bf16_t* op = QKo + (size_t)row * 2048 + hc * 64 + 4 * fq;
#pragma unroll
                for (int bj = 0; bj < 2; ++bj) { f32x4 x1 = acc[ai][bj][m][0] * rstd * nw[bj][0], x2 = acc[ai][bj][m][1] * rstd * nw[bj][1];
                    if (row < TL) { const float pos = bj ? posc : posr;
#pragma unroll
                        for (int i = 0; i < 4; ++i) { const float rev = pos * invf[i]; const float cs = __builtin_amdgcn_cosf(rev), sn = __builtin_amdgcn_sinf(rev);
                            const float a = x1[i], b = x2[i]; x1[i] = a * cs - b * sn; x2[i] = a * sn + b * cs; } }
                    x1 *= qs; x2 *= qs;
                    *(u32x2*)(op + 32 * bj) = (u32x2){pk2(x1[0], x1[1]), pk2(x1[2], x1[3])};
                    *(u32x2*)(op + 32 * bj + 16) = (u32x2){pk2(x2[0], x2[1]), pk2(x2[2], x2[3])}; } }
    }
};

struct EpiPart {
    static constexpr bool PERM = false;
    float* P;
    __device__ __forceinline__ void operator()(const Acc& acc, const Unit& u, int wr, int wc, int fr, int fq) const {
        LAUNDER_V(fr); LAUNDER_V(fq);
        const int col0 = u.pn * BM + wc * 32 + 4 * fq;
#pragma unroll
        for (int ai = 0; ai < 2; ++ai)
#pragma unroll
            for (int m = 0; m < 4; ++m) { float* rp = P + ((size_t)u.pb * TC + (u.pm - 128) * BM + ai * HALF + wr * 64 + m * 16 + fr) * D + col0;
#pragma unroll
                for (int bj = 0; bj < 2; ++bj)
#pragma unroll
                    for (int n = 0; n < 2; ++n) *(f32x4*)(rp + bj * HALF + n * 16) = acc[ai][bj][m][n]; }
    }
};

struct EpiGlu {
    static constexpr bool PERM = false;
    const float* base_lat; const float* base_ctx; float* out_lat; float* out_ctx; const float* gate;
    __device__ __forceinline__ void operator()(const Acc& acc, const Unit& u, int wr, int wc, int fr, int fq) const {
        LAUNDER_V(fr); LAUNDER_V(fq);
        const float* bp; float* op; int rbase, mi;
        if (u.pm < 128) { bp = base_lat; op = out_lat; rbase = u.pm * BM; mi = u.pm >> 4; } else { bp = base_ctx; op = out_ctx; rbase = (u.pm - 128) * BM; mi = 8; }
        const int col0 = u.pn * HALF + wc * 32 + 4 * fq;
        f32x4 gv[2];
#pragma unroll
        for (int n = 0; n < 2; ++n) gv[n] = *(const f32x4*)(gate + mi * (NMOD * D) + col0 + n * 16);
#pragma unroll
        for (int ai = 0; ai < 2; ++ai)
#pragma unroll
            for (int m = 0; m < 4; ++m) { const size_t off = (size_t)(rbase + ai * HALF + wr * 64 + m * 16 + fr) * D + col0;
#pragma unroll
                for (int n = 0; n < 2; ++n) { const f32x4 xv = *(const f32x4*)(bp + off + n * 16); const f32x4 v = acc[ai][0][m][n], gt = acc[ai][1][m][n]; f32x4 o;
#pragma unroll
                    for (int e = 0; e < 4; ++e) o[e] = xv[e] + gv[n][e] * v[e] * sigmoidf_(gt[e]);
                    *(f32x4*)(op + off + n * 16) = o; } }
    }
};

struct EpiSloc {
    static constexpr bool PERM = false;
    float* S;
    __device__ __forceinline__ void operator()(const Acc& acc, const Unit& u, int wr, int wc, int fr, int fq) const {
        LAUNDER_V(fr); LAUNDER_V(fq);
        const int col0 = wc * 32 + 4 * fq;
#pragma unroll
        for (int ai = 0; ai < 2; ++ai)
#pragma unroll
            for (int m = 0; m < 4; ++m) { const int ci = u.pm * BM + ai * HALF + wr * 64 + m * 16 + fr;
                if (ci < NCH) { float* rp = S + ((size_t)u.pb * NCH + ci) * 256 + col0;
#pragma unroll
                    for (int bj = 0; bj < 2; ++bj)
#pragma unroll
                        for (int n = 0; n < 2; ++n) *(f32x4*)(rp + bj * HALF + n * 16) = acc[ai][bj][m][n]; } }
    }
};

struct EpiZ {
    static constexpr bool PERM = false;
    bf16_t* Z;
    __device__ __forceinline__ void operator()(const Acc& acc, const Unit& u, int wr, int wc, int fr, int fq) const {
        LAUNDER_V(fr); LAUNDER_V(fq);
#pragma unroll
        for (int ai = 0; ai < 2; ++ai)
#pragma unroll
            for (int m = 0; m < 4; ++m) { const int ci = u.pm * BM + ai * HALF + wr * 64 + m * 16 + fr;
                if (ci < NCH) { const int b = ci / 136, cc = ci - b * 136; const int tok0 = cc < 8 ? TL + b * 256 + cc * 32 : b * 4096 + (cc - 8) * 32;
#pragma unroll
                    for (int bj = 0; bj < 2; ++bj)
#pragma unroll
                        for (int n = 0; n < 2; ++n) { const int t = 16 * u.pn + 8 * bj + 2 * wc + n; const f32x4 v = acc[ai][bj][m][n];
                            u32x2 w; w.x = pk2(gelu_tanh(v[0]), gelu_tanh(v[1])); w.y = pk2(gelu_tanh(v[2]), gelu_tanh(v[3]));
                            *(u32x2*)(Z + (size_t)(tok0 + t) * D + u.pb * 16 + 4 * fq) = w; } } }
    }
};

struct EpiChanDft {
    static constexpr bool PERM = true;
    bf16_t* PQ1; bf16_t* PQC;
    __device__ __forceinline__ void operator()(const Acc& acc, const Unit& u, int wr, int wc, int fr, int fq) const {
        LAUNDER_V(fr); LAUNDER_V(fq);
        if (u.pn < 128) {
            const int b = u.pn >> 4;
#pragma unroll
            for (int ai = 0; ai < 2; ++ai)
#pragma unroll
                for (int m = 0; m < 4; ++m) { const int kc = ai * HALF + wr * 64 + m * 16 + fr;
                    bf16_t* rowp = PQ1 + (size_t)(b * 1024 + u.pb * 256 + kc) * 8192 + u.pm * 64;
#pragma unroll
                    for (int bj = 0; bj < 2; ++bj) { const int tp = (u.pn & 15) * 256 + bj * HALF + wc * 32 + 8 * fq;
                        const f32x4 v0 = acc[ai][bj][m][0], v1 = acc[ai][bj][m][1];
                        u32x4 w; w.x = pk2(v0[0], v0[1]); w.y = pk2(v0[2], v0[3]); w.z = pk2(v1[0], v1[1]); w.w = pk2(v1[2], v1[3]);
                        *(u32x4*)(rowp + (tp >> 6) * 128 + (tp & 63)) = w; } }
        } else {
            const int b = u.pn - 128;
            bf16_t* base = PQC + (size_t)(b * 1024 + u.pb * 256) * 512 + (size_t)u.pm * 256 + wc * 32 + 8 * fq;
#pragma unroll
            for (int ai = 0; ai < 2; ++ai)
#pragma unroll
                for (int m = 0; m < 4; ++m) { bf16_t* rowp = base + (size_t)(ai * HALF + wr * 64 + m * 16 + fr) * 512;
#pragma unroll
                    for (int bj = 0; bj < 2; ++bj) { const f32x4 v0 = acc[ai][bj][m][0], v1 = acc[ai][bj][m][1];
                        u32x4 w; w.x = pk2(v0[0], v0[1]); w.y = pk2(v0[2], v0[3]); w.z = pk2(v1[0], v1[1]); w.w = pk2(v1[2], v1[3]);
                        *(u32x4*)(rowp + bj * HALF) = w; } }
        }
    }
};

struct EpiFft1 {
    static constexpr bool PERM = true;
    bf16_t* B2;
    __device__ __forceinline__ void operator()(const Acc& acc, const Unit& u, int wr, int wc, int fr, int fq) const {
        LAUNDER_V(fr); LAUNDER_V(fq);
        if (wr != 0) return;
#pragma unroll
        for (int m = 0; m < 4; ++m) { const int m2 = 16 * m + fr;
#pragma unroll
            for (int bj = 0; bj < 2; ++bj) { const int n0 = u.pn * BM + bj * HALF + wc * 32 + 8 * fq; const int k2 = n0 & 63, c = (n0 >> 6) & 1023, b = n0 >> 16;
                float br[8], bi[8];
#pragma unroll
                for (int e = 0; e < 8; ++e) { const float ar = acc[0][bj][m][e >> 2][e & 3], ai_ = acc[1][bj][m][e >> 2][e & 3];
                    const float rev = (float)(m2 * (k2 + e)) * (1.f / 4096.f); const float cs = __builtin_amdgcn_cosf(rev), sn = __builtin_amdgcn_sinf(rev);
                    br[e] = (ar * cs + ai_ * sn) * (1.f / 64.f); bi[e] = (ai_ * cs - ar * sn) * (1.f / 64.f); }
                bf16_t* op = B2 + ((size_t)(b * 64 + m2) * 1024 + c) * 128 + k2;
                *(u32x4*)(op) = (u32x4){pk2(br[0], br[1]), pk2(br[2], br[3]), pk2(br[4], br[5]), pk2(br[6], br[7])};
                *(u32x4*)(op + 64) = (u32x4){pk2(bi[0], bi[1]), pk2(bi[2], bi[3]), pk2(bi[4], bi[5]), pk2(bi[6], bi[7])}; } }
    }
};

struct EpiFft2 {
    static constexpr bool PERM = true;
    bf16_t* F;
    __device__ __forceinline__ void operator()(const Acc& acc, const Unit& u, int wr, int wc, int fr, int fq) const {
        LAUNDER_V(fr); LAUNDER_V(fq);
        if (wr != 0) return;
#pragma unroll
        for (int m = 0; m < 4; ++m) { const int m1 = 16 * m + fr;
#pragma unroll
            for (int bj = 0; bj < 2; ++bj) { const int n0 = u.pn * BM + bj * HALF + wc * 32 + 8 * fq; const int c = n0 & 1023, m2 = (n0 >> 10) & 63, b = n0 >> 16;
                const f32x4 v0 = acc[0][bj][m][0], v1 = acc[0][bj][m][1];
                *(u32x4*)(F + (size_t)(b * 4096 + 64 * m1 + m2) * D + c) = (u32x4){pk2(v0[0], v0[1]), pk2(v0[2], v0[3]), pk2(v1[0], v1[1]), pk2(v1[2], v1[3])}; } }
    }
};
}

__device__ __forceinline__ void transpose_item(const float* W, int K, int N, bf16_t* WT, int glu, LAS float* scr, int item, int lane) {
    const int nblk = N / 32, kb = item / nblk, nb = item % nblk, k0 = 64 * kb, n0 = 32 * nb;
#pragma unroll 8
    for (int i = 0; i < 32; ++i) { const int kk = 2 * i + (lane >> 5); scr[kk * 33 + (lane & 31)] = W[(size_t)(k0 + kk) * N + n0 + (lane & 31)]; }
    asm volatile("s_waitcnt lgkmcnt(0)" ::: "memory");
    const int n0p = glu == 1 ? (((n0 & 1023) >> 7) * 256 + (n0 >> 10) * 128 + (n0 & 127))
                  : (glu == 2 && n0 < 2048) ? ((n0 & ~255) | (((n0 >> 5) & 1) << 7) | (((n0 >> 6) & 3) << 5)) : n0;
    const int c = lane & 7;
#pragma unroll
    for (int j = 0; j < 4; ++j) { const int n = (lane >> 3) + 8 * j; const LAS float* s = scr + (8 * c) * 33 + n;
        u32x4 o; o.x = pk2(s[0 * 33], s[1 * 33]); o.y = pk2(s[2 * 33], s[3 * 33]); o.z = pk2(s[4 * 33], s[5 * 33]); o.w = pk2(s[6 * 33], s[7 * 33]);
        *(u32x4*)(WT + (size_t)(n0p + n) * K + k0 + 8 * c) = o; }
    asm volatile("s_waitcnt lgkmcnt(0)" ::: "memory");
}

__device__ __forceinline__ const float* xrow_ptr(const float* xl, const float* xc, int row) { return row < TL ? xl + (size_t)row * D : xc + (size_t)(row - TL) * D; }

struct CtxFix { const float* part; const float* pgate; const float* pbias; float* xw; };
__device__ __forceinline__ void norm_rows_tok(const float* xl, const float* xc, const float* g, const float* modl  , int sidx, bf16_t* out, int nrows, int gw, int ngw, int lane, bool perm64, const CtxFix fx) {
    const int nlat = nrows < TL ? nrows : TL, per = (nlat + ngw - 1) / ngw, nctx = nrows > TL ? (nrows - TL + ngw - 1) / ngw : 0;
    const float* fpart = fx.part; int hasfix = __builtin_amdgcn_readfirstlane(fx.part != nullptr ? 1 : 0); asm volatile("" : "+s"(hasfix)); int pf64 = __builtin_amdgcn_readfirstlane(perm64 ? 1 : 0); asm volatile("" : "+s"(pf64));
    f32x4 gsv[4], shv[4]; int cur = -1;
    for (int it = 0; it < per + nctx; ++it) {
        const int row = it < per ? gw * per + it : TL + gw + (it - per) * ngw;
        if (it < per ? row >= nlat : row >= nrows) continue;
        const f32x4* xr = (const f32x4*)xrow_ptr(xl, xc, row) + lane;
        f32x4 v[4]; float ss = 0.f;
#pragma unroll
        for (int j = 0; j < 4; ++j) v[j] = xr[64 * j];
        const int mi = row < TL ? row >> 12 : 8;
        if (mi != cur) { cur = mi; const float* sh = modl + mi * (NMOD * D) + sidx * D; const float* sc = sh + D;
#pragma unroll
            for (int j = 0; j < 4; ++j) { const int c = 4 * lane + 256 * j; const f32x4 gg = *(const f32x4*)(g + c), s1 = *(const f32x4*)(sc + c); shv[j] = *(const f32x4*)(sh + c); gsv[j] = gg * (1.f + s1); } }
        if (hasfix && row >= TL) {
#pragma unroll
            for (int j = 0; j < 4; ++j) { const int c = 4 * lane + 256 * j; f32x4 s = fx.pbias ? *(const f32x4*)(fx.pbias + c) : (f32x4){0.f, 0.f, 0.f, 0.f};
#pragma unroll
                for (int k = 0; k < KSPLIT; ++k) s += *(const f32x4*)(fpart + ((size_t)k * TC + (row - TL)) * D + c);
                v[j] += *(const f32x4*)(fx.pgate + c) * s;
                *(f32x4*)(fx.xw + (size_t)(row - TL) * D + c) = v[j]; } }
#pragma unroll
        for (int j = 0; j < 4; ++j) ss += (v[j].x * v[j].x + v[j].y * v[j].y) + (v[j].z * v[j].z + v[j].w * v[j].w);
        const float rstd = rsqrtf(wave_sum(ss, lane) * (1.f / D) + EPS);
        const int orow = (pf64 && row < TL) ? ((row & ~4095) | ((row & 63) << 6) | ((row & 4095) >> 6)) : row;
        unsigned long long* o8 = (unsigned long long*)(out + (size_t)orow * D) + lane;
#pragma unroll
        for (int j = 0; j < 4; ++j) { const f32x4 y = v[j] * rstd * gsv[j] + shv[j];
            o8[64 * j] = (unsigned long long)pk2(y[0], y[1]) | ((unsigned long long)pk2(y[2], y[3]) << 32); }
    }
}
__device__ __forceinline__ void norm_rows_s5(const float* xl, const float* xc, const float* g, const float* modl, bf16_t* ug, int gw, int ngw, int lane, const CtxFix fx) {
    const int per = (TL + ngw - 1) / ngw, nctx = (TC + ngw - 1) / ngw;
    const float* fpart = fx.part; int hasfix = __builtin_amdgcn_readfirstlane(fx.part != nullptr ? 1 : 0); asm volatile("" : "+s"(hasfix));
    f32x4 gsv[4], shv[4]; int cur = -1;
    for (int it = 0; it < per + nctx; ++it) {
        const int row = it < per ? gw * per + it : TL + gw + (it - per) * ngw;
        if (it < per ? row >= TL : row >= TA) continue;
        const f32x4* xr = (const f32x4*)xrow_ptr(xl, xc, row) + 4 * lane;
        f32x4 v[4]; float ss = 0.f;
#pragma unroll
        for (int j = 0; j < 4; ++j) v[j] = xr[j];
        int mi, b, pos; if (row < TL) { b = row >> 12; pos = 256 + (row & 4095); mi = b; } else { b = (row - TL) >> 8; pos = (row - TL) & 255; mi = 8; }
        if (mi != cur) { cur = mi; const float* sh = modl + mi * (NMOD * D); const float* sc = sh + D;
#pragma unroll
            for (int j = 0; j < 4; ++j) { const int c = 16 * lane + 4 * j; const f32x4 gg = *(const f32x4*)(g + c), s1 = *(const f32x4*)(sc + c); shv[j] = *(const f32x4*)(sh + c); gsv[j] = gg * (1.f + s1); } }
        if (hasfix && row >= TL) {
#pragma unroll
            for (int j = 0; j < 4; ++j) { const int c = 16 * lane + 4 * j; f32x4 s = fx.pbias ? *(const f32x4*)(fx.pbias + c) : (f32x4){0.f, 0.f, 0.f, 0.f};
#pragma unroll
                for (int k = 0; k < KSPLIT; ++k) s += *(const f32x4*)(fpart + ((size_t)k * TC + (row - TL)) * D + c);
                v[j] += *(const f32x4*)(fx.pgate + c) * s;
                *(f32x4*)(fx.xw + (size_t)(row - TL) * D + c) = v[j]; } }
#pragma unroll
        for (int j = 0; j < 4; ++j) ss += (v[j].x * v[j].x + v[j].y * v[j].y) + (v[j].z * v[j].z + v[j].w * v[j].w);
        const float rstd = rsqrtf(wave_sum(ss, lane) * (1.f / D) + EPS);
        const int chunk = b * 136 + (pos >> 5), s = pos & 31;
        unsigned w[8];
#pragma unroll
        for (int j = 0; j < 4; ++j) { const f32x4 y = v[j] * rstd * gsv[j] + shv[j]; w[2 * j] = pk2(y[0], y[1]); w[2 * j + 1] = pk2(y[2], y[3]); }
        u32x4* op = (u32x4*)(ug + ((size_t)lane * NCH + chunk) * UGP + s * 16);
        op[0] = (u32x4){w[0], w[1], w[2], w[3]}; op[1] = (u32x4){w[4], w[5], w[6], w[7]};
    }
}

__device__ __forceinline__ void cpow(float lr_dt, float li_dt, float k, float& re, float& im) {
    const float mag = __expf(k * lr_dt); const float rev = k * li_dt * 0.15915494309189535f;
    re = mag * __builtin_amdgcn_cosf(rev); im = mag * __builtin_amdgcn_sinf(rev);
}
__device__ __forceinline__ void s5_kcoef(float lr, float li, float dt, float& kr, float& ki) {
    const float th = li * dt; const float rv = th * 0.15915494309189535f;
    const float c = __builtin_amdgcn_cosf(rv), s = __builtin_amdgcn_sinf(rv), sh = __builtin_amdgcn_sinf(0.5f * rv);
    const float em1 = expm1f(lr * dt);
    const float nre = em1 * c - 2.f * sh * sh, nim = (em1 + 1.f) * s;
    const float den = lr * lr + li * li;
    kr = (nre * lr + nim * li) / den; ki = (nim * lr - nre * li) / den;
}


#define XB_TMO      128
#define XB_XCNT(j)  (256  + 64 * (j))
#define XB_XSUB(j)  (1280 + 64 * (j))
#define XB_XGEN(j)  (2304 + 64 * (j))
#define XB_TOP      3328
#define XB_TOPGEN   3392
#define XCD_BAR_WORDS 3456
#define XB_SPIN_CAP (1u << 18)
__device__ __forceinline__ unsigned xb_ld(unsigned* p)              { return __hip_atomic_load(p, __ATOMIC_RELAXED, __HIP_MEMORY_SCOPE_AGENT); }
__device__ __forceinline__ unsigned xb_add(unsigned* p, unsigned v) { return __hip_atomic_fetch_add(p, v, __ATOMIC_RELAXED, __HIP_MEMORY_SCOPE_AGENT); }
__device__ __forceinline__ unsigned xb_xcc_id() { return (unsigned)__builtin_amdgcn_s_getreg((3 << 11) | 20) & 0xFu; }
#define XB_SPIN(cond, bar) do { unsigned _sp = 0; while (cond) { __builtin_amdgcn_s_sleep(1); \
    if ((++_sp & 255u) == 0u) { if (xb_ld(&(bar)[XB_TMO])) break; if (_sp > XB_SPIN_CAP) { atomicAdd(&(bar)[XB_TMO], 1u); break; } } } } while (0)
struct XcdBarrier { unsigned* bar; unsigned x; volatile LAS unsigned* st; };
__device__ __forceinline__ XcdBarrier xcd_barrier_post(unsigned* bar, volatile LAS unsigned* st) {
    XcdBarrier b; b.bar = bar; b.x = xb_xcc_id(); b.st = st;
    if (threadIdx.x == 0) (void)xb_add(&bar[XB_XCNT(b.x)], 1u);
    return b;
}
__device__ __forceinline__ void xcd_barrier_complete(unsigned* bar, unsigned x, unsigned& nloc, unsigned& nx) {
    const unsigned G = gridDim.x * gridDim.y * gridDim.z;
    unsigned sum, cnt, mine, sp = 0u;
    for (;;) {
        sum = 0u; cnt = 0u; mine = 0u;
#pragma unroll
        for (unsigned j = 0; j < 16; ++j) { const unsigned c = xb_ld(&bar[XB_XCNT(j)]); sum += c; cnt += (c > 0u) ? 1u : 0u; mine = (j == x) ? c : mine; }
        if (sum == G) break;
        __builtin_amdgcn_s_sleep(1);
        if ((++sp & 255u) == 0u) { if (xb_ld(&bar[XB_TMO])) break; if (sp > XB_SPIN_CAP) { atomicAdd(&bar[XB_TMO], 1u); break; } }
    }
    nloc = mine > 0u ? mine : 1u; nx = cnt > 0u ? cnt : 1u;
}
__device__ __forceinline__ void xcd_barrier(const XcdBarrier& b) {
    asm volatile("s_waitcnt vmcnt(0)" ::: "memory");
    __syncthreads();
    if (threadIdx.x == 0) {
        unsigned* bar = b.bar;
        __builtin_amdgcn_s_waitcnt(0);
        unsigned nloc = b.st[0], nx = b.st[1];
        if (nloc == 0u) { xcd_barrier_complete(bar, b.x, nloc, nx); b.st[0] = nloc; b.st[1] = nx; }
        const unsigned old = xb_add(&bar[XB_XSUB(b.x)], 1u);
        const unsigned gen = old / nloc;
        if (old + 1u == (gen + 1u) * nloc) {
            __builtin_amdgcn_fence(__ATOMIC_RELEASE, "agent");
            asm volatile("s_waitcnt vmcnt(0)" ::: "memory");
            const unsigned og = xb_add(&bar[XB_TOP], 1u);
            const unsigned tg = og / nx;
            if (og + 1u == (tg + 1u) * nx) xb_add(&bar[XB_TOPGEN], 1u);
            else XB_SPIN(xb_ld(&bar[XB_TOPGEN]) == tg, bar);
            __builtin_amdgcn_fence(__ATOMIC_ACQUIRE, "agent");
            xb_add(&bar[XB_XGEN(b.x)], 1u);
            asm volatile("s_waitcnt vmcnt(0)" ::: "memory");
        } else {
            XB_SPIN(xb_ld(&bar[XB_XGEN(b.x)]) == gen, bar);
            __builtin_amdgcn_fence(__ATOMIC_ACQUIRE, "agent");
            asm volatile("s_waitcnt vmcnt(0)" ::: "memory");
        }
    }
    __syncthreads();
}

__global__ void __launch_bounds__(512) mega_fwd(Params p) {
    extern __shared__ __attribute__((aligned(16))) unsigned char lds_raw[];
    LAS unsigned char* lds = (LAS unsigned char*)lds_raw;
    cg::grid_group grid = cg::this_grid();
    const int G = gridDim.x, bid = blockIdx.x, NGW = G * 8;
    const int wave0 = __builtin_amdgcn_readfirstlane(threadIdx.x >> 6);
#define FRESH_IDS const int tid = fresh_tid(wave0), lane = tid & 63, wave = __builtin_amdgcn_readfirstlane(tid >> 6), gw = bid * 8 + wave; (void)lane; (void)gw
    unsigned char* ws = p.ws;
    bf16_t* W1T = (bf16_t*)(ws + WS_W1T); bf16_t* W2T = (bf16_t*)(ws + WS_W2T); bf16_t* GLUT = (bf16_t*)(ws + WS_GLUT);
    bf16_t* QKVT = (bf16_t*)(ws + WS_QKVT); bf16_t* WOT = (bf16_t*)(ws + WS_WOT); bf16_t* FWT = (bf16_t*)(ws + WS_FWT);
    float* MOD = (float*)(ws + WS_MOD); float* KTAB = (float*)(ws + WS_KTAB); float* XCTX = (float*)(ws + WS_XCTX);
    bf16_t* HN = (bf16_t*)(ws + WS_HN); bf16_t* HB = (bf16_t*)(ws + WS_H);
    int ph = 0;
#define PH_ON (ph >= p.ph_lo && ph < p.ph_hi)
    volatile LAS unsigned* bst = (volatile LAS unsigned*)(lds + LDS_BYTES - 64);
    if (threadIdx.x < 2) bst[threadIdx.x] = 0u;
    __syncthreads();
    const XcdBarrier xbar = xcd_barrier_post((unsigned*)(ws + WS_CTL), bst);
#define PH_END do { if (ph >= p.ph_lo && ph + 1 < p.ph_hi) { for (int r_ = 0; r_ < NREP(8); ++r_) { if (ph == 0) grid.sync(); else xcd_barrier(xbar); } } ++ph; } while (0)

    if (PH_ON) {
        FRESH_IDS;
        {
            LAS float* scr = (LAS float*)(lds + wave * 16384);
            constexpr int I_W1 = 16 * 128, I_W2 = 64 * 32, I_GLU = 16 * 64, I_QKV = 16 * 96, I_SQ = 16 * 32;
            constexpr int NIT = 4 * (I_W1 + I_W2) + 2 * I_GLU + I_QKV + 2 * I_SQ;
            for (int it = gw; it < NIT; it += NGW) {
                int r = it;
                if (r < 4 * I_W1) { const int l = r / I_W1; transpose_item(p.mlp_w1 + (size_t)l * D * DFF, D, DFF, W1T + (size_t)l * D * DFF, 0, scr, r % I_W1, lane); continue; } r -= 4 * I_W1;
                if (r < 4 * I_W2) { const int l = r / I_W2; transpose_item(p.mlp_w2 + (size_t)l * D * DFF, DFF, D, W2T + (size_t)l * D * DFF, 0, scr, r % I_W2, lane); continue; } r -= 4 * I_W2;
                if (r < 2 * I_GLU) { const int l = r / I_GLU; transpose_item(p.s5_wglu + (size_t)l * D * 2 * D, D, 2 * D, GLUT + (size_t)l * D * 2 * D, 1, scr, r % I_GLU, lane); continue; } r -= 2 * I_GLU;
                if (r < I_QKV) { transpose_item(p.wqkv, D, 3 * D, QKVT, 2, scr, r, lane); continue; } r -= I_QKV;
                if (r < I_SQ) { transpose_item(p.wo, D, D, WOT, 0, scr, r, lane); continue; } r -= I_SQ;
                transpose_item(p.fw, D, D, FWT, 0, scr, r, lane);
            }
        }
        if (REP_MASK) { for (int e = bid * 512 + tid; e < 9 * NMOD * D; e += G * 512) ((float*)(ws + WS_ZERO))[e] = 0.f; }
        __syncthreads();
        {
            LAS float* sc = (LAS float*)lds;
            LAS float* red = (LAS float*)(lds + 9 * 4096);
            for (int e = tid; e < 9 * D; e += 512) { const float v = e < 8 * D ? p.c[e] : p.c_ctx[e - 8 * D]; sc[e] = v * sigmoidf_(v); }
            __syncthreads();
            const int col = tid & 63, kp = tid >> 6;
            for (int item = bid; item < 4 * 96; item += G) {
                const int i = item / 96, nb = item % 96;
                float a[9];
#pragma unroll
                for (int r = 0; r < 9; ++r) a[r] = 0.f;
                const float* wp = p.w_mod + ((size_t)i * D + kp * 128) * (NMOD * D) + nb * 64 + col;
#pragma unroll 8
                for (int k = 0; k < 128; ++k) { const float w = wp[(size_t)k * (NMOD * D)];
#pragma unroll
                    for (int r = 0; r < 9; ++r) a[r] += sc[r * D + kp * 128 + k] * w; }
#pragma unroll
                for (int r = 0; r < 9; ++r) red[(kp * 64 + col) * 9 + r] = a[r];
                __syncthreads();
                for (int e = tid; e < 576; e += 512) { const int r = e >> 6, cc = e & 63; float s = p.b_mod[i * (NMOD * D) + nb * 64 + cc];
#pragma unroll
                    for (int q = 0; q < 8; ++q) s += red[(q * 64 + cc) * 9 + r];
                    MOD[((size_t)i * 9 + r) * (NMOD * D) + nb * 64 + cc] = s; }
                __syncthreads();
            }
        }
        {
            LAS float* Bb = (LAS float*)lds;
            LAS float* Cc = (LAS float*)(lds + 8192);
            LAS float* ap = (LAS float*)(lds + 16384);
            for (int item = bid; item < 256; item += G) {
                const int j = item >> 7, g = (item >> 1) & 63, dir = item & 1;
                const int pg = (j * 2 + dir) * 64 + g;
                const float dt = __expf(p.s5_ldt[pg]);
                __syncthreads();
                for (int e = tid; e < 1024; e += 512) { const int pp = e >> 4, h = e & 15; float kr, ki; s5_kcoef(p.s5_lre[pg * 64 + pp], p.s5_lim[pg * 64 + pp], dt, kr, ki);
                    const float br = p.s5_bre[((size_t)pg * 64 + pp) * 16 + h], bi = p.s5_bim[((size_t)pg * 64 + pp) * 16 + h];
                    Bb[e * 2] = kr * br - ki * bi; Bb[e * 2 + 1] = kr * bi + ki * br;
                    const int h2 = e >> 6, p2 = e & 63; Cc[e * 2] = p.s5_cre[((size_t)pg * 16 + h2) * 64 + p2]; Cc[e * 2 + 1] = p.s5_cim[((size_t)pg * 16 + h2) * 64 + p2]; }
                for (int e = tid; e < 2048; e += 512) { const int tau = e >> 6, pp = e & 63; float re, im; cpow(p.s5_lre[pg * 64 + pp] * dt, p.s5_lim[pg * 64 + pp] * dt, (float)tau, re, im); ap[e * 2] = re; ap[e * 2 + 1] = im; }
                __syncthreads();
                const int hh = tid & 255, h = hh >> 4, hp = hh & 15, th = tid >> 8;
                float a[16];
#pragma unroll
                for (int q = 0; q < 16; ++q) a[q] = 0.f;
                for (int pp = 0; pp < 64; ++pp) { const float cr = Cc[(h * 64 + pp) * 2], ci = Cc[(h * 64 + pp) * 2 + 1], br = Bb[(pp * 16 + hp) * 2], bi = Bb[(pp * 16 + hp) * 2 + 1];
                    const float cbr = cr * br - ci * bi, cbi = cr * bi + ci * br;
#pragma unroll
                    for (int q = 0; q < 16; ++q) { const float ar = ap[((th * 16 + q) * 64 + pp) * 2], ai = ap[((th * 16 + q) * 64 + pp) * 2 + 1]; a[q] += cbr * ar - cbi * ai; } }
#pragma unroll
                for (int q = 0; q < 16; ++q) KTAB[((((size_t)j * 64 + g) * 2 + dir) * 32 + th * 16 + q) * 256 + hh] = a[q];
            }
            __syncthreads();
        }
    }
    PH_END;

    for (int li = 0; li < 4; ++li) {
        const int kind = li % 3, jj = li / 3; const bool last = (li == 3);
        const float* xl = li == 0 ? p.x : p.out; const float* xc = li == 0 ? p.ctx : XCTX;
        const float* modl = MOD + (size_t)li * 9 * (NMOD * D);
        const float* ng = p.norm_g + (size_t)li * 2 * D;
        float* PART = (float*)(ws + WS_PART);
        const CtxFix fxA{li > 0 ? PART : nullptr, MOD + ((size_t)(li - 1) * 9 + 8) * (NMOD * D) + 5 * D, nullptr, XCTX};
        const CtxFix fxF{(kind != 0 && !last) ? PART : nullptr, modl + 8 * (NMOD * D) + 2 * D, kind == 2 ? p.fb : nullptr, XCTX};

        if (PH_ON) {
            FRESH_IDS;
            if (kind == 0) {
                for (int rep = 0; rep < NREP(3); ++rep) norm_rows_s5(xl, xc, ng, modl, HN, gw, NGW, lane, fxA);
                bf16_t* W1S = (bf16_t*)(ws + WS_W1S); bf16_t* W3S = (bf16_t*)(ws + WS_W3S);
                LAS float* apf = (LAS float*)lds;
                LAS float* apb = (LAS float*)(lds + 16896);
                LAS float* Cf = (LAS float*)(lds + 33792);
                LAS float* Cb = (LAS float*)(lds + 41984);
                LAS float* Bbf = (LAS float*)(lds + 50176);
                LAS float* Bbb = (LAS float*)(lds + 58368);
                for (int item = bid; item < 256; item += G) {
                    const int g = item >> 2, tq = item & 3;
                    __syncthreads();
                    for (int e = tid; e < 2 * 33 * 64; e += 512) { const int dir = e / (33 * 64), r = e % (33 * 64), k = r >> 6, pp = r & 63; const int pg = (jj * 2 + dir) * 64 + g;
                        const float dt = __expf(p.s5_ldt[pg]); float re, im; cpow(p.s5_lre[pg * 64 + pp] * dt, p.s5_lim[pg * 64 + pp] * dt, (float)k, re, im);
                        LAS float* d = dir ? apb : apf; d[r * 2] = re; d[r * 2 + 1] = im; }
                    for (int e = tid; e < 2048; e += 512) { const int dir = e >> 10, r = e & 1023; const int pg = (jj * 2 + dir) * 64 + g;
                        { const int h2 = r >> 6, p2 = r & 63; LAS float* d = dir ? Cb : Cf; d[r * 2] = p.s5_cre[((size_t)pg * 16 + h2) * 64 + p2]; d[r * 2 + 1] = p.s5_cim[((size_t)pg * 16 + h2) * 64 + p2]; }
                        { const int pp = r >> 4, h = r & 15; const float dt = __expf(p.s5_ldt[pg]); float kr, ki; s5_kcoef(p.s5_lre[pg * 64 + pp], p.s5_lim[pg * 64 + pp], dt, kr, ki);
                          const float br = p.s5_bre[((size_t)pg * 64 + pp) * 16 + h], bi = p.s5_bim[((size_t)pg * 64 + pp) * 16 + h];
                          LAS float* d = dir ? Bbb : Bbf; d[r * 2] = kr * br - ki * bi; d[r * 2 + 1] = kr * bi + ki * br; } }
                    __syncthreads();
                    for (int e = tid; e < 4096; e += 512) { const int ee = tq * 4096 + e; const int hh = ee & 1, s = (ee >> 1) & 31, pp = (ee >> 6) & 63, ri = (ee >> 12) & 1, dir = ee >> 13;
                        const int ex = dir ? s : 31 - s; const LAS float* apd = dir ? apb : apf; const LAS float* bd = dir ? Bbb : Bbf;
                        const float ar = apd[(ex * 64 + pp) * 2], ai = apd[(ex * 64 + pp) * 2 + 1];
                        float v[8];
#pragma unroll
                        for (int i = 0; i < 8; ++i) { const float br = bd[(pp * 16 + hh * 8 + i) * 2], bi = bd[(pp * 16 + hh * 8 + i) * 2 + 1]; v[i] = ri ? ar * bi + ai * br : ar * br - ai * bi; }
                        *(u32x4*)(W1S + ((size_t)(g * 256 + dir * 128 + ri * 64 + pp)) * 512 + s * 16 + hh * 8) = (u32x4){pk2(v[0], v[1]), pk2(v[2], v[3]), pk2(v[4], v[5]), pk2(v[6], v[7])}; }
                    const float* ktf = KTAB + (((size_t)jj * 64 + g) * 2 + 0) * 32 * 256; const float* ktb = ktf + 32 * 256;
                    for (int e = tid; e < 128 * 96; e += 512) { const int kc = e % 96, rowi = e / 96, t = tq * 8 + (rowi >> 4), h = rowi & 15;
                        float v[8];
                        if (kc < 64) { const int s = kc >> 1, h0 = (kc & 1) * 8;
#pragma unroll
                            for (int i = 0; i < 8; ++i) v[i] = 0.f;
                            if (s <= t) { const f32x4* kp = (const f32x4*)(ktf + (t - s) * 256 + h * 16 + h0); const f32x4 a = kp[0], b = kp[1];
#pragma unroll
                                for (int i = 0; i < 4; ++i) { v[i] += a[i]; v[4 + i] += b[i]; } }
                            if (s >= t) { const f32x4* kp = (const f32x4*)(ktb + (s - t) * 256 + h * 16 + h0); const f32x4 a = kp[0], b = kp[1];
#pragma unroll
                                for (int i = 0; i < 4; ++i) { v[i] += a[i]; v[4 + i] += b[i]; } }
                            if (s == t) { const float dd = p.s5_d[jj * D + g * 16 + h];
#pragma unroll
                                for (int i = 0; i < 8; ++i) if (h0 + i == h) v[i] += dd; }
                        } else { const int q = kc - 64, dir = q >> 4, ri = (q >> 3) & 1, p0 = (q & 7) * 8; const int ex = dir ? 32 - t : t + 1;
                            const LAS float* apd = dir ? apb : apf; const LAS float* cd = dir ? Cb : Cf;
#pragma unroll
                            for (int i = 0; i < 8; ++i) { const int pp = p0 + i; const float ar = apd[(ex * 64 + pp) * 2], ai = apd[(ex * 64 + pp) * 2 + 1], cr = cd[(h * 64 + pp) * 2], ci = cd[(h * 64 + pp) * 2 + 1];
                                v[i] = ri ? -(cr * ai + ci * ar) : cr * ar - ci * ai; } }
                        *(u32x4*)(W3S + ((size_t)(g * 512 + t * 16 + h)) * UGP + kc * 8) = (u32x4){pk2(v[0], v[1]), pk2(v[2], v[3]), pk2(v[4], v[5]), pk2(v[6], v[7])}; }
                }
                __syncthreads();
            } else {
                for (int rep = 0; rep < NREP(3); ++rep) norm_rows_tok(xl, xc, ng, modl, 0, HN, TA, gw, NGW, lane, kind == 2, fxA);
                if (kind == 2) {
                    bf16_t* CS = (bf16_t*)(ws + WS_CS); bf16_t* CN2 = (bf16_t*)(ws + WS_CN256); bf16_t* W1M = (bf16_t*)(ws + WS_W1M); bf16_t* W2M = (bf16_t*)(ws + WS_W2M);
                    const int gt = bid * 512 + tid, NT = G * 512;
                    for (int e = gt; e < 2 * 256 * 16; e += NT) { const int which = e >> 12, r = (e >> 4) & 255, kc = e & 15, k0 = (kc & 7) * 8, hs = kc >> 3; float v[8];
#pragma unroll
                        for (int i = 0; i < 8; ++i) { const int mm = r & 63; const float rev = (float)((mm * (k0 + i)) & 63) * (1.f / 64.f); const float cs = __builtin_amdgcn_cosf(rev), sn = __builtin_amdgcn_sinf(rev);
                            float val = 0.f;
                            if (which == 0) { if (r < 64) val = hs ? -sn : cs; else if (r >= 128 && r < 192) val = hs ? -cs : -sn; }
                            else { if (r < 64) val = hs ? sn : cs; }
                            v[i] = val; }
                        *(u32x4*)((which ? W2M : W1M) + (size_t)r * 128 + kc * 8) = (u32x4){pk2(v[0], v[1]), pk2(v[2], v[3]), pk2(v[4], v[5]), pk2(v[6], v[7])}; }
                    for (int e = gt; e < 512 * 32; e += NT) { const int m = e >> 5, kc = m & 255, isS = m >> 8, k0 = (e & 31) * 8; float v[8];
#pragma unroll
                        for (int i = 0; i < 8; ++i) { const float rev = (float)((kc * (k0 + i)) & 255) * (1.f / 256.f); v[i] = (isS ? __builtin_amdgcn_sinf(rev) : __builtin_amdgcn_cosf(rev)) * (1.f / 16.f); }
                        *(u32x4*)(CS + (size_t)m * 256 + k0) = (u32x4){pk2(v[0], v[1]), pk2(v[2], v[3]), pk2(v[4], v[5]), pk2(v[6], v[7])}; }
                    for (int e = gt; e < 256 * 64; e += NT) { const int m = e >> 6, kc = e & 63, k0 = (kc & 31) * 8, isS = kc >> 5; float v[8];
#pragma unroll
                        for (int i = 0; i < 8; ++i) { const float rev = (float)((m * (k0 + i)) & 255) * (1.f / 256.f); v[i] = (isS ? -__builtin_amdgcn_sinf(rev) : __builtin_amdgcn_cosf(rev)) * (1.f / 16.f); }
                        *(u32x4*)(CN2 + (size_t)m * 512 + kc * 8) = (u32x4){pk2(v[0], v[1]), pk2(v[2], v[3]), pk2(v[4], v[5]), pk2(v[6], v[7])}; }
                }
            }
        }
        PH_END;

        if (kind == 0) {
            if (PH_ON) {
                pg8::Gemm g{HN, (const bf16_t*)(ws + WS_W1S), UGP, 512, 512, (size_t)NCH * UGP, (size_t)256 * 512};
                pg8::Sched S; S.init(5, 1, 64);
                pg8::EpiSloc E{(float*)(ws + WS_SLOC)};
                pg8::gemm_phase(lds, g, S, E, wave0);
            }
            PH_END;
            if (PH_ON) {
                FRESH_IDS;
                const float* SL = (const float*)(ws + WS_SLOC);
                for (int id = bid * 512 + tid; id < 8 * 64 * 2 * 64; id += G * 512) {
                    const int pp = id & 63, dir = (id >> 6) & 1, g = (id >> 7) & 63, b = id >> 13;
                    const int pg = (jj * 2 + dir) * 64 + g; const float dt = __expf(p.s5_ldt[pg]);
                    float ar, ai; cpow(p.s5_lre[pg * 64 + pp] * dt, p.s5_lim[pg * 64 + pp] * dt, 32.f, ar, ai);
                    float sr = 0.f, si = 0.f;
                    const size_t rb = (size_t)g * NCH + b * 136;
                    for (int k0 = 0; k0 < 136; k0 += 8) {
                        float lr[8], lim[8];
#pragma unroll
                        for (int q = 0; q < 8; ++q) { const int k = k0 + q; const int cc = dir == 0 ? k : (k < 8 ? 7 - k : 143 - k);
                            lr[q] = SL[(rb + cc) * 256 + dir * 128 + pp]; lim[q] = SL[(rb + cc) * 256 + dir * 128 + 64 + pp]; }
#pragma unroll
                        for (int q = 0; q < 8; ++q) { const int k = k0 + q; const int cc = dir == 0 ? k : (k < 8 ? 7 - k : 143 - k);
                            bf16_t* o = HN + (rb + cc) * UGP + 512 + dir * 128 + pp;
                            o[0] = (bf16_t)(pk2(sr, 0.f) & 0xffffu); o[64] = (bf16_t)(pk2(si, 0.f) & 0xffffu);
                            const float nr = ar * sr - ai * si + lr[q], ni = ar * si + ai * sr + lim[q]; sr = nr; si = ni; }
                    }
                }
            }
            PH_END;
            if (PH_ON) {
                pg8::Gemm g{HN, (const bf16_t*)(ws + WS_W3S), UGP, UGP, UGP, (size_t)NCH * UGP, (size_t)512 * UGP};
                pg8::Sched S; S.init(5, 2, 64);
                pg8::EpiZ E{(bf16_t*)(ws + WS_Z)};
                pg8::gemm_phase(lds, g, S, E, wave0);
            }
            PH_END;
            if (PH_ON) {
                pg8::Gemm g{(const bf16_t*)(ws + WS_Z), GLUT + (size_t)jj * D * 2 * D, D, D, D, 0, 0};
                pg8::Sched S; S.init(last ? 128 : 136, 8, 1);
                pg8::EpiGlu E{xl, xc, p.out, XCTX, modl + 2 * D};
                pg8::gemm_phase(lds, g, S, E, wave0);
            }
            PH_END;
        } else if (kind == 1) {
            bf16_t* QK = (bf16_t*)(ws + WS_QK); bf16_t* VT = (bf16_t*)(ws + WS_VT);
            if (PH_ON) {
                { pg8::Gemm g{HN, QKVT, D, D, D, 0, 0}; pg8::Sched S; S.init(136, 8, 1); pg8::EpiQK E{QK, p.qn, p.kn}; pg8::gemm_phase(lds, g, S, E, wave0); }
                { pg8::Gemm g{QKVT + (size_t)2048 * D, HN, D, D, D, 0, 0}; pg8::Sched S; S.init(4, 136, 1, 0, 128); pg8::EpiStore<0> E{VT, (size_t)TA, 0}; pg8::gemm_phase(lds, g, S, E, wave0); }
            }
            PH_END;
            if (PH_ON) {
                FRESH_IDS;
                const int l31 = lane & 31, hi = lane >> 5, comp = wave >> 2, wq = wave & 3;
                float lamv; { const float a = wave_sum(p.dlam[lane] * p.dlam[64 + lane], lane), b = wave_sum(p.dlam[128 + lane] * p.dlam[192 + lane], lane); lamv = __expf(a) - __expf(b) + LAM_INIT; }
                const int vcu = (G % 8 == 0) ? (bid % 8) * (G / 8) + bid / 8 : bid;
                constexpr int KROW = 144, KTILE = 64 * KROW, VTILE = 128 * KROW, VRING = 4 * KTILE;
                const int kr = tid >> 3, kch = tid & 7;
                const int kst = kr * KROW + kch * 16, vst = kr * KROW + ((kch >> 1) * 32 + (kch & 1) * 8);
                for (int rep = 0; rep < NREP(2); ++rep)
                for (int u = vcu; u < 2176; u += G) {
                    int b, head, qrow0, j0;
                    if (u < 2048) { b = u >> 8; head = (u >> 5) & 7; qrow0 = b * 4096 + (u & 31) * 128; j0 = 0; }
                    else { const int v = u - 2048; b = v >> 4; head = (v >> 1) & 7; qrow0 = TL + b * 256 + (v & 1) * 128; j0 = 64; }
                    bf16x8 qf[4];
                    { const bf16_t* qp = QK + (size_t)(qrow0 + wq * 32 + l31) * 2048 + head * 128 + comp * 64 + hi * 8;
#pragma unroll
                      for (int ds = 0; ds < 4; ++ds) qf[ds] = *(const bf16x8*)(qp + ds * 16); }
                    const bf16_t* kbase = QK + (size_t)kr * 2048 + 1024 + head * 128 + kch * 8;
                    const bf16_t* vbase = VT + (size_t)(head * 128 + kr) * TA + kch * 8;
                    u32x4 pk0, pk1, pv0, pv1;
#define ATT_TOKBASE(j) ((j) < 64 ? b * 4096 + 64 * (j) : TL + b * 256 + 64 * ((j) - 64))
#define ATT_LOADK(j) do { const bf16_t* kp_ = kbase + (size_t)ATT_TOKBASE(j) * 2048; pk0 = *(const u32x4*)kp_; pk1 = *(const u32x4*)(kp_ + 64); } while (0)
#define ATT_LOADV(j) do { const bf16_t* vp_ = vbase + ATT_TOKBASE(j); pv0 = *(const u32x4*)vp_; pv1 = *(const u32x4*)(vp_ + (size_t)64 * TA); } while (0)
#define ATT_STOREK(sl) do { LAS unsigned char* bb_ = lds + (sl) * (2 * KTILE) + kst; *(LAS u32x4*)(bb_) = pk0; *(LAS u32x4*)(bb_ + KTILE) = pk1; } while (0)
#define ATT_STOREV(sl) do { LAS unsigned char* vb_ = lds + VRING + (sl) * VTILE + vst; \
                        *(LAS u32x2*)(vb_) = (u32x2){pv0.x, pv0.y}; *(LAS u32x2*)(vb_ + 16) = (u32x2){pv0.z, pv0.w}; \
                        *(LAS u32x2*)(vb_ + 64 * KROW) = (u32x2){pv1.x, pv1.y}; *(LAS u32x2*)(vb_ + 64 * KROW + 16) = (u32x2){pv1.z, pv1.w}; } while (0)
#define ATT_QK(S0, S1, sl, CI) do { const LAS unsigned char* kb_ = lds + (sl) * (2 * KTILE) + comp * KTILE + l31 * KROW + hi * 16; bf16x8 kf_[8]; \
                        _Pragma("unroll") for (int ds = 0; ds < 4; ++ds) { kf_[2 * ds] = *(const LAS bf16x8*)(kb_ + ds * 32); kf_[2 * ds + 1] = *(const LAS bf16x8*)(kb_ + 32 * KROW + ds * 32); } \
                        __builtin_amdgcn_sched_barrier(0); \
                        _Pragma("unroll") for (int ds = 0; ds < 4; ++ds) { \
                            S0 = __builtin_amdgcn_mfma_f32_32x32x16_bf16(kf_[2 * ds], qf[ds], ds == 0 ? CI : S0, 0, 0, 0); S1 = __builtin_amdgcn_mfma_f32_32x32x16_bf16(kf_[2 * ds + 1], qf[ds], ds == 0 ? CI : S1, 0, 0, 0); } } while (0)
#define ATT_PV(sl) do { const LAS unsigned char* vb_ = lds + VRING + (sl) * VTILE + l31 * KROW + hi * 16; \
                        _Pragma("unroll") for (int ks = 0; ks < 4; ++ks) _Pragma("unroll") for (int dt = 0; dt < 4; ++dt) { const bf16x8 a_ = *(const LAS bf16x8*)(vb_ + dt * 32 * KROW + ks * 32); \
                            o[dt] = __builtin_amdgcn_mfma_f32_32x32x16_bf16(a_, pp[ks], o[dt], 0, 0, 0); } } while (0)
#define ATT_SOFT(S0, S1, PD) do { f32x2 ls_ = {0.f, 0.f}; \
                        _Pragma("unroll") for (int r = 0; r < 16; ++r) { S0[r] = __builtin_amdgcn_exp2f(S0[r]); S1[r] = __builtin_amdgcn_exp2f(S1[r]); } \
                        _Pragma("unroll") for (int r = 0; r < 16; r += 2) { ls_ += (f32x2){S0[r], S0[r + 1]}; ls_ += (f32x2){S1[r], S1[r + 1]}; } \
                        l_run += ls_.x + ls_.y; \
                        { u32x4 w_; \
                          w_ = (u32x4){pk2(S0[0], S0[1]), pk2(S0[2], S0[3]), pk2(S0[4], S0[5]), pk2(S0[6], S0[7])}; PD[0] = __builtin_bit_cast(bf16x8, w_); \
                          w_ = (u32x4){pk2(S0[8], S0[9]), pk2(S0[10], S0[11]), pk2(S0[12], S0[13]), pk2(S0[14], S0[15])}; PD[1] = __builtin_bit_cast(bf16x8, w_); \
                          w_ = (u32x4){pk2(S1[0], S1[1]), pk2(S1[2], S1[3]), pk2(S1[4], S1[5]), pk2(S1[6], S1[7])}; PD[2] = __builtin_bit_cast(bf16x8, w_); \
                          w_ = (u32x4){pk2(S1[8], S1[9]), pk2(S1[10], S1[11]), pk2(S1[12], S1[13]), pk2(S1[14], S1[15])}; PD[3] = __builtin_bit_cast(bf16x8, w_); } } while (0)
                    f32x16 o[4];
#pragma unroll
                    for (int dt = 0; dt < 4; ++dt)
#pragma unroll
                        for (int r = 0; r < 16; ++r) o[dt][r] = 0.f;
                    float m_ref, l_run = 0.f;
                    f32x16 negm, zero16;
#pragma unroll
                    for (int r = 0; r < 16; ++r) zero16[r] = 0.f;
                    bf16x8 pp[4];
                    __syncthreads();
                    ATT_LOADK(j0); ATT_STOREK(j0 & 1);
                    __syncthreads();
                    {
                        ATT_LOADK(j0 + 1); ATT_LOADV(j0);
                        f32x16 s0, s1;
                        ATT_QK(s0, s1, j0 & 1, zero16);
                        float mx = fmaxf(s0[0], s1[0]);
#pragma unroll
                        for (int r = 1; r < 16; ++r) mx = fmaxf(mx, fmaxf(s0[r], s1[r]));
                        m_ref = xhalf_max(mx);
#pragma unroll
                        for (int r = 0; r < 16; ++r) { s0[r] -= m_ref; s1[r] -= m_ref; negm[r] = -m_ref; }
                        ATT_SOFT(s0, s1, pp);
                        ATT_STOREK((j0 + 1) & 1); ATT_STOREV(j0 & 1);
                        __syncthreads();
                    }
                    for (int j = j0 + 1; j < 68; ++j) {
                        const int jn = j + 1 < 68 ? j + 1 : 67;
                        ATT_LOADK(jn); ATT_LOADV(j);
                        f32x16 s0, s1;
                        ATT_QK(s0, s1, j & 1, negm);
                        float mx = max3f(s0[0], s1[0], s0[1]), mx2 = max3f(s1[1], s0[2], s1[2]);
#pragma unroll
                        for (int r = 3; r < 15; r += 2) { mx = max3f(mx, s0[r], s1[r]); mx2 = max3f(mx2, s0[r + 1], s1[r + 1]); }
                        mx = max3f(mx, s0[15], s1[15]); mx = fmaxf(mx, mx2);
                        mx = xhalf_max(mx);
                        if (__builtin_expect(__any(mx > ATT_THR), 0)) {
                            const float dl = ceilf(fmaxf(mx, 0.f)), f = __builtin_amdgcn_exp2f(-dl);
                            m_ref += dl; l_run *= f;
#pragma unroll
                            for (int r = 0; r < 16; ++r) { s0[r] -= dl; s1[r] -= dl; negm[r] = -m_ref; }
#pragma unroll
                            for (int dt = 0; dt < 4; ++dt)
#pragma unroll
                                for (int r = 0; r < 16; ++r) o[dt][r] *= f;
#pragma unroll
                            for (int ks = 0; ks < 4; ++ks) { u32x4 w = __builtin_bit_cast(u32x4, pp[ks]);
                                w.x = pk2(bflo(w.x) * f, bfhi(w.x) * f); w.y = pk2(bflo(w.y) * f, bfhi(w.y) * f); w.z = pk2(bflo(w.z) * f, bfhi(w.z) * f); w.w = pk2(bflo(w.w) * f, bfhi(w.w) * f);
                                pp[ks] = __builtin_bit_cast(bf16x8, w); }
                        }
                        __builtin_amdgcn_sched_barrier(0);
                        unsigned pw[16]; f32x2 ls = {0.f, 0.f};
                        {
                            const LAS unsigned char* vb_ = lds + VRING + ((j - 1) & 1) * VTILE + l31 * KROW + hi * 16;
                            bf16x8 vf[16];
#define ATT_VRD(i) vf[i] = *(const LAS bf16x8*)(vb_ + ((i) & 3) * 32 * KROW + ((i) >> 2) * 32)
                            ATT_VRD(0); ATT_VRD(1);
#pragma unroll
                            for (int i = 0; i < 16; ++i) {
                                if (i + 2 < 16) ATT_VRD(i + 2);
                                o[i & 3] = __builtin_amdgcn_mfma_f32_32x32x16_bf16(vf[i], pp[i >> 2], o[i & 3], 0, 0, 0);
                                s0[i] = __builtin_amdgcn_exp2f(s0[i]); s1[i] = __builtin_amdgcn_exp2f(s1[i]);
                                if (i & 1) { pw[i >> 1] = pk2(s0[i - 1], s0[i]); pw[8 + (i >> 1)] = pk2(s1[i - 1], s1[i]); ls += (f32x2){s0[i - 1], s0[i]}; ls += (f32x2){s1[i - 1], s1[i]}; }
                                __builtin_amdgcn_sched_barrier(0);
                            }
#undef ATT_VRD
                        }
                        l_run += ls.x + ls.y;
#pragma unroll
                        for (int ks = 0; ks < 4; ++ks) { const u32x4 w = {pw[4 * ks], pw[4 * ks + 1], pw[4 * ks + 2], pw[4 * ks + 3]}; pp[ks] = __builtin_bit_cast(bf16x8, w); }
                        ATT_STOREK(jn & 1); ATT_STOREV(j & 1);
                        __syncthreads();
                    }
                    ATT_PV(67 & 1);
#undef ATT_TOKBASE
#undef ATT_LOADK
#undef ATT_LOADV
#undef ATT_STOREK
#undef ATT_STOREV
#undef ATT_QK
#undef ATT_PV
#undef ATT_SOFT
                    { const float lt = xhalf_sum(l_run); const float inv = 1.f / lt;
#pragma unroll
                      for (int dt = 0; dt < 4; ++dt)
#pragma unroll
                          for (int r = 0; r < 16; ++r) o[dt][r] *= inv; }
                    __syncthreads();
                    LAS float* ex = (LAS float*)lds + wq * 4096;
                    if (comp == 1) {
#pragma unroll
                        for (int dt = 0; dt < 4; ++dt)
#pragma unroll
                            for (int r = 0; r < 16; ++r) ex[(dt * 16 + r) * 64 + lane] = o[dt][r];
                    }
                    __syncthreads();
                    LAS bf16_t* stg = (LAS bf16_t*)(lds + 81920) + wq * (32 * 136);
                    if (comp == 0) {
                        float ss = 0.f;
#pragma unroll
                        for (int dt = 0; dt < 4; ++dt)
#pragma unroll
                            for (int r = 0; r < 16; ++r) { const float d = o[dt][r] - lamv * ex[(dt * 16 + r) * 64 + lane]; o[dt][r] = d; ss += d * d; }
                        ss = xhalf_sum(ss);
                        const float rstd = rsqrtf(ss * (1.f / 128.f) + EPS) * (1.f - LAM_INIT);
#pragma unroll
                        for (int dt = 0; dt < 4; ++dt)
#pragma unroll
                            for (int r = 0; r < 16; ++r) { const int dv = 32 * dt + (r & 3) + 8 * (r >> 2) + 4 * hi; stg[l31 * 136 + dv] = (bf16_t)(pk2(o[dt][r] * rstd * p.subln[dv], 0.f) & 0xffffu); }
                    }
                    __syncthreads();
                    if (comp == 0) {
#pragma unroll
                        for (int it = 0; it < 8; ++it) { const int row = it * 4 + (lane >> 4), ch = lane & 15;
                            const u32x4 w = *(const LAS u32x4*)(stg + row * 136 + ch * 8);
                            *(u32x4*)(HN + (size_t)(qrow0 + wq * 32 + row) * D + head * 128 + ch * 8) = w; }
                    }
                }
                __syncthreads();
            }
            PH_END;
        } else {
            if (PH_ON) {
                pg8::Gemm g{(const bf16_t*)(ws + WS_CS), HN, 256, D, 256, 0, 256};
                pg8::Sched S; S.init(2, 136, 4);
                pg8::EpiChanDft E{(bf16_t*)(ws + WS_PQT), (bf16_t*)(ws + WS_PQC)};
                pg8::gemm_phase(lds, g, S, E, wave0);
            }
            PH_END;
            if (PH_ON) {
                { pg8::Gemm g{(const bf16_t*)(ws + WS_W1M), (const bf16_t*)(ws + WS_PQT), 128, 128, 128, 0, 0};
                  pg8::Sched S; S.init(1, 2048, 1); pg8::EpiFft1 E{(bf16_t*)(ws + WS_B2)}; pg8::gemm_phase(lds, g, S, E, wave0); }
                { pg8::Gemm g{(const bf16_t*)(ws + WS_CN256), (const bf16_t*)(ws + WS_PQC), 512, 512, 512, 0, (size_t)1024 * 512};
                  pg8::Sched S; S.init(1, 4, 8); pg8::EpiStore<0> E{HN + (size_t)TL * D, D, (size_t)256 * D}; pg8::gemm_phase(lds, g, S, E, wave0); }
            }
            PH_END;
            if (PH_ON) {
                pg8::Gemm g{(const bf16_t*)(ws + WS_W2M), (const bf16_t*)(ws + WS_B2), 128, 128, 128, 0, 0};
                pg8::Sched S; S.init(1, 2048, 1); pg8::EpiFft2 E{HN}; pg8::gemm_phase(lds, g, S, E, wave0);
            }
            PH_END;
        }
        if (kind != 0) {
            if (PH_ON) {
                { pg8::Gemm g{HN, kind == 1 ? WOT : FWT, D, D, D, 0, 0};
                  pg8::Sched S; S.init(128, 4, 1);
                  pg8::EpiResid E{xl, xc, p.out, XCTX, modl + 2 * D, kind == 2 ? p.fb : nullptr};
                  pg8::gemm_phase(lds, g, S, E, wave0); }
                if (!last) { pg8::Gemm g{HN, kind == 1 ? WOT : FWT, D, D, D / KSPLIT, (size_t)(D / KSPLIT), (size_t)(D / KSPLIT)};
                  pg8::Sched S; S.init(8, 4, KSPLIT, 128);
                  pg8::EpiPart E{PART};
                  pg8::gemm_phase(lds, g, S, E, wave0); }
            }
            PH_END;
        }
        if (PH_ON) { FRESH_IDS; for (int rep = 0; rep < NREP(3); ++rep) norm_rows_tok(p.out, XCTX, ng + D, modl, 3, HN, last ? TL : TA, gw, NGW, lane, false, fxF); }
        PH_END;
        if (PH_ON) {
            for (int rep = 0; rep < NREP(0); ++rep) {
            pg8::Gemm g{HN, W1T + (size_t)li * D * DFF, D, D, D, 0, 0};
            pg8::Sched S; S.init(last ? 128 : 136, 16, 1);
            pg8::EpiStore<1> E{HB, DFF, 0};
            pg8::gemm_phase(lds, g, S, E, wave0); }
        }
        PH_END;
        if (PH_ON) {
            if (!last) { pg8::Gemm g{HB, W2T + (size_t)li * D * DFF, DFF, DFF, DFF / KSPLIT, (size_t)(DFF / KSPLIT), (size_t)(DFF / KSPLIT)};
              pg8::Sched S; S.init(8, 4, KSPLIT, 128);
              pg8::EpiPart E{PART};
              pg8::gemm_phase(lds, g, S, E, wave0); }
            for (int rep = 0; rep < NREP(1); ++rep) {
            pg8::Gemm g{HB, W2T + (size_t)li * D * DFF, DFF, DFF, DFF, 0, 0};
            pg8::Sched S; S.init(128, 4, 1);
            pg8::EpiResid E{p.out, XCTX, p.out, XCTX, (rep + 1 < NREP(1)) ? (const float*)(ws + WS_ZERO) : modl + 5 * D, nullptr};
            pg8::gemm_phase(lds, g, S, E, wave0); }
        }
        PH_END;
    }
}

extern "C" void kernel_launch(void* const* d_in, const int* in_sizes, int n_in, void* d_out, int out_size, void* d_ws, size_t ws_size, hipStream_t stream) {
    static int grid = 0;
    if (grid == 0) {
        int dev = 0, cus = 0, per_cu = 0;
        hipGetDevice(&dev);
        hipDeviceGetAttribute(&cus, hipDeviceAttributeMultiprocessorCount, dev);
        hipFuncSetAttribute((const void*)mega_fwd, hipFuncAttributeMaxDynamicSharedMemorySize, LDS_BYTES);
        hipOccupancyMaxActiveBlocksPerMultiprocessor(&per_cu, (const void*)mega_fwd, 512, LDS_BYTES);
        if (per_cu < 1) per_cu = 1;
        grid = cus * per_cu;
        if (ws_size < WS_END) fprintf(stderr, "kernel_launch: workspace too small: %zu < %zu\n", ws_size, (size_t)WS_END);
    }
    (void)hipMemsetAsync((char*)d_ws + WS_CTL, 0, CTL_BYTES, stream);
    Params p{};
    const float** f = (const float**)&p;
    for (int i = 0; i < 26; ++i) f[i] = (const float*)d_in[i];
    p.out = (float*)d_out; p.ws = (unsigned char*)d_ws; p.ph_lo = 0; p.ph_hi = 1000;
    void* args[] = {&p};
    hipError_t e = hipLaunchCooperativeKernel((const void*)mega_fwd, dim3(grid), dim3(512), args, LDS_BYTES, stream);
    if (e != hipSuccess) fprintf(stderr, "cooperative launch failed: %s (grid %d)\n", hipGetErrorString(e), grid);
}
```

```cpp
#include <hip/hip_runtime.h>
#include <hip/hip_cooperative_groups.h>
#include <cstdio>
#include <cstdint>
namespace cg = cooperative_groups;

#define LAS __attribute__((address_space(3)))
typedef unsigned short bf16_t;
typedef short bf16x8 __attribute__((ext_vector_type(8)));
typedef float f32x2 __attribute__((ext_vector_type(2)));
typedef float f32x4 __attribute__((ext_vector_type(4)));
typedef float f32x16 __attribute__((ext_vector_type(16)));
typedef unsigned u32x2 __attribute__((ext_vector_type(2)));
typedef unsigned u32x4 __attribute__((ext_vector_type(4)));
typedef __bf16 bf16x2_t __attribute__((ext_vector_type(2)));

__device__ __forceinline__ unsigned pk2(float lo, float hi) { f32x2 v = {lo, hi}; bf16x2_t b = __builtin_convertvector(v, bf16x2_t); return __builtin_bit_cast(unsigned, b); }
__device__ __forceinline__ float bflo(unsigned w) { return __uint_as_float(w << 16); }
__device__ __forceinline__ float bfhi(unsigned w) { return __uint_as_float(w & 0xffff0000u); }
__device__ __forceinline__ float shx(float v, int lane, int m) { return __int_as_float(__builtin_amdgcn_ds_bpermute((lane ^ m) << 2, __float_as_int(v))); }
__device__ __forceinline__ float wave_sum(float v, int lane) {
#pragma unroll
    for (int o = 1; o < 64; o <<= 1) v += shx(v, lane, o);
    return v;
}
__device__ __forceinline__ float xhalf_max(float v) { auto rr = __builtin_amdgcn_permlane32_swap(__float_as_uint(v), __float_as_uint(v), false, false); return fmaxf(__uint_as_float(rr[0]), __uint_as_float(rr[1])); }
__device__ __forceinline__ float xhalf_sum(float v) { auto rr = __builtin_amdgcn_permlane32_swap(__float_as_uint(v), __float_as_uint(v), false, false); return __uint_as_float(rr[0]) + __uint_as_float(rr[1]); }
__device__ __forceinline__ int fresh_tid(int wave0) { int l; asm volatile("v_mbcnt_lo_u32_b32 %0, -1, 0\n\tv_mbcnt_hi_u32_b32 %0, -1, %0" : "=v"(l)); return wave0 * 64 + l; }
#define LAUNDER_V(x) asm volatile("" : "+v"(x))
__device__ __forceinline__ float max3f(float a, float b, float c) { float r; asm("v_max3_f32 %0, %1, %2, %3" : "=v"(r) : "v"(a), "v"(b), "v"(c)); return r; }
__device__ __forceinline__ float sigmoidf_(float x) { return __builtin_amdgcn_rcpf(1.0f + __builtin_amdgcn_exp2f(-1.4426950408889634f * x)); }
__device__ __forceinline__ float gelu_tanh(float x) { const float u = 0.7978845608028654f * (x + 0.044715f * x * x * x); return x * sigmoidf_(2.0f * u); }

constexpr int D = 1024, TL = 32768, TC = 2048, TA = TL + TC, DFF = 4096, NMOD = 6;
constexpr int NCH = 1088;
constexpr int UGP = 768;
constexpr float EPS = 1e-6f;
constexpr float LAM_INIT = 0.35550906759f;
constexpr float QSCALE = 0.125f * 1.4426950408889634f;
#ifndef REP_MASK
#define REP_MASK 0
#endif
#define NREP(bit) ((REP_MASK >> (bit)) & 1 ? 2 : 1)
#ifndef ATT_THR
#define ATT_THR 16.0f
#endif

constexpr size_t MiB = 1u << 20;
constexpr size_t WS_W1T = 0, WS_W2T = 32 * MiB, WS_GLUT = 64 * MiB, WS_QKVT = 72 * MiB, WS_WOT = 78 * MiB, WS_FWT = 80 * MiB;
constexpr size_t WS_ZERO = 474 * MiB, WS_CTL = 475 * MiB, CTL_BYTES = 16384;
constexpr size_t WS_PART = 476 * MiB;
constexpr int KSPLIT = 4;
constexpr size_t WS_MOD = 82 * MiB, WS_KTAB = 83 * MiB, WS_XCTX = 91 * MiB, WS_HN = 99 * MiB, WS_H = 202 * MiB, WS_END = 474 * MiB;
constexpr size_t WS_SLOC = WS_H, WS_W1S = WS_H + 68 * MiB, WS_W3S = WS_H + 84 * MiB, WS_Z = WS_H + 132 * MiB;
constexpr size_t WS_QK = WS_H, WS_VT = WS_H + 136 * MiB;
constexpr size_t WS_PQT = WS_H, WS_PQC = WS_H + 128 * MiB, WS_B2 = WS_H + 136 * MiB, WS_CS = WS_H + 264 * MiB, WS_CN256 = WS_H + 265 * MiB, WS_W1M = WS_H + 266 * MiB, WS_W2M = WS_H + 267 * MiB;

constexpr int LDS_BYTES = 147456;

struct Params {
    const float *x, *c, *ctx, *c_ctx, *w_mod, *b_mod, *norm_g, *mlp_w1, *mlp_w2;
    const float *s5_lre, *s5_lim, *s5_ldt, *s5_bre, *s5_bim, *s5_cre, *s5_cim, *s5_d, *s5_wglu;
    const float *wqkv, *qn, *kn, *dlam, *subln, *wo, *fw, *fb;
    float* out; unsigned char* ws;
    int ph_lo, ph_hi;
};

namespace pg8 {
constexpr int BM = 256, BK = 64, HALF = 128, HTB = HALF * BK * 2, STAGE_BYTES = 8 * HTB, NXCD = 8, WGM = 8;
__host__ __device__ __forceinline__ int lds_byte(int r, int c) { const int st = (r >> 4) * 2 + (c >> 5), rr = r & 15, cc = c & 31, ob = rr * 64 + cc * 2; return st * 1024 + (ob ^ (((ob >> 9) & 1) << 5)); }
__host__ __device__ __forceinline__ void stage_rc(int b, int& R, int& C) { const int st = b / 1024, sb = b % 1024, swz = sb ^ (((sb >> 9) & 1) << 5); R = (st >> 1) * 16 + swz / 64; C = (st & 1) * 32 + (swz % 64) / 2; }
__host__ __device__ __forceinline__ int perm32(int rho) { const int n = rho >> 4, i = rho & 15; return 8 * (i >> 2) + 4 * n + (i & 3); }

struct Unit { int pm, pn, pb; };
struct Gemm { const bf16_t* A; const bf16_t* Bt; int lda, ldb, K; size_t batchA, batchB; };
struct Sched {
    int nM, nN, nwg, G, c;
    int pm0;
    __device__ __forceinline__ void init(int nM_, int nN_, int nB_, int pm0_ = 0, int coff = 0) { nM = nM_; nN = nN_; nwg = nM_ * nN_ * nB_; G = gridDim.x; c = (blockIdx.x + coff) % gridDim.x; pm0 = pm0_; }
    __device__ __forceinline__ bool next(int i, Unit& u) const {
        const long L = (long)i * G + c; if (L >= nwg) return false;
        int wgid = (int)L; { const int q = nwg / NXCD, r = nwg % NXCD, xcd = wgid % NXCD, off = wgid / NXCD; wgid = (xcd < r ? xcd * (q + 1) : r * (q + 1) + (xcd - r) * q) + off; }
        const int upb = nM * nN; u.pb = wgid / upb; const int w = wgid - u.pb * upb;
        const int nig = WGM * nN, gid = w / nig, fm = gid * WGM, gsz = (nM - fm) < WGM ? (nM - fm) : WGM;
        u.pm = pm0 + fm + ((w % nig) % gsz); u.pn = (w % nig) / gsz; return true;
    }
};

template <class Epi>
__device__ __forceinline__ void gemm_phase(LAS unsigned char* lds, const Gemm g, const Sched& S, const Epi& E, int wave0) {
    const int tid = fresh_tid(wave0), wid = __builtin_amdgcn_readfirstlane(tid >> 6), lane = tid & 63, wr = wid >> 2, wc = wid & 3, fr = lane & 15, fq = lane >> 4;
    const int nt = g.K / BK;
    unsigned voffA[2], voffB[2];
#pragma unroll
    for (int i = 0; i < 2; ++i) { int R, C; stage_rc(tid * 16 + i * 8192, R, C); const int Rb = Epi::PERM ? ((R & ~31) + perm32(R & 31)) : R;
        voffA[i] = (unsigned)(R * g.lda + C) * 2u; voffB[i] = (unsigned)(Rb * g.ldb + C) * 2u; }
    const size_t kstep = (size_t)(BK * 2);
    const size_t hstepA = (size_t)HALF * g.lda * 2, hstepB = (size_t)HALF * g.ldb * 2;
    const unsigned ldsw = (unsigned)wid * 1024u;
    const int aoff = lds_byte(wr * 64 + fr, fq * 8), boff = lds_byte(wc * 32 + fr, fq * 8);
#define PG8_APTR(u) ((const char*)(g.A + (size_t)(u).pb * g.batchA + (size_t)(u).pm * BM * g.lda))
#define PG8_BPTR(u) ((const char*)(g.Bt + (size_t)(u).pb * g.batchB + (size_t)(u).pn * BM * g.ldb))
#define PG8_SA(b, h) (((b) * 2 + (h)) * HTB)
#define PG8_SB(b, h) ((4 + (b) * 2 + (h)) * HTB)
#define PG8_STAGE(bufoff, gbase, voff) do { const char* gb_ = (const char*)(gbase); asm volatile("" : "+s"(gb_)); _Pragma("unroll") for (int _i = 0; _i < 2; ++_i) \
        __builtin_amdgcn_global_load_lds((const unsigned*)(gb_ + (voff)[_i]), (LAS unsigned*)(lds + (bufoff) + ldsw + _i * 8192), 16, 0, 0); } while (0)
#define PG8_LDA(dst, b, h) do { _Pragma("unroll") for (int m = 0; m < 4; ++m) _Pragma("unroll") for (int k = 0; k < 2; ++k) dst[m][k] = *(const LAS bf16x8*)(lds + PG8_SA(b, h) + aoff + m * 2048 + k * 1024); } while (0)
#define PG8_LDB(dst, b, h) do { _Pragma("unroll") for (int n = 0; n < 2; ++n) _Pragma("unroll") for (int k = 0; k < 2; ++k) dst[n][k] = *(const LAS bf16x8*)(lds + PG8_SB(b, h) + boff + n * 2048 + k * 1024); } while (0)
#define PG8_MMA(ai, bj, At, Bt) do { __builtin_amdgcn_s_setprio(1); _Pragma("unroll") for (int m = 0; m < 4; ++m) _Pragma("unroll") for (int n = 0; n < 2; ++n) _Pragma("unroll") for (int k = 0; k < 2; ++k) \
        acc[ai][bj][m][n] = __builtin_amdgcn_mfma_f32_16x16x32_bf16(Bt[n][k], At[m][k], acc[ai][bj][m][n], 0, 0, 0); __builtin_amdgcn_s_setprio(0); } while (0)
#define PG8_WAIT_V(n) asm volatile("s_waitcnt vmcnt(" #n ")" ::: "memory")
#define PG8_WAIT_L(n) asm volatile("s_waitcnt lgkmcnt(" #n ")" ::: "memory")
#define PG8_BAR __builtin_amdgcn_s_barrier()
#define PG8_SCHED __builtin_amdgcn_sched_barrier(0)
    Unit cur, nxt; int ui = 0;
    if (!S.next(0, cur)) return;
    f32x4 acc[2][2][4][2];
#pragma unroll
    for (int a = 0; a < 2; ++a)
#pragma unroll
        for (int b = 0; b < 2; ++b)
#pragma unroll
            for (int m = 0; m < 4; ++m)
#pragma unroll
                for (int n = 0; n < 2; ++n) acc[a][b][m][n] = (f32x4){0.f, 0.f, 0.f, 0.f};
    bf16x8 At[4][2], B0[2][2], B1[2][2];
    const char* cA = PG8_APTR(cur); const char* cB = PG8_BPTR(cur);
    PG8_STAGE(PG8_SB(0, 0), cB, voffB); PG8_STAGE(PG8_SB(0, 1), cB + hstepB, voffB); PG8_STAGE(PG8_SA(0, 0), cA, voffA); PG8_STAGE(PG8_SA(0, 1), cA + hstepA, voffA);
    if (wr == 1) PG8_BAR;
    PG8_WAIT_V(2); PG8_BAR;
    PG8_STAGE(PG8_SB(1, 0), cB + kstep, voffB); PG8_STAGE(PG8_SA(1, 0), cA + kstep, voffA); PG8_STAGE(PG8_SB(1, 1), cB + hstepB + kstep, voffB);
    PG8_WAIT_V(6); PG8_BAR;
    for (;;) {
        const bool has_next = S.next(ui + 1, nxt);
        const char* nA = has_next ? PG8_APTR(nxt) : cA; const char* nB = has_next ? PG8_BPTR(nxt) : cB;
        for (int t = 0; t < nt; t += 2) {
            const bool last = (t == nt - 2);
            const char* a1 = cA + (size_t)(t + 1) * kstep;
            const char* a2 = last ? nA : cA + (size_t)(t + 2) * kstep; const char* b2 = last ? nB : cB + (size_t)(t + 2) * kstep;
            const char* a3 = a2 + kstep; const char* b3 = b2 + kstep;
            PG8_LDB(B0, 0, 0); PG8_LDB(B1, 0, 1); PG8_SCHED; PG8_LDA(At, 0, 0); PG8_STAGE(PG8_SA(1, 1), a1 + hstepA, voffA);
            PG8_WAIT_V(8); PG8_WAIT_L(0); PG8_BAR; PG8_MMA(0, 0, At, B0); PG8_MMA(0, 1, At, B1); PG8_BAR; PG8_SCHED;
            PG8_LDA(At, 0, 1); PG8_STAGE(PG8_SB(0, 0), b2, voffB); PG8_STAGE(PG8_SB(0, 1), b2 + hstepB, voffB); PG8_STAGE(PG8_SA(0, 0), a2, voffA);
            PG8_WAIT_V(8); PG8_WAIT_L(0); PG8_BAR; PG8_MMA(1, 0, At, B0); PG8_MMA(1, 1, At, B1); PG8_BAR; PG8_SCHED;
            PG8_LDB(B0, 1, 0); PG8_LDB(B1, 1, 1); PG8_SCHED; PG8_LDA(At, 1, 0); PG8_STAGE(PG8_SA(0, 1), a2 + hstepA, voffA);
            PG8_WAIT_V(8); PG8_WAIT_L(0); PG8_BAR; PG8_MMA(0, 0, At, B0); PG8_MMA(0, 1, At, B1); PG8_BAR; PG8_SCHED;
            PG8_LDA(At, 1, 1); PG8_STAGE(PG8_SB(1, 0), b3, voffB); PG8_STAGE(PG8_SB(1, 1), b3 + hstepB, voffB); PG8_STAGE(PG8_SA(1, 0), a3, voffA);
            PG8_WAIT_V(8); PG8_WAIT_L(0); PG8_BAR; PG8_MMA(1, 0, At, B0); PG8_MMA(1, 1, At, B1); PG8_BAR; PG8_SCHED;
        }
        if (wr == 0) PG8_BAR;
        { int l2_; asm volatile("v_mbcnt_lo_u32_b32 %0, -1, 0\n\tv_mbcnt_hi_u32_b32 %0, -1, %0" : "=v"(l2_)); E(acc, cur, wr, wc, l2_ & 15, l2_ >> 4); }
        if (!has_next) break;
#pragma unroll
        for (int a = 0; a < 2; ++a)
#pragma unroll
            for (int b = 0; b < 2; ++b)
#pragma unroll
                for (int m = 0; m < 4; ++m)
#pragma unroll
                    for (int n = 0; n < 2; ++n) acc[a][b][m][n] = (f32x4){0.f, 0.f, 0.f, 0.f};
        cur = nxt; cA = nA; cB = nB; ++ui;
        if (wr == 1) PG8_BAR;
    }
    PG8_WAIT_V(0);
    PG8_BAR;
#undef PG8_APTR
#undef PG8_BPTR
#undef PG8_SA
#undef PG8_SB
#undef PG8_STAGE
#undef PG8_LDA
#undef PG8_LDB
#undef PG8_MMA
#undef PG8_WAIT_V
#undef PG8_WAIT_L
#undef PG8_BAR
#undef PG8_SCHED
}

typedef f32x4 Acc[2][2][4][2];

template <int ACT  > struct EpiStore {
    static constexpr bool PERM = true;
    bf16_t* O; size_t ldc, bstride;
    __device__ __forceinline__ void operator()(const Acc& acc, const Unit& u, int wr, int wc, int fr, int fq) const {
        LAUNDER_V(fr); LAUNDER_V(fq);
        const int row0 = u.pm * BM + wr * 64 + fr, col0 = u.pn * BM + wc * 32 + 8 * fq;
        bf16_t* base = O + (size_t)u.pb * bstride;
#pragma unroll
        for (int ai = 0; ai < 2; ++ai)
#pragma unroll
            for (int m = 0; m < 4; ++m) { bf16_t* rowp = base + (size_t)(row0 + ai * HALF + m * 16) * ldc + col0;
#pragma unroll
                for (int bj = 0; bj < 2; ++bj) { f32x4 v0 = acc[ai][bj][m][0], v1 = acc[ai][bj][m][1];
                    if (ACT == 1) {
#pragma unroll
                        for (int e = 0; e < 4; ++e) { float a = fmaxf(v0[e], 0.f), b = fmaxf(v1[e], 0.f); v0[e] = a * a; v1[e] = b * b; } }
                    u32x4 w; w.x = pk2(v0[0], v0[1]); w.y = pk2(v0[2], v0[3]); w.z = pk2(v1[0], v1[1]); w.w = pk2(v1[2], v1[3]);
                    *(u32x4*)(rowp + bj * HALF) = w; } }
    }
};

struct EpiResid {
    static constexpr bool PERM = false;
    const float* base_lat; const float* base_ctx; float* out_lat; float* out_ctx; const float* gate; const float* bias;
    __device__ __forceinline__ void operator()(const Acc& acc, const Unit& u, int wr, int wc, int fr, int fq) const {
        LAUNDER_V(fr); LAUNDER_V(fq);
        const float* bp; float* op; int rbase, mi;
        if (u.pm < 128) { bp = base_lat; op = out_lat; rbase = u.pm * BM; mi = u.pm >> 4; } else { bp = base_ctx; op = out_ctx; rbase = (u.pm - 128) * BM; mi = 8; }
        const int col0 = u.pn * BM + wc * 32 + 4 * fq;
        f32x4 gv[2][2], bv[2][2];
#pragma unroll
        for (int bj = 0; bj < 2; ++bj)
#pragma unroll
            for (int n = 0; n < 2; ++n) { gv[bj][n] = *(const f32x4*)(gate + mi * (NMOD * D) + col0 + bj * HALF + n * 16);
                bv[bj][n] = bias ? *(const f32x4*)(bias + col0 + bj * HALF + n * 16) : (f32x4){0.f, 0.f, 0.f, 0.f}; }
#pragma unroll
        for (int ai = 0; ai < 2; ++ai)
#pragma unroll
            for (int m = 0; m < 4; ++m) { const size_t off = (size_t)(rbase + ai * HALF + wr * 64 + m * 16 + fr) * D + col0;
#pragma unroll
                for (int bj = 0; bj < 2; ++bj)
#pragma unroll
                    for (int n = 0; n < 2; ++n) { const f32x4 xv = *(const f32x4*)(bp + off + bj * HALF + n * 16);
                        *(f32x4*)(op + off + bj * HALF + n * 16) = xv + gv[bj][n] * (acc[ai][bj][m][n] + bv[bj][n]); } }
    }
};

struct EpiQK {
    static constexpr bool PERM = false;
    bf16_t* QKo; const float* qn; const float* kn;
    __device__ __forceinline__ void operator()(const Acc& acc, const Unit& u, int wr, int wc, int fr, int fq) const {
        LAUNDER_V(fr); LAUNDER_V(fq);
        const int lane = fq * 16 + fr, hc = u.pn * 4 + wc; const bool isq = hc < 16;
        const float* nwp = (isq ? qn : kn) + 4 * fq;
        f32x4 nw[2][2];
#pragma unroll
        for (int bj = 0; bj < 2; ++bj)
#pragma unroll
            for (int n = 0; n < 2; ++n) nw[bj][n] = *(const f32x4*)(nwp + 32 * bj + 16 * n);
        float invf[4];
#pragma unroll
        for (int i = 0; i < 4; ++i) invf[i] = __builtin_amdgcn_exp2f(-(float)(4 * fq + i) * 0.8304820237218406f) * 0.15915494309189535f;
        const float qs = isq ? QSCALE : 1.f;
#pragma unroll
        for (int ai = 0; ai < 2; ++ai)
#pragma unroll
            for (int m = 0; m < 4; ++m) { const int row = u.pm * BM + ai * HALF + wr * 64 + m * 16 + fr;
                float ss = 0.f;
#pragma unroll
                for (int bj = 0; bj < 2; ++bj)
#pragma unroll
                    for (int n = 0; n < 2; ++n) { const f32x4 a = acc[ai][bj][m][n]; ss += (a[0] * a[0] + a[1] * a[1]) + (a[2] * a[2] + a[3] * a[3]); }
                ss += shx(ss, lane, 16); ss += shx(ss, lane, 32);
                const float rstd = rsqrtf(ss * (1.f / 64.f) + EPS) ;
                const int l = row & 4095; const float posr = (float)(l >> 6), posc = (float)(l & 63);
                bf16_t* op = QKo + (size_t)row * 2048 + hc * 64 + 4 * fq;
#pragma unroll
                for (int bj = 0; bj < 2; ++bj) { f32x4 x1 = acc[ai][bj][m][0] * rstd * nw[bj][0], x2 = acc[ai][bj][m][1] * rstd * nw[bj][1];
                    if (row < TL) { const float pos = bj ? posc : posr;
#pragma unroll
                        for (int i = 0; i < 4; ++i) { const float rev = pos * invf[i]; const float cs = __builtin_amdgcn_cosf(rev), sn = __builtin_amdgcn_sinf(rev);
                            const float a = x1[i], b = x2[i]; x1[i] = a * cs - b * sn; x2[i] = a * sn + b * cs; } }
                    x1 *= qs; x2 *= qs;
                    *(u32x2*)(op + 32 * bj) = (u32x2){pk2(x1[0], x1[1]), pk2(x1[2], x1[3])};
                    *(u32x2*)(op + 32 * bj + 16) = (u32x2){pk2(x2[0], x2[1]), pk2(x2[2], x2[3])}; } }
    }
};

struct EpiPart {
    static constexpr bool PERM = false;
    float* P;
    __device__ __forceinline__ void operator()(const Acc& acc, const Unit& u, int wr, int wc, int fr, int fq) const {
        LAUNDER_V(fr); LAUNDER_V(fq);
        const int col0 = u.pn * BM + wc * 32 + 4 * fq;
#pragma unroll
        for (int ai = 0; ai < 2; ++ai)
#pragma unroll
            for (int m = 0; m < 4; ++m) { float* rp = P + ((size_t)u.pb * TC + (u.pm - 128) * BM + ai * HALF + wr * 64 + m * 16 + fr) * D + col0;
#pragma unroll
                for (int bj = 0; bj < 2; ++bj)
#pragma unroll
                    for (int n = 0; n < 2; ++n) *(f32x4*)(rp + bj * HALF + n * 16) = acc[ai][bj][m][n]; }
    }
};

struct EpiGlu {
    static constexpr bool PERM = false;
    const float* base_lat; const float* base_ctx; float* out_lat; float* out_ctx; const float* gate;
    __device__ __forceinline__ void operator()(const Acc& acc, const Unit& u, int wr, int wc, int fr, int fq) const {
        LAUNDER_V(fr); LAUNDER_V(fq);
        const float* bp; float* op; int rbase, mi;
        if (u.pm < 128) { bp = base_lat; op = out_lat; rbase = u.pm * BM; mi = u.pm >> 4; } else { bp = base_ctx; op = out_ctx; rbase = (u.pm - 128) * BM; mi = 8; }
        const int col0 = u.pn * HALF + wc * 32 + 4 * fq;
        f32x4 gv[2];
#pragma unroll
        for (int n = 0; n < 2; ++n) gv[n] = *(const f32x4*)(gate + mi * (NMOD * D) + col0 + n * 16);
#pragma unroll
        for (int ai = 0; ai < 2; ++ai)
#pragma unroll
            for (int m = 0; m < 4; ++m) { const size_t off = (size_t)(rbase + ai * HALF + wr * 64 + m * 16 + fr) * D + col0;
#pragma unroll
                for (int n = 0; n < 2; ++n) { const f32x4 xv = *(const f32x4*)(bp + off + n * 16); const f32x4 v = acc[ai][0][m][n], gt = acc[ai][1][m][n]; f32x4 o;
#pragma unroll
                    for (int e = 0; e < 4; ++e) o[e] = xv[e] + gv[n][e] * v[e] * sigmoidf_(gt[e]);
                    *(f32x4*)(op + off + n * 16) = o; } }
    }
};

struct EpiSloc {
    static constexpr bool PERM = false;
    float* S;
    __device__ __forceinline__ void operator()(const Acc& acc, const Unit& u, int wr, int wc, int fr, int fq) const {
        LAUNDER_V(fr); LAUNDER_V(fq);
        const int col0 = wc * 32 + 4 * fq;
#pragma unroll
        for (int ai = 0; ai < 2; ++ai)
#pragma unroll
            for (int m = 0; m < 4; ++m) { const int ci = u.pm * BM + ai * HALF + wr * 64 + m * 16 + fr;
                if (ci < NCH) { float* rp = S + ((size_t)u.pb * NCH + ci) * 256 + col0;
#pragma unroll
                    for (int bj = 0; bj < 2; ++bj)
#pragma unroll
                        for (int n = 0; n < 2; ++n) *(f32x4*)(rp + bj * HALF + n * 16) = acc[ai][bj][m][n]; } }
    }
};

struct EpiZ {
    static constexpr bool PERM = false;
    bf16_t* Z;
    __device__ __forceinline__ void operator()(const Acc& acc, const Unit& u, int wr, int wc, int fr, int fq) const {
        LAUNDER_V(fr); LAUNDER_V(fq);
#pragma unroll
        for (int ai = 0; ai < 2; ++ai)
#pragma unroll
            for (int m = 0; m < 4; ++m) { const int ci = u.pm * BM + ai * HALF + wr * 64 + m * 16 + fr;
                if (ci < NCH) { const int b = ci / 136, cc = ci - b * 136; const int tok0 = cc < 8 ? TL + b * 256 + cc * 32 : b * 4096 + (cc - 8) * 32;
#pragma unroll
                    for (int bj = 0; bj < 2; ++bj)
#pragma unroll
                        for (int n = 0; n < 2; ++n) { const int t = 16 * u.pn + 8 * bj + 2 * wc + n; const f32x4 v = acc[ai][bj][m][n];
                            u32x2 w; w.x = pk2(gelu_tanh(v[0]), gelu_tanh(v[1])); w.y = pk2(gelu_tanh(v[2]), gelu_tanh(v[3]));
                            *(u32x2*)(Z + (size_t)(tok0 + t) * D + u.pb * 16 + 4 * fq) = w; } } }
    }
};

struct EpiChanDft {
    static constexpr bool PERM = true;
    bf16_t* PQ1; bf16_t* PQC;
    __device__ __forceinline__ void operator()(const Acc& acc, const Unit& u, int wr, int wc, int fr, int fq) const {
        LAUNDER_V(fr); LAUNDER_V(fq);
        if (u.pn < 128) {
            const int b = u.pn >> 4;
#pragma unroll
            for (int ai = 0; ai < 2; ++ai)
#pragma unroll
                for (int m = 0; m < 4; ++m) { const int kc = ai * HALF + wr * 64 + m * 16 + fr;
                    bf16_t* rowp = PQ1 + (size_t)(b * 1024 + u.pb * 256 + kc) * 8192 + u.pm * 64;
#pragma unroll
                    for (int bj = 0; bj < 2; ++bj) { const int tp = (u.pn & 15) * 256 + bj * HALF + wc * 32 + 8 * fq;
                        const f32x4 v0 = acc[ai][bj][m][0], v1 = acc[ai][bj][m][1];
                        u32x4 w; w.x = pk2(v0[0], v0[1]); w.y = pk2(v0[2], v0[3]); w.z = pk2(v1[0], v1[1]); w.w = pk2(v1[2], v1[3]);
                        *(u32x4*)(rowp + (tp >> 6) * 128 + (tp & 63)) = w; } }
        } else {
            const int b = u.pn - 128;
            bf16_t* base = PQC + (size_t)(b * 1024 + u.pb * 256) * 512 + (size_t)u.pm * 256 + wc * 32 + 8 * fq;
#pragma unroll
            for (int ai = 0; ai < 2; ++ai)
#pragma unroll
                for (int m = 0; m < 4; ++m) { bf16_t* rowp = base + (size_t)(ai * HALF + wr * 64 + m * 16 + fr) * 512;
#pragma unroll
                    for (int bj = 0; bj < 2; ++bj) { const f32x4 v0 = acc[ai][bj][m][0], v1 = acc[ai][bj][m][1];
                        u32x4 w; w.x = pk2(v0[0], v0[1]); w.y = pk2(v0[2], v0[3]); w.z = pk2(v1[0], v1[1]); w.w = pk2(v1[2], v1[3]);
                        *(u32x4*)(rowp + bj * HALF) = w; } }
        }
    }
};

struct EpiFft1 {
    static constexpr bool PERM = true;
    bf16_t* B2;
    __device__ __forceinline__ void operator()(const Acc& acc, const Unit& u, int wr, int wc, int fr, int fq) const {
        LAUNDER_V(fr); LAUNDER_V(fq);
        if (wr != 0) return;
#pragma unroll
        for (int m = 0; m < 4; ++m) { const int m2 = 16 * m + fr;
#pragma unroll
            for (int bj = 0; bj < 2; ++bj) { const int n0 = u.pn * BM + bj * HALF + wc * 32 + 8 * fq; const int k2 = n0 & 63, c = (n0 >> 6) & 1023, b = n0 >> 16;
                float br[8], bi[8];
#pragma unroll
                for (int e = 0; e < 8; ++e) { const float ar = acc[0][bj][m][e >> 2][e & 3], ai_ = acc[1][bj][m][e >> 2][e & 3];
                    const float rev = (float)(m2 * (k2 + e)) * (1.f / 4096.f); const float cs = __builtin_amdgcn_cosf(rev), sn = __builtin_amdgcn_sinf(rev);
                    br[e] = (ar * cs + ai_ * sn) * (1.f / 64.f); bi[e] = (ai_ * cs - ar * sn) * (1.f / 64.f); }
                bf16_t* op = B2 + ((size_t)(b * 64 + m2) * 1024 + c) * 128 + k2;
                *(u32x4*)(op) = (u32x4){pk2(br[0], br[1]), pk2(br[2], br[3]), pk2(br[4], br[5]), pk2(br[6], br[7])};
                *(u32x4*)(op + 64) = (u32x4){pk2(bi[0], bi[1]), pk2(bi[2], bi[3]), pk2(bi[4], bi[5]), pk2(bi[6], bi[7])}; } }
    }
};

struct EpiFft2 {
    static constexpr bool PERM = true;
    bf16_t* F;
    __device__ __forceinline__ void operator()(const Acc& acc, const Unit& u, int wr, int wc, int fr, int fq) const {
        LAUNDER_V(fr); LAUNDER_V(fq);
        if (wr != 0) return;
#pragma unroll
        for (int m = 0; m < 4; ++m) { const int m1 = 16 * m + fr;
#pragma unroll
            for (int bj = 0; bj < 2; ++bj) { const int n0 = u.pn * BM + bj * HALF + wc * 32 + 8 * fq; const int c = n0 & 1023, m2 = (n0 >> 10) & 63, b = n0 >> 16;
                const f32x4 v0 = acc[0][bj][m][0], v1 = acc[0][bj][m][1];
                *(u32x4*)(F + (size_t)(b * 4096 + 64 * m1 + m2) * D + c) = (u32x4){pk2(v0[0], v0[1]), pk2(v0[2], v0[3]), pk2(v1[0], v1[1]), pk2(v1[2], v1[3])}; } }
    }
};
}

__device__ __forceinline__ void transpose_item(const float* W, int K, int N, bf16_t* WT, int glu, LAS float* scr, int item, int lane) {
    const int nblk = N / 32, kb = item / nblk, nb = item % nblk, k0 = 64 * kb, n0 = 32 * nb;
#pragma unroll 8
    for (int i = 0; i < 32; ++i) { const int kk = 2 * i + (lane >> 5); scr[kk * 33 + (lane & 31)] = W[(size_t)(k0 + kk) * N + n0 + (lane & 31)]; }
    asm volatile("s_waitcnt lgkmcnt(0)" ::: "memory");
    const int n0p = glu == 1 ? (((n0 & 1023) >> 7) * 256 + (n0 >> 10) * 128 + (n0 & 127))
                  : (glu == 2 && n0 < 2048) ? ((n0 & ~255) | (((n0 >> 5) & 1) << 7) | (((n0 >> 6) & 3) << 5)) : n0;
    const int c = lane & 7;
#pragma unroll
    for (int j = 0; j < 4; ++j) { const int n = (lane >> 3) + 8 * j; const LAS float* s = scr + (8 * c) * 33 + n;
        u32x4 o; o.x = pk2(s[0 * 33], s[1 * 33]); o.y = pk2(s[2 * 33], s[3 * 33]); o.z = pk2(s[4 * 33], s[5 * 33]); o.w = pk2(s[6 * 33], s[7 * 33]);
        *(u32x4*)(WT + (size_t)(n0p + n) * K + k0 + 8 * c) = o; }
    asm volatile("s_waitcnt lgkmcnt(0)" ::: "memory");
}

__device__ __forceinline__ const float* xrow_ptr(const float* xl, const float* xc, int row) { return row < TL ? xl + (size_t)row * D : xc + (size_t)(row - TL) * D; }

struct CtxFix { const float* part; const float* pgate; const float* pbias; float* xw; };
__device__ __forceinline__ void norm_rows_tok(const float* xl, const float* xc, const float* g, const float* modl  , int sidx, bf16_t* out, int nrows, int gw, int ngw, int lane, bool perm64, const CtxFix fx) {
    const int nlat = nrows < TL ? nrows : TL, per = (nlat + ngw - 1) / ngw, nctx = nrows > TL ? (nrows - TL + ngw - 1) / ngw : 0;
    const float* fpart = fx.part; int hasfix = __builtin_amdgcn_readfirstlane(fx.part != nullptr ? 1 : 0); asm volatile("" : "+s"(hasfix)); int pf64 = __builtin_amdgcn_readfirstlane(perm64 ? 1 : 0); asm volatile("" : "+s"(pf64));
    f32x4 gsv[4], shv[4]; int cur = -1;
    for (int it = 0; it < per + nctx; ++it) {
        const int row = it < per ? gw * per + it : TL + gw + (it - per) * ngw;
        if (it < per ? row >= nlat : row >= nrows) continue;
        const f32x4* xr = (const f32x4*)xrow_ptr(xl, xc, row) + lane;
        f32x4 v[4]; float ss = 0.f;
#pragma unroll
        for (int j = 0; j < 4; ++j) v[j] = xr[64 * j];
        const int mi = row < TL ? row >> 12 : 8;
        if (mi != cur) { cur = mi; const float* sh = modl + mi * (NMOD * D) + sidx * D; const float* sc = sh + D;
#pragma unroll
            for (int j = 0; j < 4; ++j) { const int c = 4 * lane + 256 * j; const f32x4 gg = *(const f32x4*)(g + c), s1 = *(const f32x4*)(sc + c); shv[j] = *(const f32x4*)(sh + c); gsv[j] = gg * (1.f + s1); } }
        if (hasfix && row >= TL) {
#pragma unroll
            for (int j = 0; j < 4; ++j) { const int c = 4 * lane + 256 * j; f32x4 s = fx.pbias ? *(const f32x4*)(fx.pbias + c) : (f32x4){0.f, 0.f, 0.f, 0.f};
#pragma unroll
                for (int k = 0; k < KSPLIT; ++k) s += *(const f32x4*)(fpart + ((size_t)k * TC + (row - TL)) * D + c);
                v[j] += *(const f32x4*)(fx.pgate + c) * s;
                *(f32x4*)(fx.xw + (size_t)(row - TL) * D + c) = v[j]; } }
#pragma unroll
        for (int j = 0; j < 4; ++j) ss += (v[j].x * v[j].x + v[j].y * v[j].y) + (v[j].z * v[j].z + v[j].w * v[j].w);
        const float rstd = rsqrtf(wave_sum(ss, lane) * (1.f / D) + EPS);
        const int orow = (pf64 && row < TL) ? ((row & ~4095) | ((row & 63) << 6) | ((row & 4095) >> 6)) : row;
        unsigned long long* o8 = (unsigned long long*)(out + (size_t)orow * D) + lane;
#pragma unroll
        for (int j = 0; j < 4; ++j) { const f32x4 y = v[j] * rstd * gsv[j] + shv[j];
            o8[64 * j] = (unsigned long long)pk2(y[0], y[1]) | ((unsigned long long)pk2(y[2], y[3]) << 32); }
    }
}
__device__ __forceinline__ void norm_rows_s5(const float* xl, const float* xc, const float* g, const float* modl, bf16_t* ug, int gw, int ngw, int lane, const CtxFix fx) {
    const int per = (TL + ngw - 1) / ngw, nctx = (TC + ngw - 1) / ngw;
    const float* fpart = fx.part; int hasfix = __builtin_amdgcn_readfirstlane(fx.part != nullptr ? 1 : 0); asm volatile("" : "+s"(hasfix));
    f32x4 gsv[4], shv[4]; int cur = -1;
    for (int it = 0; it < per + nctx; ++it) {
        const int row = it < per ? gw * per + it : TL + gw + (it - per) * ngw;
        if (it < per ? row >= TL : row >= TA) continue;
        const f32x4* xr = (const f32x4*)xrow_ptr(xl, xc, row) + 4 * lane;
        f32x4 v[4]; float ss = 0.f;
#pragma unroll
        for (int j = 0; j < 4; ++j) v[j] = xr[j];
        int mi, b, pos; if (row < TL) { b = row >> 12; pos = 256 + (row & 4095); mi = b; } else { b = (row - TL) >> 8; pos = (row - TL) & 255; mi = 8; }
        if (mi != cur) { cur = mi; const float* sh = modl + mi * (NMOD * D); const float* sc = sh + D;
#pragma unroll
            for (int j = 0; j < 4; ++j) { const int c = 16 * lane + 4 * j; const f32x4 gg = *(const f32x4*)(g + c), s1 = *(const f32x4*)(sc + c); shv[j] = *(const f32x4*)(sh + c); gsv[j] = gg * (1.f + s1); } }
        if (hasfix && row >= TL) {
#pragma unroll
            for (int j = 0; j < 4; ++j) { const int c = 16 * lane + 4 * j; f32x4 s = fx.pbias ? *(const f32x4*)(fx.pbias + c) : (f32x4){0.f, 0.f, 0.f, 0.f};
#pragma unroll
                for (int k = 0; k < KSPLIT; ++k) s += *(const f32x4*)(fpart + ((size_t)k * TC + (row - TL)) * D + c);
                v[j] += *(const f32x4*)(fx.pgate + c) * s;
                *(f32x4*)(fx.xw + (size_t)(row - TL) * D + c) = v[j]; } }
#pragma unroll
        for (int j = 0; j < 4; ++j) ss += (v[j].x * v[j].x + v[j].y * v[j].y) + (v[j].z * v[j].z + v[j].w * v[j].w);
        const float rstd = rsqrtf(wave_sum(ss, lane) * (1.f / D) + EPS);
        const int chunk = b * 136 + (pos >> 5), s = pos & 31;
        unsigned w[8];
#pragma unroll
        for (int j = 0; j < 4; ++j) { const f32x4 y = v[j] * rstd * gsv[j] + shv[j]; w[2 * j] = pk2(y[0], y[1]); w[2 * j + 1] = pk2(y[2], y[3]); }
        u32x4* op = (u32x4*)(ug + ((size_t)lane * NCH + chunk) * UGP + s * 16);
        op[0] = (u32x4){w[0], w[1], w[2], w[3]}; op[1] = (u32x4){w[4], w[5], w[6], w[7]};
    }
}

__device__ __forceinline__ void cpow(float lr_dt, float li_dt, float k, float& re, float& im) {
    const float mag = __expf(k * lr_dt); const float rev = k * li_dt * 0.15915494309189535f;
    re = mag * __builtin_amdgcn_cosf(rev); im = mag * __builtin_amdgcn_sinf(rev);
}
__device__ __forceinline__ void s5_kcoef(float lr, float li, float dt, float& kr, float& ki) {
    const float th = li * dt; const float rv = th * 0.15915494309189535f;
    const float c = __builtin_amdgcn_cosf(rv), s = __builtin_amdgcn_sinf(rv), sh = __builtin_amdgcn_sinf(0.5f * rv);
    const float em1 = expm1f(lr * dt);
    const float nre = em1 * c - 2.f * sh * sh, nim = (em1 + 1.f) * s;
    const float den = lr * lr + li * li;
    kr = (nre * lr + nim * li) / den; ki = (nim * lr - nre * li) / den;
}


#define XB_TMO      128
#define XB_XCNT(j)  (256  + 64 * (j))
#define XB_XSUB(j)  (1280 + 64 * (j))
#define XB_XGEN(j)  (2304 + 64 * (j))
#define XB_TOP      3328
#define XB_TOPGEN   3392
#define XCD_BAR_WORDS 3456
#define XB_SPIN_CAP (1u << 18)
__device__ __forceinline__ unsigned xb_ld(unsigned* p)              { return __hip_atomic_load(p, __ATOMIC_RELAXED, __HIP_MEMORY_SCOPE_AGENT); }
__device__ __forceinline__ unsigned xb_add(unsigned* p, unsigned v) { return __hip_atomic_fetch_add(p, v, __ATOMIC_RELAXED, __HIP_MEMORY_SCOPE_AGENT); }
__device__ __forceinline__ unsigned xb_xcc_id() { return (unsigned)__builtin_amdgcn_s_getreg((3 << 11) | 20) & 0xFu; }
#define XB_SPIN(cond, bar) do { unsigned _sp = 0; while (cond) { __builtin_amdgcn_s_sleep(1); \
    if ((++_sp & 255u) == 0u) { if (xb_ld(&(bar)[XB_TMO])) break; if (_sp > XB_SPIN_CAP) { atomicAdd(&(bar)[XB_TMO], 1u); break; } } } } while (0)
struct XcdBarrier { unsigned* bar; unsigned x; volatile LAS unsigned* st; };
__device__ __forceinline__ XcdBarrier xcd_barrier_post(unsigned* bar, volatile LAS unsigned* st) {
    XcdBarrier b; b.bar = bar; b.x = xb_xcc_id(); b.st = st;
    if (threadIdx.x == 0) (void)xb_add(&bar[XB_XCNT(b.x)], 1u);
    return b;
}
__device__ __forceinline__ void xcd_barrier_complete(unsigned* bar, unsigned x, unsigned& nloc, unsigned& nx) {
    const unsigned G = gridDim.x * gridDim.y * gridDim.z;
    unsigned sum, cnt, mine, sp = 0u;
    for (;;) {
        sum = 0u; cnt = 0u; mine = 0u;
#pragma unroll
        for (unsigned j = 0; j < 16; ++j) { const unsigned c = xb_ld(&bar[XB_XCNT(j)]); sum += c; cnt += (c > 0u) ? 1u : 0u; mine = (j == x) ? c : mine; }
        if (sum == G) break;
        __builtin_amdgcn_s_sleep(1);
        if ((++sp & 255u) == 0u) { if (xb_ld(&bar[XB_TMO])) break; if (sp > XB_SPIN_CAP) { atomicAdd(&bar[XB_TMO], 1u); break; } }
    }
    nloc = mine > 0u ? mine : 1u; nx = cnt > 0u ? cnt : 1u;
}
__device__ __forceinline__ void xcd_barrier(const XcdBarrier& b) {
    asm volatile("s_waitcnt vmcnt(0)" ::: "memory");
    __syncthreads();
    if (threadIdx.x == 0) {
        unsigned* bar = b.bar;
        __builtin_amdgcn_s_waitcnt(0);
        unsigned nloc = b.st[0], nx = b.st[1];
        if (nloc == 0u) { xcd_barrier_complete(bar, b.x, nloc, nx); b.st[0] = nloc; b.st[1] = nx; }
        const unsigned old = xb_add(&bar[XB_XSUB(b.x)], 1u);
        const unsigned gen = old / nloc;
        if (old + 1u == (gen + 1u) * nloc) {
            __builtin_amdgcn_fence(__ATOMIC_RELEASE, "agent");
            asm volatile("s_waitcnt vmcnt(0)" ::: "memory");
            const unsigned og = xb_add(&bar[XB_TOP], 1u);
            const unsigned tg = og / nx;
            if (og + 1u == (tg + 1u) * nx) xb_add(&bar[XB_TOPGEN], 1u);
            else XB_SPIN(xb_ld(&bar[XB_TOPGEN]) == tg, bar);
            __builtin_amdgcn_fence(__ATOMIC_ACQUIRE, "agent");
            xb_add(&bar[XB_XGEN(b.x)], 1u);
            asm volatile("s_waitcnt vmcnt(0)" ::: "memory");
        } else {
            XB_SPIN(xb_ld(&bar[XB_XGEN(b.x)]) == gen, bar);
            __builtin_amdgcn_fence(__ATOMIC_ACQUIRE, "agent");
            asm volatile("s_waitcnt vmcnt(0)" ::: "memory");
        }
    }
    __syncthreads();
}

__global__ void __launch_bounds__(512) mega_fwd(Params p) {
    extern __shared__ __attribute__((aligned(16))) unsigned char lds_raw[];
    LAS unsigned char* lds = (LAS unsigned char*)lds_raw;
    cg::grid_group grid = cg::this_grid();
    const int G = gridDim.x, bid = blockIdx.x, NGW = G * 8;
    const int wave0 = __builtin_amdgcn_readfirstlane(threadIdx.x >> 6);
#define FRESH_IDS const int tid = fresh_tid(wave0), lane = tid & 63, wave = __builtin_amdgcn_readfirstlane(tid >> 6), gw = bid * 8 + wave; (void)lane; (void)gw
    unsigned char* ws = p.ws;
    bf16_t* W1T = (bf16_t*)(ws + WS_W1T); bf16_t* W2T = (bf16_t*)(ws + WS_W2T); bf16_t* GLUT = (bf16_t*)(ws + WS_GLUT);
    bf16_t* QKVT = (bf16_t*)(ws + WS_QKVT); bf16_t* WOT = (bf16_t*)(ws + WS_WOT); bf16_t* FWT = (bf16_t*)(ws + WS_FWT);
    float* MOD = (float*)(ws + WS_MOD); float* KTAB = (float*)(ws + WS_KTAB); float* XCTX = (float*)(ws + WS_XCTX);
    bf16_t* HN = (bf16_t*)(ws + WS_HN); bf16_t* HB = (bf16_t*)(ws + WS_H);
    int ph = 0;
#define PH_ON (ph >= p.ph_lo && ph < p.ph_hi)
    volatile LAS unsigned* bst = (volatile LAS unsigned*)(lds + LDS_BYTES - 64);
    if (threadIdx.x < 2) bst[threadIdx.x] = 0u;
    __syncthreads();
    const XcdBarrier xbar = xcd_barrier_post((unsigned*)(ws + WS_CTL), bst);
#define PH_END do { if (ph >= p.ph_lo && ph + 1 < p.ph_hi) { for (int r_ = 0; r_ < NREP(8); ++r_) { if (ph == 0) grid.sync(); else xcd_barrier(xbar); } } ++ph; } while (0)

    if (PH_ON) {
        FRESH_IDS;
        {
            LAS float* scr = (LAS float*)(lds + wave * 16384);
            constexpr int I_W1 = 16 * 128, I_W2 = 64 * 32, I_GLU = 16 * 64, I_QKV = 16 * 96, I_SQ = 16 * 32;
            constexpr int NIT = 4 * (I_W1 + I_W2) + 2 * I_GLU + I_QKV + 2 * I_SQ;
            for (int it = gw; it < NIT; it += NGW) {
                int r = it;
                if (r < 4 * I_W1) { const int l = r / I_W1; transpose_item(p.mlp_w1 + (size_t)l * D * DFF, D, DFF, W1T + (size_t)l * D * DFF, 0, scr, r % I_W1, lane); continue; } r -= 4 * I_W1;
                if (r < 4 * I_W2) { const int l = r / I_W2; transpose_item(p.mlp_w2 + (size_t)l * D * DFF, DFF, D, W2T + (size_t)l * D * DFF, 0, scr, r % I_W2, lane); continue; } r -= 4 * I_W2;
                if (r < 2 * I_GLU) { const int l = r / I_GLU; transpose_item(p.s5_wglu + (size_t)l * D * 2 * D, D, 2 * D, GLUT + (size_t)l * D * 2 * D, 1, scr, r % I_GLU, lane); continue; } r -= 2 * I_GLU;
                if (r < I_QKV) { transpose_item(p.wqkv, D, 3 * D, QKVT, 2, scr, r, lane); continue; } r -= I_QKV;
                if (r < I_SQ) { transpose_item(p.wo, D, D, WOT, 0, scr, r, lane); continue; } r -= I_SQ;
                transpose_item(p.fw, D, D, FWT, 0, scr, r, lane);
            }
        }
        if (REP_MASK) { for (int e = bid * 512 + tid; e < 9 * NMOD * D; e += G * 512) ((float*)(ws + WS_ZERO))[e] = 0.f; }
        __syncthreads();
        {
            LAS float* sc = (LAS float*)lds;
            LAS float* red = (LAS float*)(lds + 9 * 4096);
            for (int e = tid; e < 9 * D; e += 512) { const float v = e < 8 * D ? p.c[e] : p.c_ctx[e - 8 * D]; sc[e] = v * sigmoidf_(v); }
            __syncthreads();
            const int col = tid & 63, kp = tid >> 6;
            for (int item = bid; item < 4 * 96; item += G) {
                const int i = item / 96, nb = item % 96;
                float a[9];
#pragma unroll
                for (int r = 0; r < 9; ++r) a[r] = 0.f;
                const float* wp = p.w_mod + ((size_t)i * D + kp * 128) * (NMOD * D) + nb * 64 + col;
#pragma unroll 8
                for (int k = 0; k < 128; ++k) { const float w = wp[(size_t)k * (NMOD * D)];
#pragma unroll
                    for (int r = 0; r < 9; ++r) a[r] += sc[r * D + kp * 128 + k] * w; }
#pragma unroll
                for (int r = 0; r < 9; ++r) red[(kp * 64 + col) * 9 + r] = a[r];
                __syncthreads();
                for (int e = tid; e < 576; e += 512) { const int r = e >> 6, cc = e & 63; float s = p.b_mod[i * (NMOD * D) + nb * 64 + cc];
#pragma unroll
                    for (int q = 0; q < 8; ++q) s += red[(q * 64 + cc) * 9 + r];
                    MOD[((size_t)i * 9 + r) * (NMOD * D) + nb * 64 + cc] = s; }
                __syncthreads();
            }
        }
        {
            LAS float* Bb = (LAS float*)lds;
            LAS float* Cc = (LAS float*)(lds + 8192);
            LAS float* ap = (LAS float*)(lds + 16384);
            for (int item = bid; item < 256; item += G) {
                const int j = item >> 7, g = (item >> 1) & 63, dir = item & 1;
                const int pg = (j * 2 + dir) * 64 + g;
                const float dt = __expf(p.s5_ldt[pg]);
                __syncthreads();
                for (int e = tid; e < 1024; e += 512) { const int pp = e >> 4, h = e & 15; float kr, ki; s5_kcoef(p.s5_lre[pg * 64 + pp], p.s5_lim[pg * 64 + pp], dt, kr, ki);
                    const float br = p.s5_bre[((size_t)pg * 64 + pp) * 16 + h], bi = p.s5_bim[((size_t)pg * 64 + pp) * 16 + h];
                    Bb[e * 2] = kr * br - ki * bi; Bb[e * 2 + 1] = kr * bi + ki * br;
                    const int h2 = e >> 6, p2 = e & 63; Cc[e * 2] = p.s5_cre[((size_t)pg * 16 + h2) * 64 + p2]; Cc[e * 2 + 1] = p.s5_cim[((size_t)pg * 16 + h2) * 64 + p2]; }
                for (int e = tid; e < 2048; e += 512) { const int tau = e >> 6, pp = e & 63; float re, im; cpow(p.s5_lre[pg * 64 + pp] * dt, p.s5_lim[pg * 64 + pp] * dt, (float)tau, re, im); ap[e * 2] = re; ap[e * 2 + 1] = im; }
                __syncthreads();
                const int hh = tid & 255, h = hh >> 4, hp = hh & 15, th = tid >> 8;
                float a[16];
#pragma unroll
                for (int q = 0; q < 16; ++q) a[q] = 0.f;
                for (int pp = 0; pp < 64; ++pp) { const float cr = Cc[(h * 64 + pp) * 2], ci = Cc[(h * 64 + pp) * 2 + 1], br = Bb[(pp * 16 + hp) * 2], bi = Bb[(pp * 16 + hp) * 2 + 1];
                    const float cbr = cr * br - ci * bi, cbi = cr * bi + ci * br;
#pragma unroll
                    for (int q = 0; q < 16; ++q) { const float ar = ap[((th * 16 + q) * 64 + pp) * 2], ai = ap[((th * 16 + q) * 64 + pp) * 2 + 1]; a[q] += cbr * ar - cbi * ai; } }
#pragma unroll
                for (int q = 0; q < 16; ++q) KTAB[((((size_t)j * 64 + g) * 2 + dir) * 32 + th * 16 + q) * 256 + hh] = a[q];
            }
            __syncthreads();
        }
    }
    PH_END;

    for (int li = 0; li < 4; ++li) {
        const int kind = li % 3, jj = li / 3; const bool last = (li == 3);
        const float* xl = li == 0 ? p.x : p.out; const float* xc = li == 0 ? p.ctx : XCTX;
        const float* modl = MOD + (size_t)li * 9 * (NMOD * D);
        const float* ng = p.norm_g + (size_t)li * 2 * D;
        float* PART = (float*)(ws + WS_PART);
        const CtxFix fxA{li > 0 ? PART : nullptr, MOD + ((size_t)(li - 1) * 9 + 8) * (NMOD * D) + 5 * D, nullptr, XCTX};
        const CtxFix fxF{(kind != 0 && !last) ? PART : nullptr, modl + 8 * (NMOD * D) + 2 * D, kind == 2 ? p.fb : nullptr, XCTX};

        if (PH_ON) {
            FRESH_IDS;
            if (kind == 0) {
                for (int rep = 0; rep < NREP(3); ++rep) norm_rows_s5(xl, xc, ng, modl, HN, gw, NGW, lane, fxA);
                bf16_t* W1S = (bf16_t*)(ws + WS_W1S); bf16_t* W3S = (bf16_t*)(ws + WS_W3S);
                LAS float* apf = (LAS float*)lds;
                LAS float* apb = (LAS float*)(lds + 16896);
                LAS float* Cf = (LAS float*)(lds + 33792);
                LAS float* Cb = (LAS float*)(lds + 41984);
                LAS float* Bbf = (LAS float*)(lds + 50176);
                LAS float* Bbb = (LAS float*)(lds + 58368);
                for (int item = bid; item < 256; item += G) {
                    const int g = item >> 2, tq = item & 3;
                    __syncthreads();
                    for (int e = tid; e < 2 * 33 * 64; e += 512) { const int dir = e / (33 * 64), r = e % (33 * 64), k = r >> 6, pp = r & 63; const int pg = (jj * 2 + dir) * 64 + g;
                        const float dt = __expf(p.s5_ldt[pg]); float re, im; cpow(p.s5_lre[pg * 64 + pp] * dt, p.s5_lim[pg * 64 + pp] * dt, (float)k, re, im);
                        LAS float* d = dir ? apb : apf; d[r * 2] = re; d[r * 2 + 1] = im; }
                    for (int e = tid; e < 2048; e += 512) { const int dir = e >> 10, r = e & 1023; const int pg = (jj * 2 + dir) * 64 + g;
                        { const int h2 = r >> 6, p2 = r & 63; LAS float* d = dir ? Cb : Cf; d[r * 2] = p.s5_cre[((size_t)pg * 16 + h2) * 64 + p2]; d[r * 2 + 1] = p.s5_cim[((size_t)pg * 16 + h2) * 64 + p2]; }
                        { const int pp = r >> 4, h = r & 15; const float dt = __expf(p.s5_ldt[pg]); float kr, ki; s5_kcoef(p.s5_lre[pg * 64 + pp], p.s5_lim[pg * 64 + pp], dt, kr, ki);
                          const float br = p.s5_bre[((size_t)pg * 64 + pp) * 16 + h], bi = p.s5_bim[((size_t)pg * 64 + pp) * 16 + h];
                          LAS float* d = dir ? Bbb : Bbf; d[r * 2] = kr * br - ki * bi; d[r * 2 + 1] = kr * bi + ki * br; } }
                    __syncthreads();
                    for (int e = tid; e < 4096; e += 512) { const int ee = tq * 4096 + e; const int hh = ee & 1, s = (ee >> 1) & 31, pp = (ee >> 6) & 63, ri = (ee >> 12) & 1, dir = ee >> 13;
                        const int ex = dir ? s : 31 - s; const LAS float* apd = dir ? apb : apf; const LAS float* bd = dir ? Bbb : Bbf;
                        const float ar = apd[(ex * 64 + pp) * 2], ai = apd[(ex * 64 + pp) * 2 + 1];
                        float v[8];
#pragma unroll
                        for (int i = 0; i < 8; ++i) { const float br = bd[(pp * 16 + hh * 8 + i) * 2], bi = bd[(pp * 16 + hh * 8 + i) * 2 + 1]; v[i] = ri ? ar * bi + ai * br : ar * br - ai * bi; }
                        *(u32x4*)(W1S + ((size_t)(g * 256 + dir * 128 + ri * 64 + pp)) * 512 + s * 16 + hh * 8) = (u32x4){pk2(v[0], v[1]), pk2(v[2], v[3]), pk2(v[4], v[5]), pk2(v[6], v[7])}; }
                    const float* ktf = KTAB + (((size_t)jj * 64 + g) * 2 + 0) * 32 * 256; const float* ktb = ktf + 32 * 256;
#pragma unroll 4
                    for (int e = tid; e < 128 * 64; e += 512) { const int kc = e & 63, rowi = e >> 6, t = tq * 8 + (rowi >> 4), h = rowi & 15;
                        const int s = kc >> 1, h0 = (kc & 1) * 8; const int tau = t >= s ? t - s : s - t;
                        const f32x4* kpf = (const f32x4*)(ktf + tau * 256 + h * 16 + h0); const f32x4* kpb = (const f32x4*)(ktb + tau * 256 + h * 16 + h0);
                        const f32x4 fa = kpf[0], fb = kpf[1], ba = kpb[0], bb = kpb[1];
                        const float mf = s <= t ? 1.f : 0.f, mb = s >= t ? 1.f : 0.f;
                        float v[8];
#pragma unroll
                        for (int i = 0; i < 4; ++i) { v[i] = mf * fa[i] + mb * ba[i]; v[4 + i] = mf * fb[i] + mb * bb[i]; }
                        if (s == t) { const float dd = p.s5_d[jj * D + g * 16 + h];
#pragma unroll
                            for (int i = 0; i < 8; ++i) if (h0 + i == h) v[i] += dd; }
                        *(u32x4*)(W3S + ((size_t)(g * 512 + t * 16 + h)) * UGP + kc * 8) = (u32x4){pk2(v[0], v[1]), pk2(v[2], v[3]), pk2(v[4], v[5]), pk2(v[6], v[7])}; }
                    for (int e = tid; e < 128 * 32; e += 512) { const int q = e & 31, rowi = e >> 5, t = tq * 8 + (rowi >> 4), h = rowi & 15;
                        const int dir = q >> 4, ri = (q >> 3) & 1, p0 = (q & 7) * 8; const int ex = dir ? 32 - t : t + 1;
                        const LAS float* apd = dir ? apb : apf; const LAS float* cd = dir ? Cb : Cf;
                        float v[8];
#pragma unroll
                        for (int i = 0; i < 8; ++i) { const int pp = p0 + i; const float ar = apd[(ex * 64 + pp) * 2], ai = apd[(ex * 64 + pp) * 2 + 1], cr = cd[(h * 64 + pp) * 2], ci = cd[(h * 64 + pp) * 2 + 1];
                            v[i] = ri ? -(cr * ai + ci * ar) : cr * ar - ci * ai; }
                        *(u32x4*)(W3S + ((size_t)(g * 512 + t * 16 + h)) * UGP + (64 + q) * 8) = (u32x4){pk2(v[0], v[1]), pk2(v[2], v[3]), pk2(v[4], v[5]), pk2(v[6], v[7])}; }
                }
                __syncthreads();
            } else {
                for (int rep = 0; rep < NREP(3); ++rep) norm_rows_tok(xl, xc, ng, modl, 0, HN, TA, gw, NGW, lane, kind == 2, fxA);
                if (kind == 2) {
                    bf16_t* CS = (bf16_t*)(ws + WS_CS); bf16_t* CN2 = (bf16_t*)(ws + WS_CN256); bf16_t* W1M = (bf16_t*)(ws + WS_W1M); bf16_t* W2M = (bf16_t*)(ws + WS_W2M);
                    const int gt = bid * 512 + tid, NT = G * 512;
                    for (int e = gt; e < 2 * 256 * 16; e += NT) { const int which = e >> 12, r = (e >> 4) & 255, kc = e & 15, k0 = (kc & 7) * 8, hs = kc >> 3; float v[8];
#pragma unroll
                        for (int i = 0; i < 8; ++i) { const int mm = r & 63; const float rev = (float)((mm * (k0 + i)) & 63) * (1.f / 64.f); const float cs = __builtin_amdgcn_cosf(rev), sn = __builtin_amdgcn_sinf(rev);
                            float val = 0.f;
                            if (which == 0) { if (r < 64) val = hs ? -sn : cs; else if (r >= 128 && r < 192) val = hs ? -cs : -sn; }
                            else { if (r < 64) val = hs ? sn : cs; }
                            v[i] = val; }
                        *(u32x4*)((which ? W2M : W1M) + (size_t)r * 128 + kc * 8) = (u32x4){pk2(v[0], v[1]), pk2(v[2], v[3]), pk2(v[4], v[5]), pk2(v[6], v[7])}; }
                    for (int e = gt; e < 512 * 32; e += NT) { const int m = e >> 5, kc = m & 255, isS = m >> 8, k0 = (e & 31) * 8; float v[8];
#pragma unroll
                        for (int i = 0; i < 8; ++i) { const float rev = (float)((kc * (k0 + i)) & 255) * (1.f / 256.f); v[i] = (isS ? __builtin_amdgcn_sinf(rev) : __builtin_amdgcn_cosf(rev)) * (1.f / 16.f); }
                        *(u32x4*)(CS + (size_t)m * 256 + k0) = (u32x4){pk2(v[0], v[1]), pk2(v[2], v[3]), pk2(v[4], v[5]), pk2(v[6], v[7])}; }
                    for (int e = gt; e < 256 * 64; e += NT) { const int m = e >> 6, kc = e & 63, k0 = (kc & 31) * 8, isS = kc >> 5; float v[8];
#pragma unroll
                        for (int i = 0; i < 8; ++i) { const float rev = (float)((m * (k0 + i)) & 255) * (1.f / 256.f); v[i] = (isS ? -__builtin_amdgcn_sinf(rev) : __builtin_amdgcn_cosf(rev)) * (1.f / 16.f); }
                        *(u32x4*)(CN2 + (size_t)m * 512 + kc * 8) = (u32x4){pk2(v[0], v[1]), pk2(v[2], v[3]), pk2(v[4], v[5]), pk2(v[6], v[7])}; }
                }
            }
        }
        PH_END;

        if (kind == 0) {
            if (PH_ON) {
                pg8::Gemm g{HN, (const bf16_t*)(ws + WS_W1S), UGP, 512, 512, (size_t)NCH * UGP, (size_t)256 * 512};
                pg8::Sched S; S.init(5, 1, 64);
                pg8::EpiSloc E{(float*)(ws + WS_SLOC)};
                pg8::gemm_phase(lds, g, S, E, wave0);
            }
            PH_END;
            if (PH_ON) {
                FRESH_IDS;
                const float* SL = (const float*)(ws + WS_SLOC);
                for (int id = bid * 512 + tid; id < 8 * 64 * 2 * 64; id += G * 512) {
                    const int pp = id & 63, dir = (id >> 6) & 1, g = (id >> 7) & 63, b = id >> 13;
                    const int pg = (jj * 2 + dir) * 64 + g; const float dt = __expf(p.s5_ldt[pg]);
                    float ar, ai; cpow(p.s5_lre[pg * 64 + pp] * dt, p.s5_lim[pg * 64 + pp] * dt, 32.f, ar, ai);
                    float sr = 0.f, si = 0.f;
                    const size_t rb = (size_t)g * NCH + b * 136;
                    for (int k0 = 0; k0 < 136; k0 += 8) {
                        float lr[8], lim[8];
#pragma unroll
                        for (int q = 0; q < 8; ++q) { const int k = k0 + q; const int cc = dir == 0 ? k : (k < 8 ? 7 - k : 143 - k);
                            lr[q] = SL[(rb + cc) * 256 + dir * 128 + pp]; lim[q] = SL[(rb + cc) * 256 + dir * 128 + 64 + pp]; }
#pragma unroll
                        for (int q = 0; q < 8; ++q) { const int k = k0 + q; const int cc = dir == 0 ? k : (k < 8 ? 7 - k : 143 - k);
                            bf16_t* o = HN + (rb + cc) * UGP + 512 + dir * 128 + pp;
                            o[0] = (bf16_t)(pk2(sr, 0.f) & 0xffffu); o[64] = (bf16_t)(pk2(si, 0.f) & 0xffffu);
                            const float nr = ar * sr - ai * si + lr[q], ni = ar * si + ai * sr + lim[q]; sr = nr; si = ni; }
                    }
                }
            }
            PH_END;
            if (PH_ON) {
                pg8::Gemm g{HN, (const bf16_t*)(ws + WS_W3S), UGP, UGP, UGP, (size_t)NCH * UGP, (size_t)512 * UGP};
                pg8::Sched S; S.init(5, 2, 64);
                pg8::EpiZ E{(bf16_t*)(ws + WS_Z)};
                pg8::gemm_phase(lds, g, S, E, wave0);
            }
            PH_END;
            if (PH_ON) {
                pg8::Gemm g{(const bf16_t*)(ws + WS_Z), GLUT + (size_t)jj * D * 2 * D, D, D, D, 0, 0};
                pg8::Sched S; S.init(last ? 128 : 136, 8, 1);
                pg8::EpiGlu E{xl, xc, p.out, XCTX, modl + 2 * D};
                pg8::gemm_phase(lds, g, S, E, wave0);
            }
            PH_END;
        } else if (kind == 1) {
            bf16_t* QK = (bf16_t*)(ws + WS_QK); bf16_t* VT = (bf16_t*)(ws + WS_VT);
            if (PH_ON) {
                { pg8::Gemm g{HN, QKVT, D, D, D, 0, 0}; pg8::Sched S; S.init(136, 8, 1); pg8::EpiQK E{QK, p.qn, p.kn}; pg8::gemm_phase(lds, g, S, E, wave0); }
                { pg8::Gemm g{QKVT + (size_t)2048 * D, HN, D, D, D, 0, 0}; pg8::Sched S; S.init(4, 136, 1, 0, 128); pg8::EpiStore<0> E{VT, (size_t)TA, 0}; pg8::gemm_phase(lds, g, S, E, wave0); }
            }
            PH_END;
            if (PH_ON) {
                FRESH_IDS;
                const int l31 = lane & 31, hi = lane >> 5, comp = wave >> 2, wq = wave & 3;
                float lamv; { const float a = wave_sum(p.dlam[lane] * p.dlam[64 + lane], lane), b = wave_sum(p.dlam[128 + lane] * p.dlam[192 + lane], lane); lamv = __expf(a) - __expf(b) + LAM_INIT; }
                const int vcu = (G % 8 == 0) ? (bid % 8) * (G / 8) + bid / 8 : bid;
                constexpr int KROW = 144, KTILE = 64 * KROW, VTILE = 128 * KROW, VRING = 4 * KTILE;
                const int kr = tid >> 3, kch = tid & 7;
                const int kst = kr * KROW + kch * 16, vst = kr * KROW + ((kch >> 1) * 32 + (kch & 1) * 8);
                for (int rep = 0; rep < NREP(2); ++rep)
                for (int u = vcu; u < 2176; u += G) {
                    int b, head, qrow0, j0;
                    if (u < 2048) { b = u >> 8; head = (u >> 5) & 7; qrow0 = b * 4096 + (u & 31) * 128; j0 = 0; }
                    else { const int v = u - 2048; b = v >> 4; head = (v >> 1) & 7; qrow0 = TL + b * 256 + (v & 1) * 128; j0 = 64; }
                    bf16x8 qf[4];
                    { const bf16_t* qp = QK + (size_t)(qrow0 + wq * 32 + l31) * 2048 + head * 128 + comp * 64 + hi * 8;
#pragma unroll
                      for (int ds = 0; ds < 4; ++ds) qf[ds] = *(const bf16x8*)(qp + ds * 16); }
                    const bf16_t* kbase = QK + (size_t)kr * 2048 + 1024 + head * 128 + kch * 8;
                    const bf16_t* vbase = VT + (size_t)(head * 128 + kr) * TA + kch * 8;
                    u32x4 pk0, pk1, pv0, pv1;
#define ATT_TOKBASE(j) ((j) < 64 ? b * 4096 + 64 * (j) : TL + b * 256 + 64 * ((j) - 64))
#define ATT_LOADK(j) do { const bf16_t* kp_ = kbase + (size_t)ATT_TOKBASE(j) * 2048; pk0 = *(const u32x4*)kp_; pk1 = *(const u32x4*)(kp_ + 64); } while (0)
#define ATT_LOADV(j) do { const bf16_t* vp_ = vbase + ATT_TOKBASE(j); pv0 = *(const u32x4*)vp_; pv1 = *(const u32x4*)(vp_ + (size_t)64 * TA); } while (0)
#define ATT_STOREK(sl) do { LAS unsigned char* bb_ = lds + (sl) * (2 * KTILE) + kst; *(LAS u32x4*)(bb_) = pk0; *(LAS u32x4*)(bb_ + KTILE) = pk1; } while (0)
#define ATT_STOREV(sl) do { LAS unsigned char* vb_ = lds + VRING + (sl) * VTILE + vst; \
                        *(LAS u32x2*)(vb_) = (u32x2){pv0.x, pv0.y}; *(LAS u32x2*)(vb_ + 16) = (u32x2){pv0.z, pv0.w}; \
                        *(LAS u32x2*)(vb_ + 64 * KROW) = (u32x2){pv1.x, pv1.y}; *(LAS u32x2*)(vb_ + 64 * KROW + 16) = (u32x2){pv1.z, pv1.w}; } while (0)
#define ATT_QK(S0, S1, sl, CI) do { const LAS unsigned char* kb_ = lds + (sl) * (2 * KTILE) + comp * KTILE + l31 * KROW + hi * 16; bf16x8 kf_[8]; \
                        _Pragma("unroll") for (int ds = 0; ds < 4; ++ds) { kf_[2 * ds] = *(const LAS bf16x8*)(kb_ + ds * 32); kf_[2 * ds + 1] = *(const LAS bf16x8*)(kb_ + 32 * KROW + ds * 32); } \
                        __builtin_amdgcn_sched_barrier(0); \
                        _Pragma("unroll") for (int ds = 0; ds < 4; ++ds) { \
                            S0 = __builtin_amdgcn_mfma_f32_32x32x16_bf16(kf_[2 * ds], qf[ds], ds == 0 ? CI : S0, 0, 0, 0); S1 = __builtin_amdgcn_mfma_f32_32x32x16_bf16(kf_[2 * ds + 1], qf[ds], ds == 0 ? CI : S1, 0, 0, 0); } } while (0)
#define ATT_PV(sl) do { const LAS unsigned char* vb_ = lds + VRING + (sl) * VTILE + l31 * KROW + hi * 16; \
                        _Pragma("unroll") for (int ks = 0; ks < 4; ++ks) _Pragma("unroll") for (int dt = 0; dt < 4; ++dt) { const bf16x8 a_ = *(const LAS bf16x8*)(vb_ + dt * 32 * KROW + ks * 32); \
                            o[dt] = __builtin_amdgcn_mfma_f32_32x32x16_bf16(a_, pp[ks], o[dt], 0, 0, 0); } } while (0)
#define ATT_SOFT(S0, S1, PD) do { f32x2 ls_ = {0.f, 0.f}; \
                        _Pragma("unroll") for (int r = 0; r < 16; ++r) { S0[r] = __builtin_amdgcn_exp2f(S0[r]); S1[r] = __builtin_amdgcn_exp2f(S1[r]); } \
                        _Pragma("unroll") for (int r = 0; r < 16; r += 2) { ls_ += (f32x2){S0[r], S0[r + 1]}; ls_ += (f32x2){S1[r], S1[r + 1]}; } \
                        l_run += ls_.x + ls_.y; \
                        { u32x4 w_; \
                          w_ = (u32x4){pk2(S0[0], S0[1]), pk2(S0[2], S0[3]), pk2(S0[4], S0[5]), pk2(S0[6], S0[7])}; PD[0] = __builtin_bit_cast(bf16x8, w_); \
                          w_ = (u32x4){pk2(S0[8], S0[9]), pk2(S0[10], S0[11]), pk2(S0[12], S0[13]), pk2(S0[14], S0[15])}; PD[1] = __builtin_bit_cast(bf16x8, w_); \
                          w_ = (u32x4){pk2(S1[0], S1[1]), pk2(S1[2], S1[3]), pk2(S1[4], S1[5]), pk2(S1[6], S1[7])}; PD[2] = __builtin_bit_cast(bf16x8, w_); \
                          w_ = (u32x4){pk2(S1[8], S1[9]), pk2(S1[10], S1[11]), pk2(S1[12], S1[13]), pk2(S1[14], S1[15])}; PD[3] = __builtin_bit_cast(bf16x8, w_); } } while (0)
                    f32x16 o[4];
#pragma unroll
                    for (int dt = 0; dt < 4; ++dt)
#pragma unroll
                        for (int r = 0; r < 16; ++r) o[dt][r] = 0.f;
                    float m_ref, l_run = 0.f;
                    f32x16 negm, zero16;
#pragma unroll
                    for (int r = 0; r < 16; ++r) zero16[r] = 0.f;
                    bf16x8 pp[4];
                    __syncthreads();
                    ATT_LOADK(j0); ATT_STOREK(j0 & 1);
                    __syncthreads();
                    {
                        ATT_LOADK(j0 + 1); ATT_LOADV(j0);
                        f32x16 s0, s1;
                        ATT_QK(s0, s1, j0 & 1, zero16);
                        float mx = fmaxf(s0[0], s1[0]);
#pragma unroll
                        for (int r = 1; r < 16; ++r) mx = fmaxf(mx, fmaxf(s0[r], s1[r]));
                        m_ref = xhalf_max(mx);
#pragma unroll
                        for (int r = 0; r < 16; ++r) { s0[r] -= m_ref; s1[r] -= m_ref; negm[r] = -m_ref; }
                        ATT_SOFT(s0, s1, pp);
                        ATT_STOREK((j0 + 1) & 1); ATT_STOREV(j0 & 1);
                        __syncthreads();
                    }
                    for (int j = j0 + 1; j < 68; ++j) {
                        const int jn = j + 1 < 68 ? j + 1 : 67;
                        ATT_LOADK(jn); ATT_LOADV(j);
                        f32x16 s0, s1;
                        ATT_QK(s0, s1, j & 1, negm);
                        float mx = max3f(s0[0], s1[0], s0[1]), mx2 = max3f(s1[1], s0[2], s1[2]);
#pragma unroll
                        for (int r = 3; r < 15; r += 2) { mx = max3f(mx, s0[r], s1[r]); mx2 = max3f(mx2, s0[r + 1], s1[r + 1]); }
                        mx = max3f(mx, s0[15], s1[15]); mx = fmaxf(mx, mx2);
                        mx = xhalf_max(mx);
                        if (__builtin_expect(__any(mx > ATT_THR), 0)) {
                            const float dl = ceilf(fmaxf(mx, 0.f)), f = __builtin_amdgcn_exp2f(-dl);
                            m_ref += dl; l_run *= f;
#pragma unroll
                            for (int r = 0; r < 16; ++r) { s0[r] -= dl; s1[r] -= dl; negm[r] = -m_ref; }
#pragma unroll
                            for (int dt = 0; dt < 4; ++dt)
#pragma unroll
                                for (int r = 0; r < 16; ++r) o[dt][r] *= f;
#pragma unroll
                            for (int ks = 0; ks < 4; ++ks) { u32x4 w = __builtin_bit_cast(u32x4, pp[ks]);
                                w.x = pk2(bflo(w.x) * f, bfhi(w.x) * f); w.y = pk2(bflo(w.y) * f, bfhi(w.y) * f); w.z = pk2(bflo(w.z) * f, bfhi(w.z) * f); w.w = pk2(bflo(w.w) * f, bfhi(w.w) * f);
                                pp[ks] = __builtin_bit_cast(bf16x8, w); }
                        }
                        __builtin_amdgcn_sched_barrier(0);
                        unsigned pw[16]; f32x2 ls = {0.f, 0.f};
                        {
                            const LAS unsigned char* vb_ = lds + VRING + ((j - 1) & 1) * VTILE + l31 * KROW + hi * 16;
                            bf16x8 vf[16];
#define ATT_VRD(i) vf[i] = *(const LAS bf16x8*)(vb_ + ((i) & 3) * 32 * KROW + ((i) >> 2) * 32)
                            ATT_VRD(0); ATT_VRD(1);
#pragma unroll
                            for (int i = 0; i < 16; ++i) {
                                if (i + 2 < 16) ATT_VRD(i + 2);
                                o[i & 3] = __builtin_amdgcn_mfma_f32_32x32x16_bf16(vf[i], pp[i >> 2], o[i & 3], 0, 0, 0);
                                s0[i] = __builtin_amdgcn_exp2f(s0[i]); s1[i] = __builtin_amdgcn_exp2f(s1[i]);
                                if (i & 1) { pw[i >> 1] = pk2(s0[i - 1], s0[i]); pw[8 + (i >> 1)] = pk2(s1[i - 1], s1[i]); ls += (f32x2){s0[i - 1], s0[i]}; ls += (f32x2){s1[i - 1], s1[i]}; }
                                __builtin_amdgcn_sched_barrier(0);
                            }
#undef ATT_VRD
                        }
                        l_run += ls.x + ls.y;
#pragma unroll
                        for (int ks = 0; ks < 4; ++ks) { const u32x4 w = {pw[4 * ks], pw[4 * ks + 1], pw[4 * ks + 2], pw[4 * ks + 3]}; pp[ks] = __builtin_bit_cast(bf16x8, w); }
                        ATT_STOREK(jn & 1); ATT_STOREV(j & 1);
                        __syncthreads();
                    }
                    ATT_PV(67 & 1);
#undef ATT_TOKBASE
#undef ATT_LOADK
#undef ATT_LOADV
#undef ATT_STOREK
#undef ATT_STOREV
#undef ATT_QK
#undef ATT_PV
#undef ATT_SOFT
                    { const float lt = xhalf_sum(l_run); const float inv = 1.f / lt;
#pragma unroll
                      for (int dt = 0; dt < 4; ++dt)
#pragma unroll
                          for (int r = 0; r < 16; ++r) o[dt][r] *= inv; }
                    __syncthreads();
                    LAS float* ex = (LAS float*)lds + wq * 4096;
                    if (comp == 1) {
#pragma unroll
                        for (int dt = 0; dt < 4; ++dt)
#pragma unroll
                            for (int r = 0; r < 16; ++r) ex[(dt * 16 + r) * 64 + lane] = o[dt][r];
                    }
                    __syncthreads();
                    LAS bf16_t* stg = (LAS bf16_t*)(lds + 81920) + wq * (32 * 136);
                    if (comp == 0) {
                        float ss = 0.f;
#pragma unroll
                        for (int dt = 0; dt < 4; ++dt)
#pragma unroll
                            for (int r = 0; r < 16; ++r) { const float d = o[dt][r] - lamv * ex[(dt * 16 + r) * 64 + lane]; o[dt][r] = d; ss += d * d; }
                        ss = xhalf_sum(ss);
                        const float rstd = rsqrtf(ss * (1.f / 128.f) + EPS) * (1.f - LAM_INIT);
#pragma unroll
                        for (int dt = 0; dt < 4; ++dt)
#pragma unroll
                            for (int r = 0; r < 16; ++r) { const int dv = 32 * dt + (r & 3) + 8 * (r >> 2) + 4 * hi; stg[l31 * 136 + dv] = (bf16_t)(pk2(o[dt][r] * rstd * p.subln[dv], 0.f) & 0xffffu); }
                    }
                    __syncthreads();
                    if (comp == 0) {
#pragma unroll
                        for (int it = 0; it < 8; ++it) { const int row = it * 4 + (lane >> 4), ch = lane & 15;
                            const u32x4 w = *(const LAS u32x4*)(stg + row * 136 + ch * 8);
                            *(u32x4*)(HN + (size_t)(qrow0 + wq * 32 + row) * D + head * 128 + ch * 8) = w; }
                    }
                }
                __syncthreads();
            }
            PH_END;
        } else {
            if (PH_ON) {
                pg8::Gemm g{(const bf16_t*)(ws + WS_CS), HN, 256, D, 256, 0, 256};
                pg8::Sched S; S.init(2, 136, 4);
                pg8::EpiChanDft E{(bf16_t*)(ws + WS_PQT), (bf16_t*)(ws + WS_PQC)};
                pg8::gemm_phase(lds, g, S, E, wave0);
            }
            PH_END;
            if (PH_ON) {
                { pg8::Gemm g{(const bf16_t*)(ws + WS_W1M), (const bf16_t*)(ws + WS_PQT), 128, 128, 128, 0, 0};
                  pg8::Sched S; S.init(1, 2048, 1); pg8::EpiFft1 E{(bf16_t*)(ws + WS_B2)}; pg8::gemm_phase(lds, g, S, E, wave0); }
                { pg8::Gemm g{(const bf16_t*)(ws + WS_CN256), (const bf16_t*)(ws + WS_PQC), 512, 512, 512, 0, (size_t)1024 * 512};
                  pg8::Sched S; S.init(1, 4, 8); pg8::EpiStore<0> E{HN + (size_t)TL * D, D, (size_t)256 * D}; pg8::gemm_phase(lds, g, S, E, wave0); }
            }
            PH_END;
            if (PH_ON) {
                pg8::Gemm g{(const bf16_t*)(ws + WS_W2M), (const bf16_t*)(ws + WS_B2), 128, 128, 128, 0, 0};
                pg8::Sched S; S.init(1, 2048, 1); pg8::EpiFft2 E{HN}; pg8::gemm_phase(lds, g, S, E, wave0);
            }
            PH_END;
        }
        if (kind != 0) {
            if (PH_ON) {
                { pg8::Gemm g{HN, kind == 1 ? WOT : FWT, D, D, D, 0, 0};
                  pg8::Sched S; S.init(128, 4, 1);
                  pg8::EpiResid E{xl, xc, p.out, XCTX, modl + 2 * D, kind == 2 ? p.fb : nullptr};
                  pg8::gemm_phase(lds, g, S, E, wave0); }
                if (!last) { pg8::Gemm g{HN, kind == 1 ? WOT : FWT, D, D, D / KSPLIT, (size_t)(D / KSPLIT), (size_t)(D / KSPLIT)};
                  pg8::Sched S; S.init(8, 4, KSPLIT, 128);
                  pg8::EpiPart E{PART};
                  pg8::gemm_phase(lds, g, S, E, wave0); }
            }
            PH_END;
        }
        if (PH_ON) { FRESH_IDS; for (int rep = 0; rep < NREP(3); ++rep) norm_rows_tok(p.out, XCTX, ng + D, modl, 3, HN, last ? TL : TA, gw, NGW, lane, false, fxF); }
        PH_END;
        if (PH_ON) {
            for (int rep = 0; rep < NREP(0); ++rep) {
            pg8::Gemm g{HN, W1T + (size_t)li * D * DFF, D, D, D, 0, 0};
            pg8::Sched S; S.init(last ? 128 : 136, 16, 1);
            pg8::EpiStore<1> E{HB, DFF, 0};
            pg8::gemm_phase(lds, g, S, E, wave0); }
        }
        PH_END;
        if (PH_ON) {
            if (!last) { pg8::Gemm g{HB, W2T + (size_t)li * D * DFF, DFF, DFF, DFF / KSPLIT, (size_t)(DFF / KSPLIT), (size_t)(DFF / KSPLIT)};
              pg8::Sched S; S.init(8, 4, KSPLIT, 128);
              pg8::EpiPart E{PART};
              pg8::gemm_phase(lds, g, S, E, wave0); }
            for (int rep = 0; rep < NREP(1); ++rep) {
            pg8::Gemm g{HB, W2T + (size_t)li * D * DFF, DFF, DFF, DFF, 0, 0};
            pg8::Sched S; S.init(128, 4, 1);
            pg8::EpiResid E{p.out, XCTX, p.out, XCTX, (rep + 1 < NREP(1)) ? (const float*)(ws + WS_ZERO) : modl + 5 * D, nullptr};
            pg8::gemm_phase(lds, g, S, E, wave0); }
        }
        PH_END;
    }
}

extern "C" void kernel_launch(void* const* d_in, const int* in_sizes, int n_in, void* d_out, int out_size, void* d_ws, size_t ws_size, hipStream_t stream) {
    static int grid = 0;
    if (grid == 0) {
        int dev = 0, cus = 0, per_cu = 0;
        hipGetDevice(&dev);
        hipDeviceGetAttribute(&cus, hipDeviceAttributeMultiprocessorCount, dev);
        hipFuncSetAttribute((const void*)mega_fwd, hipFuncAttributeMaxDynamicSharedMemorySize, LDS_BYTES);
        hipOccupancyMaxActiveBlocksPerMultiprocessor(&per_cu, (const void*)mega_fwd, 512, LDS_BYTES);
        if (per_cu < 1) per_cu = 1;
        grid = cus * per_cu;
        if (ws_size < WS_END) fprintf(stderr, "kernel_launch: workspace too small: %zu < %zu\n", ws_size, (size_t)WS_END);
    }
    (void)hipMemsetAsync((char*)d_ws + WS_CTL, 0, CTL_BYTES, stream);
    Params p{};
    const float** f = (const float**)&p;
    for (int i = 0; i < 26; ++i) f[i] = (const float*)d_in[i];
    p.out = (float*)d_out; p.ws = (unsigned char*)d_ws; p.ph_lo = 0; p.ph_hi = 1000;
    void* args[] = {&p};
    hipError_t e = hipLaunchCooperativeKernel((const void*)mega_fwd, dim3(grid), dim3(512), args, LDS_BYTES, stream);
    if (e != hipSuccess) fprintf(stderr, "cooperative launch failed: %s (grid %d)\n", hipGetErrorString(e), grid);
}
```
